# Optimizing an MI355X kernel written in HIP

```python
import math
import jax, jax.numpy as jnp
from jax import lax
import numpy as np

D_MODEL = 1024
BATCH = 32
SEQ = 256
DEPTH = 2
DEC_BATCH = 2
DEC_SEQ = 4096
PAST_LEN = 256

GRID_W = 64
N_EVEN = (DEPTH + 1) // 2
N_ODD = DEPTH // 2
EPS = 1e-6
S5_WIDTH = D_MODEL // 2
S5_CH = 16
S5_GROUPS = S5_WIDTH // S5_CH
S5_STATE = 64
LRU_WIDTH = D_MODEL // 2
LRU_HEADS = 8
LRU_BW = LRU_WIDTH // LRU_HEADS
LRU_CONV = 4
LRU_C = 8.0
HY_WIDTH = D_MODEL
HY_SHORT = 3
HY_BANDS = 16
HY_EMB = 2 * HY_BANDS + 1
HY_FF = 64
HY_SHIFT = 0.05
PEER_HEADS = 8
PEER_DK = 256
PEER_DKH = PEER_DK // 2
PEER_NKEYS = 128
PEER_EXPERTS = PEER_NKEYS ** 2
PEER_TOPK = 16
PEER_BLOCK = 128

kernel_name = 'hybrid_s5_rglru_hyena_peer_diffusion'


def rmsnorm(x, g):
    xf = x.astype(jnp.float32)
    y = xf * lax.rsqrt(jnp.mean(xf * xf, axis=-1, keepdims=True) + EPS)
    return y.astype(x.dtype) * g


def dwconv_rows(x, w, b, grid, pad_left):
    bsz, length, ch = x.shape
    rows, row_len = grid
    taps = w.shape[0]
    xr = x.reshape(bsz, rows, row_len, ch)
    xp = jnp.pad(xr, ((0, 0), (0, 0), (pad_left, taps - 1 - pad_left), (0, 0)))
    y = sum(xp[:, :, k:k + row_len, :] * w[k] for k in range(taps)) + b
    return y.reshape(bsz, length, ch)


def _complex_combine(e1, e2):
    ar1, ai1, br1, bi1 = e1
    ar2, ai2, br2, bi2 = e2
    return (ar2 * ar1 - ai2 * ai1, ar2 * ai1 + ai2 * ar1,
            ar2 * br1 - ai2 * bi1 + br2, ar2 * bi1 + ai2 * br1 + bi2)


def _real_combine(e1, e2):
    a1, b1 = e1
    a2, b2 = e2
    return (a2 * a1, a2 * b1 + b2)


def s5_scan(u, a_re, a_im, log_dt, b_re, b_im, c_re, c_im, h0, reverse):
    f32 = jnp.float32
    a_re = a_re.astype(f32)
    a_im = a_im.astype(f32)
    dt = jnp.exp(log_dt.astype(f32))[:, None]
    mag = jnp.exp(a_re * dt)
    abar_r = mag * jnp.cos(a_im * dt)
    abar_i = mag * jnp.sin(a_im * dt)
    den = a_re * a_re + a_im * a_im
    num_r = abar_r - 1.0
    coef_r = ((num_r * a_re + abar_i * a_im) / den)[..., None]
    coef_i = ((abar_i * a_re - num_r * a_im) / den)[..., None]
    bbar_r = coef_r * b_re - coef_i * b_im
    bbar_i = coef_r * b_im + coef_i * b_re
    bu_r = jnp.einsum('gpc,blgc->blgp', bbar_r, u)
    bu_i = jnp.einsum('gpc,blgc->blgp', bbar_i, u)
    first, last = (-1, 0) if reverse else (0, -1)
    if h0 is not None:
        h0_r = h0[0].astype(f32)
        h0_i = h0[1].astype(f32)
        bu_r = bu_r.at[:, first].add(abar_r * h0_r - abar_i * h0_i)
        bu_i = bu_i.at[:, first].add(abar_r * h0_i + abar_i * h0_r)
    elems = (jnp.broadcast_to(abar_r, bu_r.shape), jnp.broadcast_to(abar_i, bu_r.shape), bu_r, bu_i)
    _, _, h_r, h_i = lax.associative_scan(_complex_combine, elems, reverse=reverse, axis=1)
    y = jnp.einsum('gcp,blgp->blgc', c_re, h_r) - jnp.einsum('gcp,blgp->blgc', c_im, h_i)
    return y, h_r[:, last], h_i[:, last]


def rglru_scan(xb, w_a, b_a, w_x, b_x, lam, h0, reverse):
    bsz, length, width = xb.shape
    xh = xb.reshape(bsz, length, LRU_HEADS, LRU_BW)
    r = jax.nn.sigmoid(jnp.einsum('blhi,hij->blhj', xh, w_a).reshape(bsz, length, width) + b_a)
    i = jax.nn.sigmoid(jnp.einsum('blhi,hij->blhj', xh, w_x).reshape(bsz, length, width) + b_x)
    log_a = -LRU_C * r * jax.nn.softplus(-lam.astype(jnp.float32))
    a = jnp.exp(log_a)
    b = jnp.sqrt(-jnp.expm1(2.0 * log_a)) * (i * xb)
    first, last = (-1, 0) if reverse else (0, -1)
    if h0 is not None:
        b = b.at[:, first].add(a[:, first] * h0.astype(jnp.float32))
    _, h = lax.associative_scan(_real_combine, (a, b), reverse=reverse, axis=1)
    return h, h[:, last]


def mixer_ab(h, P, le, grid, h0):
    f32 = jnp.float32
    bsz, length, _ = h.shape
    z = h @ P['w_in_ab'][le]
    u, xr, xg = jnp.split(z, [S5_WIDTH, S5_WIDTH + LRU_WIDTH], axis=-1)
    uf = u.astype(f32).reshape(bsz, length, S5_GROUPS, S5_CH)
    y = uf * P['s5_d'][le].astype(f32).reshape(S5_GROUPS, S5_CH)
    xb = dwconv_rows(xr, P['lru_conv_w'][le], P['lru_conv_b'][le], grid, 2).astype(f32)
    hsum = jnp.zeros_like(xb)
    st_re, st_im, st_lru = [], [], []
    for d in range(2):
        rev = d == 1
        h0_s5 = None if h0 is None else (h0[0][:, d], h0[1][:, d])
        yd, hr, hi = s5_scan(uf, P['s5_a_re'][le, d], P['s5_a_im'][le, d], P['s5_log_dt'][le, d],
                             P['s5_b_re'][le, d], P['s5_b_im'][le, d], P['s5_c_re'][le, d], P['s5_c_im'][le, d],
                             h0_s5, rev)
        y = y + yd
        hd, hl = rglru_scan(xb, P['lru_w_a'][le, d], P['lru_b_a'][le, d], P['lru_w_x'][le, d], P['lru_b_x'][le, d],
                            P['lru_lambda'][le, d], None if h0 is None else h0[2][:, d], rev)
        hsum = hsum + hd
        st_re.append(hr)
        st_im.append(hi)
        st_lru.append(hl)
    zs = jax.nn.gelu(y.reshape(bsz, length, S5_WIDTH))
    s5_out = zs * jax.nn.sigmoid(zs @ P['s5_w_glu'][le] + P['s5_b_glu'][le])
    lru_out = hsum * jax.nn.gelu(xg.astype(f32))
    out = jnp.concatenate([s5_out, lru_out], axis=-1).astype(h.dtype) @ P['w_out_ab'][le]
    return out, (jnp.stack(st_re, axis=1), jnp.stack(st_im, axis=1), jnp.stack(st_lru, axis=1))


def hyena_filters(length, w1, b1, f1, w2, b2, f2, w3, decay):
    f32 = jnp.float32
    pos = jnp.arange(length, dtype=f32)
    t = (pos / length)[:, None]
    bands = jnp.linspace(1e-4, HY_BANDS - 1, HY_BANDS, dtype=f32)
    ang = (2.0 * math.pi / length) * pos[:, None] * bands[None, :]
    emb = jnp.concatenate([t, jnp.cos(ang), -jnp.sin(ang)], axis=-1)
    z = jnp.sin(f1 * (emb @ w1 + b1))
    z = jnp.sin(f2 * (z @ w2 + b2))
    filt = (z @ w3).astype(f32).reshape(length, 2, HY_WIDTH)
    filt = filt * (jnp.exp(-t[:, :, None] * jnp.abs(decay.astype(f32))) + HY_SHIFT)
    circ = jnp.concatenate([filt[:, 0], jnp.zeros((1, HY_WIDTH), f32), filt[:0:-1, 1]], axis=0)
    return circ * lax.rsqrt(jnp.sum(circ * circ, axis=0, keepdims=True) + EPS)


def bidir_long_conv(v, circ):
    length = v.shape[1]
    n = 2 * length
    vf = jnp.fft.rfft(v, n=n, axis=1)
    kf = jnp.fft.rfft(circ, n=n, axis=0)
    return jnp.fft.irfft(vf * kf[None], n=n, axis=1)[:, :length]


def mixer_c(h, P, lo, grid):
    length = h.shape[1]
    z = h @ P['w_in_c'][lo] + P['b_in_c'][lo]
    z = dwconv_rows(z, P['hy_conv_w'][lo], P['hy_conv_b'][lo], grid, 1)
    x0, x1, v = jnp.split(z, 3, axis=-1)
    v = (v * x1).astype(jnp.float32)
    circ = hyena_filters(length, P['hy_w1'][lo], P['hy_b1'][lo], P['hy_freq1'][lo], P['hy_w2'][lo],
                         P['hy_b2'][lo], P['hy_freq2'][lo], P['hy_w3'][lo], P['hy_decay'][lo])
    v = bidir_long_conv(v, circ) + P['hy_bias'][lo] * v
    y = v.astype(h.dtype) * x0
    return y @ P['w_out_c'][lo] + P['b_out_c'][lo]


def peer(h, wq, keys, u_tab, v_tab):
    bsz, length, dm = h.shape
    ntok = bsz * length
    x = h.reshape(ntok, dm)
    q = (x @ wq).reshape(ntok, PEER_HEADS, 2, PEER_DKH)
    s = jnp.einsum('thpk,hpnk->thpn', q, keys).astype(jnp.float32)
    sv, si = lax.top_k(s, PEER_TOPK)
    cand = (sv[:, :, 0, :, None] + sv[:, :, 1, None, :]).reshape(ntok, PEER_HEADS, PEER_TOPK * PEER_TOPK)
    cidx = (si[:, :, 0, :, None] * PEER_NKEYS + si[:, :, 1, None, :]).reshape(ntok, PEER_HEADS, PEER_TOPK * PEER_TOPK)
    fv, fpos = lax.top_k(cand, PEER_TOPK)
    eidx = jnp.take_along_axis(cidx, fpos, axis=-1)
    g = jax.nn.softmax(fv, axis=-1).astype(h.dtype)
    nblk = ntok // PEER_BLOCK
    eidx = eidx.reshape(nblk, PEER_BLOCK, PEER_HEADS * PEER_TOPK)
    g = g.reshape(nblk, PEER_BLOCK, PEER_HEADS * PEER_TOPK)
    xb = x.reshape(nblk, PEER_BLOCK, dm)

    def block(args):
        xb_, idx_, g_ = args
        act = jax.nn.gelu(jnp.einsum('td,ted->te', xb_, u_tab[idx_]))
        return jnp.einsum('te,ted->td', g_ * act, v_tab[idx_])

    out = lax.map(block, (xb, eidx, g))
    return out.reshape(bsz, length, dm)


def trunk(x, cond, grid, P, cache):
    collect = cache is None
    st_re, st_im, st_lru = [], [], []
    for l in range(DEPTH):
        mod = jax.nn.silu(cond) @ P['w_mod'][l] + P['b_mod'][l]
        sh1, sc1, g1, sh2, sc2, g2 = jnp.split(mod[:, None, :], 6, axis=-1)
        h = rmsnorm(x, P['norm1_g'][l]) * (1 + sc1) + sh1
        if l % 2 == 0:
            le = l // 2
            h0 = None if collect else (cache[0][:, le], cache[1][:, le], cache[2][:, le])
            out, (s_re, s_im, s_lru) = mixer_ab(h, P, le, grid, h0)
            if collect:
                st_re.append(s_re)
                st_im.append(s_im)
                st_lru.append(s_lru)
        else:
            out = mixer_c(h, P, l // 2, grid)
        x = x + g1 * out
        h = rmsnorm(x, P['norm2_g'][l]) * (1 + sc2) + sh2
        x = x + g2 * peer(h, P['peer_wq'][l], P['peer_keys'][l], P['peer_u'][l], P['peer_v'][l])
    y = rmsnorm(x, P['final_g'])
    if collect:
        return y, (jnp.stack(st_re, axis=1), jnp.stack(st_im, axis=1), jnp.stack(st_lru, axis=1))
    return y, None


def setup_inputs(seed: int = 0) -> dict:
    key = jax.random.key(seed)
    ks = iter(jax.random.split(key, 64))
    f32 = jnp.float32

    def nrm(shape, scale):
        return scale * jax.random.normal(next(ks), shape, f32)

    def uni(shape, lo, hi):
        return jax.random.uniform(next(ks), shape, f32, lo, hi)

    D = D_MODEL
    lru_a = uni((N_EVEN, 2, LRU_WIDTH), 0.9, 0.999)
    s5_shape = (N_EVEN, 2, S5_GROUPS, S5_STATE)
    return {
        'x_prompt': nrm((BATCH, SEQ, D), 1.0),
        'x_sample': nrm((DEC_BATCH, DEC_SEQ, D), 1.0),
        'state_s5_re': nrm((DEC_BATCH, N_EVEN, 2, S5_GROUPS, S5_STATE), 0.1),
        'state_s5_im': nrm((DEC_BATCH, N_EVEN, 2, S5_GROUPS, S5_STATE), 0.1),
        'state_lru': nrm((DEC_BATCH, N_EVEN, 2, LRU_WIDTH), 0.5),
        'c': nrm((DEC_BATCH, D), 1.0),
        'c_ctx': nrm((D,), 1.0),
        'norm1_g': 1.0 + nrm((DEPTH, D), 0.01),
        'norm2_g': 1.0 + nrm((DEPTH, D), 0.01),
        'w_mod': nrm((DEPTH, D, 6 * D), 0.5 * D ** -0.5),
        'b_mod': nrm((DEPTH, 6 * D), 0.01),
        'w_in_ab': nrm((N_EVEN, D, S5_WIDTH + 2 * LRU_WIDTH), D ** -0.5),
        's5_a_re': -0.5 + nrm(s5_shape, 0.01),
        's5_a_im': jnp.pi * jnp.arange(S5_STATE, dtype=f32) + nrm(s5_shape, 0.01),
        's5_log_dt': uni((N_EVEN, 2, S5_GROUPS), math.log(1e-3), math.log(1e-1)),
        's5_b_re': nrm((N_EVEN, 2, S5_GROUPS, S5_STATE, S5_CH), (2 * S5_CH) ** -0.5),
        's5_b_im': nrm((N_EVEN, 2, S5_GROUPS, S5_STATE, S5_CH), (2 * S5_CH) ** -0.5),
        's5_c_re': nrm((N_EVEN, 2, S5_GROUPS, S5_CH, S5_STATE), S5_STATE ** -0.5),
        's5_c_im': nrm((N_EVEN, 2, S5_GROUPS, S5_CH, S5_STATE), S5_STATE ** -0.5),
        's5_d': nrm((N_EVEN, S5_WIDTH), 1.0),
        's5_w_glu': nrm((N_EVEN, S5_WIDTH, S5_WIDTH), S5_WIDTH ** -0.5),
        's5_b_glu': nrm((N_EVEN, S5_WIDTH), 0.01),
        'lru_conv_w': nrm((N_EVEN, LRU_CONV, LRU_WIDTH), LRU_CONV ** -0.5),
        'lru_conv_b': nrm((N_EVEN, LRU_WIDTH), 0.01),
        'lru_w_a': nrm((N_EVEN, 2, LRU_HEADS, LRU_BW, LRU_BW), LRU_BW ** -0.5),
        'lru_b_a': nrm((N_EVEN, 2, LRU_WIDTH), 0.01),
        'lru_w_x': nrm((N_EVEN, 2, LRU_HEADS, LRU_BW, LRU_BW), LRU_BW ** -0.5),
        'lru_b_x': nrm((N_EVEN, 2, LRU_WIDTH), 0.01),
        'lru_lambda': jnp.log(lru_a) - jnp.log1p(-lru_a),
        'w_out_ab': nrm((N_EVEN, S5_WIDTH + LRU_WIDTH, D), (S5_WIDTH + LRU_WIDTH) ** -0.5),
        'w_in_c': nrm((N_ODD, D, 3 * HY_WIDTH), D ** -0.5),
        'b_in_c': nrm((N_ODD, 3 * HY_WIDTH), 0.01),
        'hy_conv_w': nrm((N_ODD, HY_SHORT, 3 * HY_WIDTH), HY_SHORT ** -0.5),
        'hy_conv_b': nrm((N_ODD, 3 * HY_WIDTH), 0.01),
        'hy_w1': nrm((N_ODD, HY_EMB, HY_FF), HY_EMB ** -0.5),
        'hy_b1': nrm((N_ODD, HY_FF), 0.1),
        'hy_freq1': 1.0 + nrm((N_ODD, HY_FF), 0.01),
        'hy_w2': nrm((N_ODD, HY_FF, HY_FF), HY_FF ** -0.5),
        'hy_b2': nrm((N_ODD, HY_FF), 0.1),
        'hy_freq2': 1.0 + nrm((N_ODD, HY_FF), 0.01),
        'hy_w3': nrm((N_ODD, HY_FF, 2 * HY_WIDTH), HY_FF ** -0.5),
        'hy_decay': uni((N_ODD, 2, HY_WIDTH), 3.0, 15.0),
        'hy_bias': nrm((N_ODD, HY_WIDTH), 1.0),
        'w_out_c': nrm((N_ODD, HY_WIDTH, D), HY_WIDTH ** -0.5),
        'b_out_c': nrm((N_ODD, D), 0.01),
        'peer_wq': nrm((DEPTH, D, PEER_HEADS * PEER_DK), D ** -0.5),
        'peer_keys': nrm((DEPTH, PEER_HEADS, 2, PEER_NKEYS, PEER_DKH), PEER_DKH ** -0.5),
        'peer_u': nrm((DEPTH, PEER_EXPERTS, D), D ** -0.5),
        'peer_v': nrm((DEPTH, PEER_EXPERTS, D), PEER_HEADS ** -0.5),
        'final_g': 1.0 + nrm((D,), 0.01),
    }


def reference(x_prompt, x_sample, state_s5_re, state_s5_im, state_lru, c, c_ctx,
              norm1_g, norm2_g, w_mod, b_mod, w_in_ab,
              s5_a_re, s5_a_im, s5_log_dt, s5_b_re, s5_b_im, s5_c_re, s5_c_im, s5_d, s5_w_glu, s5_b_glu,
              lru_conv_w, lru_conv_b, lru_w_a, lru_b_a, lru_w_x, lru_b_x, lru_lambda, w_out_ab,
              w_in_c, b_in_c, hy_conv_w, hy_conv_b, hy_w1, hy_b1, hy_freq1, hy_w2, hy_b2, hy_freq2, hy_w3,
              hy_decay, hy_bias, w_out_c, b_out_c,
              peer_wq, peer_keys, peer_u, peer_v, final_g):
    P = dict(norm1_g=norm1_g, norm2_g=norm2_g, w_mod=w_mod, b_mod=b_mod, w_in_ab=w_in_ab,
             s5_a_re=s5_a_re, s5_a_im=s5_a_im, s5_log_dt=s5_log_dt, s5_b_re=s5_b_re, s5_b_im=s5_b_im,
             s5_c_re=s5_c_re, s5_c_im=s5_c_im, s5_d=s5_d, s5_w_glu=s5_w_glu, s5_b_glu=s5_b_glu,
             lru_conv_w=lru_conv_w, lru_conv_b=lru_conv_b, lru_w_a=lru_w_a, lru_b_a=lru_b_a,
             lru_w_x=lru_w_x, lru_b_x=lru_b_x, lru_lambda=lru_lambda, w_out_ab=w_out_ab,
             w_in_c=w_in_c, b_in_c=b_in_c, hy_conv_w=hy_conv_w, hy_conv_b=hy_conv_b,
             hy_w1=hy_w1, hy_b1=hy_b1, hy_freq1=hy_freq1, hy_w2=hy_w2, hy_b2=hy_b2, hy_freq2=hy_freq2,
             hy_w3=hy_w3, hy_decay=hy_decay, hy_bias=hy_bias, w_out_c=w_out_c, b_out_c=b_out_c,
             peer_wq=peer_wq, peer_keys=peer_keys, peer_u=peer_u, peer_v=peer_v, final_g=final_g)
    ctx_grid = (1, x_prompt.shape[1])
    y_prompt, (new_s5_re, new_s5_im, new_lru) = trunk(x_prompt, c_ctx[None, :], ctx_grid, P, None)
    rows = x_sample.shape[1] // GRID_W
    y_sample, _ = trunk(x_sample, c, (rows, GRID_W), P, (state_s5_re, state_s5_im, state_lru))
    return (y_prompt, y_sample, new_s5_re, new_s5_im, new_lru)
```

```cpp
#include <hip/hip_runtime.h>
#include <stdint.h>
#include <math.h>

#define D 1024
#define NTOK 16384
#define CTX_TOK 8192
#define EPSV 1e-6f

__device__ __forceinline__ int tok_cv(int t) { return t < CTX_TOK ? 0 : 1 + ((t - CTX_TOK) >> 12); }
__device__ __forceinline__ float gelu_f(float x) { float z = 1.5957691216057308f * (x + 0.044715f * x * x * x); return x / (1.f + expf(-z)); }
__device__ __forceinline__ float sigmoid_f(float x) { return 1.f / (1.f + expf(-x)); }

__global__ void k_mod(const float* c, const float* c_ctx, const float* w_mod, const float* b_mod, float* modv) {
    int idx = blockIdx.x * 256 + threadIdx.x;
    if (idx >= 2 * 3 * 6144) return;
    int n = idx % 6144, cv = (idx / 6144) % 3, l = idx / (3 * 6144);
    const float* cond = cv == 0 ? c_ctx : c + (cv - 1) * D;
    const float* w = w_mod + (size_t)l * D * 6144 + n;
    float acc = b_mod[l * 6144 + n];
    for (int k = 0; k < D; ++k) { float x = cond[k]; acc += (x / (1.f + expf(-x))) * w[(size_t)k * 6144]; }
    modv[idx] = acc;
}

__global__ void k_norm_mod(const float* x, const float* g, const float* modv_l, int sh_chunk, int sc_chunk, float* h) {
    int t = blockIdx.x; const float* xr = x + (size_t)t * D;
    __shared__ float red[256];
    float v[4]; float s = 0.f;
    for (int i = 0; i < 4; ++i) { v[i] = xr[threadIdx.x + 256 * i]; s += v[i] * v[i]; }
    red[threadIdx.x] = s; __syncthreads();
    for (int o = 128; o > 0; o >>= 1) { if (threadIdx.x < o) red[threadIdx.x] += red[threadIdx.x + o]; __syncthreads(); }
    float rstd = rsqrtf(red[0] / D + EPSV);
    const float* mv = modv_l + (size_t)tok_cv(t) * 6144;
    for (int i = 0; i < 4; ++i) { int c = threadIdx.x + 256 * i; float y = v[i] * rstd * g[c];
        if (sh_chunk >= 0) y = y * (1.f + mv[sc_chunk * D + c]) + mv[sh_chunk * D + c];
        h[(size_t)t * D + c] = y; }
}

__global__ void __launch_bounds__(256) k_sgemm(const float* A, int lda, const float* B, int ldb, const float* bias, float* C, int ldc, int M, int N, int K) {
    __shared__ float sA[16][65]; __shared__ float sB[16][64];
    int bm = blockIdx.y * 64, bn = blockIdx.x * 64; int tx = threadIdx.x & 15, ty = threadIdx.x >> 4;
    float acc[4][4] = {};
    for (int k0 = 0; k0 < K; k0 += 16) {
        for (int e = threadIdx.x; e < 64 * 16; e += 256) { int r = e >> 4, kk = e & 15; sA[kk][r] = A[(size_t)(bm + r) * lda + k0 + kk]; }
        for (int e = threadIdx.x; e < 64 * 16; e += 256) { int kk = e >> 6, cidx = e & 63; sB[kk][cidx] = B[(size_t)(k0 + kk) * ldb + bn + cidx]; }
        __syncthreads();
#pragma unroll
        for (int kk = 0; kk < 16; ++kk) { float a[4], b[4];
#pragma unroll
            for (int i = 0; i < 4; ++i) { a[i] = sA[kk][ty * 4 + i]; b[i] = sB[kk][tx * 4 + i]; }
#pragma unroll
            for (int i = 0; i < 4; ++i)
#pragma unroll
                for (int j = 0; j < 4; ++j) acc[i][j] += a[i] * b[j]; }
        __syncthreads();
    }
    for (int i = 0; i < 4; ++i) for (int j = 0; j < 4; ++j) { int r = bm + ty * 4 + i, cc = bn + tx * 4 + j; C[(size_t)r * ldc + cc] = acc[i][j] + (bias ? bias[cc] : 0.f); }
}

__global__ void k_s5_prep(const float* a_re, const float* a_im, const float* log_dt, const float* b_re, const float* b_im, float* abar, float* bbar) {
    int idx = blockIdx.x * 256 + threadIdx.x; if (idx >= 2 * 32 * 64) return;
    int dg = idx >> 6;
    double ar = a_re[idx], ai = a_im[idx], dt = exp((double)log_dt[dg]);
    double mag = exp(ar * dt), abr = mag * cos(ai * dt), abi = mag * sin(ai * dt);
    double den = ar * ar + ai * ai, nr = abr - 1.0;
    double cr = (nr * ar + abi * ai) / den, ci = (abi * ar - nr * ai) / den;
    abar[idx * 2] = (float)abr; abar[idx * 2 + 1] = (float)abi;
    for (int c = 0; c < 16; ++c) { double br = b_re[idx * 16 + c], bi = b_im[idx * 16 + c];
        bbar[(idx * 16 + c) * 2] = (float)(cr * br - ci * bi); bbar[(idx * 16 + c) * 2 + 1] = (float)(cr * bi + ci * br); }
}

__global__ void __launch_bounds__(64) k_s5_scan(const float* Z, int ldz, const float* abar, const float* bbar, const float* c_re, const float* c_im, const float* s5d,
                          const float* st_re, const float* st_im, float* Y, float* new_re, float* new_im) {
    int g = blockIdx.x & 31, seq = blockIdx.x >> 5;
    int p = threadIdx.x;
    bool ctx = seq < 32; int L = ctx ? 256 : 4096; int t0 = ctx ? seq * 256 : CTX_TOK + (seq - 32) * 4096;
    __shared__ float hs[2][64]; __shared__ float us[16];
    for (int d = 0; d < 2; ++d) {
        int q = (d * 32 + g) * 64 + p;
        float ar = abar[q * 2], ai = abar[q * 2 + 1];
        float br[16], bi[16];
        for (int c = 0; c < 16; ++c) { br[c] = bbar[(q * 16 + c) * 2]; bi[c] = bbar[(q * 16 + c) * 2 + 1]; }
        float hr = 0.f, hi = 0.f;
        if (!ctx) { int b = seq - 32; hr = st_re[((b * 2 + d) * 32 + g) * 64 + p]; hi = st_im[((b * 2 + d) * 32 + g) * 64 + p]; }
        for (int s = 0; s < L; ++s) {
            int l = d == 0 ? s : L - 1 - s; int t = t0 + l;
            if (p < 16) us[p] = Z[(size_t)t * ldz + 16 * g + p];
            __syncthreads();
            float bur = 0.f, bui = 0.f;
            for (int c = 0; c < 16; ++c) { bur += br[c] * us[c]; bui += bi[c] * us[c]; }
            float nr = ar * hr - ai * hi + bur, ni = ar * hi + ai * hr + bui; hr = nr; hi = ni;
            hs[0][p] = hr; hs[1][p] = hi;
            __syncthreads();
            if (p < 16) { float acc = 0.f; const float* cr = c_re + ((size_t)(d * 32 + g) * 16 + p) * 64; const float* ci = c_im + ((size_t)(d * 32 + g) * 16 + p) * 64;
                for (int k = 0; k < 64; ++k) acc += cr[k] * hs[0][k] - ci[k] * hs[1][k];
                size_t o = (size_t)t * 512 + 16 * g + p;
                if (d == 0) Y[o] = us[p] * s5d[16 * g + p] + acc; else Y[o] += acc; }
            __syncthreads();
        }
        if (ctx) { int b = seq; new_re[((b * 2 + d) * 32 + g) * 64 + p] = hr; new_im[((b * 2 + d) * 32 + g) * 64 + p] = hi; }
    }
}

__global__ void k_lru_conv(const float* Z, int ldz, const float* w, const float* b, float* XB) {
    int idx = blockIdx.x * 256 + threadIdx.x; int t = idx >> 9, c = idx & 511;
    int rowlen = t < CTX_TOK ? 256 : 64; int pos = (t < CTX_TOK ? t : t - CTX_TOK) % rowlen;
    float acc = b[c];
    for (int k = 0; k < 4; ++k) { int pp = pos + k - 2; if (pp >= 0 && pp < rowlen) acc += w[k * 512 + c] * Z[(size_t)(t + k - 2) * ldz + 512 + c]; }
    XB[idx] = acc;
}
__global__ void k_lru_gates(const float* XB, const float* w_a, const float* b_a, const float* w_x, const float* b_x, const float* lam, int d, float* Aout, float* Bout) {
    int idx = blockIdx.x * 256 + threadIdx.x; int t = idx >> 9, c = idx & 511; int h = c >> 6, j = c & 63;
    const float* xr = XB + (size_t)t * 512 + h * 64;
    const float* wa = w_a + ((size_t)(d * 8 + h) * 64) * 64 + j; const float* wx = w_x + ((size_t)(d * 8 + h) * 64) * 64 + j;
    float ra = b_a[d * 512 + c], rx = b_x[d * 512 + c];
    for (int i = 0; i < 64; ++i) { float x = xr[i]; ra += x * wa[i * 64]; rx += x * wx[i * 64]; }
    float r = sigmoid_f(ra), ig = sigmoid_f(rx);
    float lm = -lam[d * 512 + c]; float sp = lm > 20.f ? lm : log1pf(expf(lm));
    float log_a = -8.f * r * sp; float a = expf(log_a);
    float bb = sqrtf(-expm1f(2.f * log_a)) * (ig * XB[idx]);
    Aout[idx] = a; Bout[idx] = bb;
}
__global__ void k_lru_scan(const float* Aa, const float* Bb, const float* st_lru, int d, float* HS, float* new_lru) {
    int idx = blockIdx.x * 256 + threadIdx.x; if (idx >= 34 * 512) return; int seq = idx >> 9, c = idx & 511;
    bool ctx = seq < 32; int L = ctx ? 256 : 4096; int t0 = ctx ? seq * 256 : CTX_TOK + (seq - 32) * 4096;
    float h = 0.f; if (!ctx) h = st_lru[((seq - 32) * 2 + d) * 512 + c];
    for (int s = 0; s < L; ++s) { int l = d == 0 ? s : L - 1 - s; size_t o = (size_t)(t0 + l) * 512 + c;
        h = Aa[o] * h + Bb[o]; if (d == 0) HS[o] = h; else HS[o] += h; }
    if (ctx) new_lru[(seq * 2 + d) * 512 + c] = h;
}
__global__ void k_gelu(const float* Y, float* ZS, int n) { int i = blockIdx.x * 256 + threadIdx.x; if (i < n) ZS[i] = gelu_f(Y[i]); }
__global__ void k_mix_cat(const float* ZS, const float* GLU, const float* HS, const float* Z, int ldz, float* CAT) {
    int idx = blockIdx.x * 256 + threadIdx.x; int t = idx >> 9, c = idx & 511;
    CAT[(size_t)t * D + c] = ZS[idx] * sigmoid_f(GLU[idx]);
    CAT[(size_t)t * D + 512 + c] = HS[idx] * gelu_f(Z[(size_t)t * ldz + 1024 + c]);
}
__global__ void k_resid(const float* xin, const float* o, const float* modv_l, int gchunk, float* xout) {
    int idx = blockIdx.x * 256 + threadIdx.x; int t = idx >> 10, c = idx & 1023;
    xout[idx] = xin[idx] + modv_l[(size_t)tok_cv(t) * 6144 + gchunk * D + c] * o[idx];
}

__global__ void k_peer_scores(const float* Q, const float* keys, float* S) {
    int idx = blockIdx.x * 256 + threadIdx.x; int n = idx & 127, hp = (idx >> 7) & 15, tl = idx >> 11;
    const float* q = Q + (size_t)tl * 2048 + hp * 128; const float* k = keys + ((size_t)hp * 128 + n) * 128;
    float acc = 0.f; for (int i = 0; i < 128; ++i) acc += q[i] * k[i];
    S[idx] = acc;
}
__global__ void k_peer_top1(const float* S, float* SV, int* SI, int n_rows) {
    int r = blockIdx.x * 256 + threadIdx.x; if (r >= n_rows) return;
    const float* s = S + (size_t)r * 128; unsigned used[4] = {0, 0, 0, 0};
    for (int k = 0; k < 16; ++k) { float best = -INFINITY; int bi = 0;
        for (int n = 0; n < 128; ++n) { if ((used[n >> 5] >> (n & 31)) & 1) continue; float v = s[n]; if (v > best) { best = v; bi = n; } }
        used[bi >> 5] |= 1u << (bi & 31); SV[r * 16 + k] = best; SI[r * 16 + k] = bi; }
}
__global__ void k_peer_top2(const float* SV, const int* SI, int* EI, float* EG, int n_rows) {
    int r = blockIdx.x * 256 + threadIdx.x; if (r >= n_rows) return;
    const float* v0 = SV + (size_t)(r * 2) * 16; const float* v1 = v0 + 16; const int* i0 = SI + (size_t)(r * 2) * 16; const int* i1 = i0 + 16;
    unsigned used[8] = {0, 0, 0, 0, 0, 0, 0, 0}; float fv[16]; int fe[16];
    for (int k = 0; k < 16; ++k) { float best = -INFINITY; int bi = 0;
        for (int n = 0; n < 256; ++n) { if ((used[n >> 5] >> (n & 31)) & 1) continue; float v = v0[n >> 4] + v1[n & 15]; if (v > best) { best = v; bi = n; } }
        used[bi >> 5] |= 1u << (bi & 31); fv[k] = best; fe[k] = i0[bi >> 4] * 128 + i1[bi & 15]; }
    float mx = fv[0], sum = 0.f; for (int k = 0; k < 16; ++k) { fv[k] = expf(fv[k] - mx); sum += fv[k]; }
    for (int k = 0; k < 16; ++k) { EI[r * 16 + k] = fe[k]; EG[r * 16 + k] = fv[k] / sum; }
}
__global__ void k_peer_eval(const float* H, const int* EI, const float* EG, const float* U, const float* V, float* OUT, int t_base) {
    int tl = blockIdx.x; int t = t_base + tl; const float* x = H + (size_t)t * D;
    __shared__ float red[4]; __shared__ float coef;
    float xv[4], acc[4] = {0, 0, 0, 0};
    for (int i = 0; i < 4; ++i) xv[i] = x[threadIdx.x + 256 * i];
    for (int e = 0; e < 128; ++e) {
        int ei = EI[tl * 128 + e]; const float* u = U + (size_t)ei * D; const float* v = V + (size_t)ei * D;
        float s = 0.f; for (int i = 0; i < 4; ++i) s += xv[i] * u[threadIdx.x + 256 * i];
        for (int o = 32; o > 0; o >>= 1) s += __shfl_xor(s, o);
        if ((threadIdx.x & 63) == 0) red[threadIdx.x >> 6] = s;
        __syncthreads();
        if (threadIdx.x == 0) coef = EG[tl * 128 + e] * gelu_f(red[0] + red[1] + red[2] + red[3]);
        __syncthreads();
        float cf = coef;
        for (int i = 0; i < 4; ++i) acc[i] += cf * v[threadIdx.x + 256 * i];
        __syncthreads();
    }
    for (int i = 0; i < 4; ++i) OUT[(size_t)t * D + threadIdx.x + 256 * i] = acc[i];
}

__global__ void __launch_bounds__(64) k_hy_mlp(const float* w1, const float* b1, const float* f1, const float* w2, const float* b2, const float* f2, float* Z2, int L) {
    int pos = blockIdx.x; int j = threadIdx.x;
    __shared__ float emb[33]; __shared__ float z1[64];
    if (j < 33) { float v; if (j == 0) v = (float)pos / (float)L; else { int bi = (j - 1) & 15; float band = 1e-4f + (15.f - 1e-4f) * (float)bi / 15.f;
            float ang = (6.283185307179586f / (float)L) * (float)pos * band; v = j <= 16 ? cosf(ang) : -sinf(ang); } emb[j] = v; }
    __syncthreads();
    float a = b1[j]; for (int k = 0; k < 33; ++k) a += emb[k] * w1[k * 64 + j];
    z1[j] = sinf(f1[j] * a); __syncthreads();
    float c = b2[j]; for (int k = 0; k < 64; ++k) c += z1[k] * w2[k * 64 + j];
    Z2[(size_t)pos * 64 + j] = sinf(f2[j] * c);
}
__global__ void k_hy_filt(const float* Z2, const float* w3, const float* decay, float* F, int L) {
    int idx = blockIdx.x * 256 + threadIdx.x; int col = idx & 2047, pos = idx >> 11;
    float acc = 0.f; for (int k = 0; k < 64; ++k) acc += Z2[(size_t)pos * 64 + k] * w3[k * 2048 + col];
    float t = (float)pos / (float)L;
    F[idx] = acc * (expf(-t * fabsf(decay[col])) + 0.05f);
}
__global__ void k_hy_norm(const float* F, float* NR, int L) {
    int c = blockIdx.x * 256 + threadIdx.x; if (c >= 1024) return;
    float s = 0.f; for (int p = 0; p < L; ++p) { float a = F[(size_t)p * 2048 + c]; s += a * a; if (p >= 1) { float b = F[(size_t)p * 2048 + 1024 + c]; s += b * b; } }
    NR[c] = rsqrtf(s + EPSV);
}
__device__ __forceinline__ float hyconv1(const float* Z, const float* w, const float* b, int t, int pos, int rowlen, int c) {
    float acc = b[c];
    for (int k = 0; k < 3; ++k) { int pp = pos + k - 1; if (pp >= 0 && pp < rowlen) acc += w[k * 3072 + c] * Z[(size_t)(t + k - 1) * 3072 + c]; }
    return acc;
}
__global__ void k_hy_conv(const float* Z, const float* w, const float* b, float* VV, float* X0C) {
    int idx = blockIdx.x * 256 + threadIdx.x; int t = idx >> 10, c = idx & 1023;
    int rowlen = t < CTX_TOK ? 256 : 64; int pos = (t < CTX_TOK ? t : t - CTX_TOK) % rowlen;
    X0C[idx] = hyconv1(Z, w, b, t, pos, rowlen, c);
    VV[idx] = hyconv1(Z, w, b, t, pos, rowlen, 2048 + c) * hyconv1(Z, w, b, t, pos, rowlen, 1024 + c);
}
__global__ void k_hy_long(const float* VV, const float* X0C, const float* F256, const float* N256, const float* F4096, const float* N4096, const float* hbias, float* YY) {
    int idx = blockIdx.x * 256 + threadIdx.x; int t = idx >> 10, c = idx & 1023;
    bool ctx = t < CTX_TOK; int L = ctx ? 256 : 4096; int tt = ctx ? t : t - CTX_TOK; int l = tt % L; int t0 = t - l;
    const float* F = ctx ? F256 : F4096; float nr = ctx ? N256[c] : N4096[c];
    float acc = 0.f;
    for (int s = 0; s < L; ++s) { float vv = VV[(size_t)(t0 + s) * D + c]; int dd = l - s;
        float f = dd >= 0 ? F[(size_t)dd * 2048 + c] : F[(size_t)(-dd) * 2048 + 1024 + c]; acc += f * vv; }
    float v = VV[idx];
    YY[idx] = (acc * nr + hbias[c] * v) * X0C[idx];
}

extern "C" void kernel_launch(void* const* d_in, const int* in_sizes, int n_in, void* d_out, int out_size, void* d_ws, size_t ws_size, hipStream_t stream) {
    const float* x_prompt = (const float*)d_in[0]; const float* x_sample = (const float*)d_in[1];
    const float* st_re = (const float*)d_in[2]; const float* st_im = (const float*)d_in[3]; const float* st_lru = (const float*)d_in[4];
    const float* c = (const float*)d_in[5]; const float* c_ctx = (const float*)d_in[6];
    const float* norm1_g = (const float*)d_in[7]; const float* norm2_g = (const float*)d_in[8];
    const float* w_mod = (const float*)d_in[9]; const float* b_mod = (const float*)d_in[10]; const float* w_in_ab = (const float*)d_in[11];
    const float* s5_a_re = (const float*)d_in[12]; const float* s5_a_im = (const float*)d_in[13]; const float* s5_log_dt = (const float*)d_in[14];
    const float* s5_b_re = (const float*)d_in[15]; const float* s5_b_im = (const float*)d_in[16]; const float* s5_c_re = (const float*)d_in[17]; const float* s5_c_im = (const float*)d_in[18];
    const float* s5_d = (const float*)d_in[19]; const float* s5_w_glu = (const float*)d_in[20]; const float* s5_b_glu = (const float*)d_in[21];
    const float* lru_conv_w = (const float*)d_in[22]; const float* lru_conv_b = (const float*)d_in[23];
    const float* lru_w_a = (const float*)d_in[24]; const float* lru_b_a = (const float*)d_in[25]; const float* lru_w_x = (const float*)d_in[26]; const float* lru_b_x = (const float*)d_in[27];
    const float* lru_lambda = (const float*)d_in[28]; const float* w_out_ab = (const float*)d_in[29];
    const float* w_in_c = (const float*)d_in[30]; const float* b_in_c = (const float*)d_in[31]; const float* hy_conv_w = (const float*)d_in[32]; const float* hy_conv_b = (const float*)d_in[33];
    const float* hy_w1 = (const float*)d_in[34]; const float* hy_b1 = (const float*)d_in[35]; const float* hy_f1 = (const float*)d_in[36];
    const float* hy_w2 = (const float*)d_in[37]; const float* hy_b2 = (const float*)d_in[38]; const float* hy_f2 = (const float*)d_in[39];
    const float* hy_w3 = (const float*)d_in[40]; const float* hy_decay = (const float*)d_in[41]; const float* hy_bias = (const float*)d_in[42];
    const float* w_out_c = (const float*)d_in[43]; const float* b_out_c = (const float*)d_in[44];
    const float* peer_wq = (const float*)d_in[45]; const float* peer_keys = (const float*)d_in[46]; const float* peer_u = (const float*)d_in[47]; const float* peer_v = (const float*)d_in[48];
    const float* final_g = (const float*)d_in[49];
    float* out = (float*)d_out;
    float* y_out = out; float* new_re = out + (size_t)NTOK * D; float* new_im = new_re + 131072; float* new_lru = new_im + 131072;

    float* ws = (float*)d_ws; size_t off = 0;
    auto take = [&](size_t n) { float* p = ws + off; off += (n + 63) & ~(size_t)63; return p; };
    float* X = take((size_t)NTOK * D);
    float* H = take((size_t)NTOK * D);
    float* Z = take((size_t)NTOK * 3072);
    float* modv = take(2 * 3 * 6144);
    float* abar = take(2 * 32 * 64 * 2); float* bbar = take(2 * 32 * 64 * 16 * 2);
    float* F256 = take(256 * 2048); float* F4096 = take((size_t)4096 * 2048); float* N256 = take(1024); float* N4096 = take(1024); float* Z2 = take(4096 * 64);
    float* R = take((size_t)NTOK * 1024 * 2);
    float* Y = R; float* ZS = R + (size_t)NTOK * 512; float* GLU = ZS + (size_t)NTOK * 512; float* HS = GLU + (size_t)NTOK * 512;
    float* AA2 = Z + (size_t)NTOK * 1536; float* BB2 = AA2 + (size_t)NTOK * 512; float* XB = BB2 + (size_t)NTOK * 512;
    float* CAT = H;

    (void)hipMemcpyAsync(X, x_prompt, (size_t)CTX_TOK * D * 4, hipMemcpyDeviceToDevice, stream);
    (void)hipMemcpyAsync(X + (size_t)CTX_TOK * D, x_sample, (size_t)CTX_TOK * D * 4, hipMemcpyDeviceToDevice, stream);

    k_mod<<<(2 * 3 * 6144 + 255) / 256, 256, 0, stream>>>(c, c_ctx, w_mod, b_mod, modv);
    k_s5_prep<<<16, 256, 0, stream>>>(s5_a_re, s5_a_im, s5_log_dt, s5_b_re, s5_b_im, abar, bbar);
    for (int pass = 0; pass < 2; ++pass) { int L = pass ? 4096 : 256; float* F = pass ? F4096 : F256; float* NR = pass ? N4096 : N256;
        k_hy_mlp<<<L, 64, 0, stream>>>(hy_w1, hy_b1, hy_f1, hy_w2, hy_b2, hy_f2, Z2, L);
        k_hy_filt<<<L * 2048 / 256, 256, 0, stream>>>(Z2, hy_w3, hy_decay, F, L);
        k_hy_norm<<<4, 256, 0, stream>>>(F, NR, L); }

    auto run_peer = [&](int l, const float* Hn, float* PO) {
        float* Q = Z; float* S = Z + (size_t)4096 * 2048; float* SV = S + (size_t)4096 * 2048; int* SI = (int*)(SV + (size_t)4096 * 256);
        int* EI = SI + (size_t)4096 * 256; float* EG = (float*)(EI + (size_t)4096 * 128);
        for (int ch = 0; ch < 4; ++ch) { int tb = ch * 4096;
            k_sgemm<<<dim3(2048 / 64, 4096 / 64), 256, 0, stream>>>(Hn + (size_t)tb * D, D, peer_wq + (size_t)l * D * 2048, 2048, nullptr, Q, 2048, 4096, 2048, D);
            k_peer_scores<<<4096 * 2048 / 256, 256, 0, stream>>>(Q, peer_keys + (size_t)l * 16 * 128 * 128, S);
            k_peer_top1<<<4096 * 16 / 256, 256, 0, stream>>>(S, SV, SI, 4096 * 16);
            k_peer_top2<<<4096 * 8 / 256, 256, 0, stream>>>(SV, SI, EI, EG, 4096 * 8);
            k_peer_eval<<<4096, 256, 0, stream>>>(Hn, EI, EG, peer_u + (size_t)l * 16384 * D, peer_v + (size_t)l * 16384 * D, PO, tb); }
    };

    const float* mv0 = modv; const float* mv1 = modv + 3 * 6144;
    k_norm_mod<<<NTOK, 256, 0, stream>>>(X, norm1_g, mv0, 0, 1, H);
    k_sgemm<<<dim3(1536 / 64, NTOK / 64), 256, 0, stream>>>(H, D, w_in_ab, 1536, nullptr, Z, 1536, NTOK, 1536, D);
    k_s5_scan<<<34 * 32, 64, 0, stream>>>(Z, 1536, abar, bbar, s5_c_re, s5_c_im, s5_d, st_re, st_im, Y, new_re, new_im);
    k_lru_conv<<<NTOK * 512 / 256, 256, 0, stream>>>(Z, 1536, lru_conv_w, lru_conv_b, XB);
    for (int d = 0; d < 2; ++d) {
        k_lru_gates<<<NTOK * 512 / 256, 256, 0, stream>>>(XB, lru_w_a, lru_b_a, lru_w_x, lru_b_x, lru_lambda, d, AA2, BB2);
        k_lru_scan<<<(34 * 512 + 255) / 256, 256, 0, stream>>>(AA2, BB2, st_lru, d, HS, new_lru); }
    k_gelu<<<NTOK * 512 / 256, 256, 0, stream>>>(Y, ZS, NTOK * 512);
    k_sgemm<<<dim3(512 / 64, NTOK / 64), 256, 0, stream>>>(ZS, 512, s5_w_glu, 512, s5_b_glu, GLU, 512, NTOK, 512, 512);
    k_mix_cat<<<NTOK * 512 / 256, 256, 0, stream>>>(ZS, GLU, HS, Z, 1536, CAT);
    float* O = R;
    k_sgemm<<<dim3(D / 64, NTOK / 64), 256, 0, stream>>>(CAT, D, w_out_ab, D, nullptr, O, D, NTOK, D, D);
    k_resid<<<NTOK * D / 256, 256, 0, stream>>>(X, O, mv0, 2, X);
    k_norm_mod<<<NTOK, 256, 0, stream>>>(X, norm2_g, mv0, 3, 4, H);
    run_peer(0, H, O);
    k_resid<<<NTOK * D / 256, 256, 0, stream>>>(X, O, mv0, 5, X);
    k_norm_mod<<<NTOK, 256, 0, stream>>>(X, norm1_g + D, mv1, 0, 1, H);
    k_sgemm<<<dim3(3072 / 64, NTOK / 64), 256, 0, stream>>>(H, D, w_in_c, 3072, b_in_c, Z, 3072, NTOK, 3072, D);
    float* VV = R; float* X0C = R + (size_t)NTOK * D;
    k_hy_conv<<<NTOK * D / 256, 256, 0, stream>>>(Z, hy_conv_w, hy_conv_b, VV, X0C);
    float* YY = Z;
    k_hy_long<<<NTOK * D / 256, 256, 0, stream>>>(VV, X0C, F256, N256, F4096, N4096, hy_bias, YY);
    float* O2 = H;
    k_sgemm<<<dim3(D / 64, NTOK / 64), 256, 0, stream>>>(YY, D, w_out_c, D, b_out_c, O2, D, NTOK, D, D);
    k_resid<<<NTOK * D / 256, 256, 0, stream>>>(X, O2, mv1, 2, X);
    k_norm_mod<<<NTOK, 256, 0, stream>>>(X, norm2_g + D, mv1, 3, 4, H);
    run_peer(1, H, R);
    k_resid<<<NTOK * D / 256, 256, 0, stream>>>(X, R, mv1, 5, X);
    k_norm_mod<<<NTOK, 256, 0, stream>>>(X, final_g, mv1, -1, -1, y_out);
}
```

```cpp
#include <hip/hip_runtime.h>
#include <hip/hip_cooperative_groups.h>
#include <stdint.h>
#include <math.h>
#include <stdio.h>
namespace cg = cooperative_groups;

#define D 1024
#define NTOK 16384
#define CTX_TOK 8192
#define EPSV 1e-6f
#define NTHR 512
#define LAS __attribute__((address_space(3)))
#define GAS __attribute__((address_space(1)))

typedef unsigned short bf16_t;
typedef unsigned char uchar;
typedef short bf16x8 __attribute__((ext_vector_type(8)));
typedef float f32x4 __attribute__((ext_vector_type(4)));
typedef float f32x2 __attribute__((ext_vector_type(2)));
typedef float f32x16 __attribute__((ext_vector_type(16)));
typedef unsigned u32x4 __attribute__((ext_vector_type(4)));
typedef unsigned u32x2 __attribute__((ext_vector_type(2)));
typedef __bf16 bf16x2v __attribute__((ext_vector_type(2)));

struct MKP {
    const float *x_prompt, *x_sample, *st_re, *st_im, *st_lru, *c, *c_ctx, *norm1_g, *norm2_g, *w_mod, *b_mod, *w_in_ab,
        *s5_a_re, *s5_a_im, *s5_log_dt, *s5_b_re, *s5_b_im, *s5_c_re, *s5_c_im, *s5_d, *s5_w_glu, *s5_b_glu,
        *lru_conv_w, *lru_conv_b, *lru_w_a, *lru_b_a, *lru_w_x, *lru_b_x, *lru_lambda, *w_out_ab,
        *w_in_c, *b_in_c, *hy_conv_w, *hy_conv_b, *hy_w1, *hy_b1, *hy_f1, *hy_w2, *hy_b2, *hy_f2, *hy_w3, *hy_decay, *hy_bias, *w_out_c, *b_out_c,
        *peer_wq, *peer_keys, *peer_u, *peer_v, *final_g;
    float* out;
    float* X;
    bf16_t* Hb;
    bf16_t* Zb;
    bf16_t* CAT;
    bf16_t* ZS;
    float* HS;
    bf16_t* Qs;
    int* EI; float* EG;
    bf16_t *X0C, *VG, *VT, *YT;
    bf16_t *Ub, *Vb;
    bf16_t *WinT, *WgluT, *WoutT, *WincT, *WoutcT, *WqT, *Keysb, *WaT, *WxT;
    bf16_t *Bmat, *CmT; float *abar, *aL;
    float *S5car;
    float *LRUcar;
    float *modv;
    float *Z2;
    float *NORMSQ;
    bf16_t *Rf;
    int stop_after; int pad0;
};

__device__ __forceinline__ float bf2f(bf16_t v) { return __uint_as_float((unsigned)v << 16); }
__device__ __forceinline__ float bflo(unsigned p) { return __uint_as_float(p << 16); }
__device__ __forceinline__ float bfhi(unsigned p) { return __uint_as_float(p & 0xffff0000u); }
__device__ __forceinline__ unsigned pk_bf16(float lo, float hi) { const f32x2 v = {lo, hi}; const bf16x2v r = __builtin_convertvector(v, bf16x2v); return __builtin_bit_cast(unsigned, r); }
__device__ __forceinline__ bf16_t f2bf(float x) { return (bf16_t)(pk_bf16(x, 0.f) & 0xffffu); }
__device__ __forceinline__ float sigmoid_f(float x) { return 1.f / (1.f + __expf(-x)); }
__device__ __forceinline__ float gelu_f(float x) { float z = 1.5957691216057308f * (x + 0.044715f * x * x * x); return x / (1.f + __expf(-z)); }
__device__ __forceinline__ float silu_f(float x) { return x / (1.f + __expf(-x)); }
__device__ __forceinline__ int tok_cv(int t) { return t < CTX_TOK ? 0 : 1 + ((t - CTX_TOK) >> 12); }
__device__ __forceinline__ const float* xin_row(const MKP& p, int t) { return t < CTX_TOK ? p.x_prompt + (size_t)t * D : p.x_sample + (size_t)(t - CTX_TOK) * D; }
__device__ __forceinline__ float wave_sum(float v) {
#pragma unroll
    for (int o = 32; o > 0; o >>= 1) v += __shfl_xor(v, o);
    return v;
}
__device__ __forceinline__ void glds16(const void* g, LAS uchar* l) { __builtin_amdgcn_global_load_lds((const GAS void*)g, (LAS void*)l, 16, 0, 0); }

template <int BN, class Epi>
__device__ __forceinline__ void gemm_tile(const bf16_t* A, int lda, const bf16_t* Bt, int ldb, int K, int m0, int n0, LAS uchar* lds, Epi& epi) {
    constexpr int NW = BN / 64;
    constexpr int STAGE = 256 * 128 + BN * 128;
    int tid = threadIdx.x; asm volatile("" : "+v"(tid));
    const int wid = tid >> 6, lane = tid & 63, wr = wid >> 2, wc = wid & 3, fr = lane & 15, fq = lane >> 4;
    f32x4 acc[8][NW];
#pragma unroll
    for (int m = 0; m < 8; ++m)
#pragma unroll
        for (int n = 0; n < NW; ++n) acc[m][n] = (f32x4){0.f, 0.f, 0.f, 0.f};
    const int nk = K >> 6;
    const int srow = lane >> 3, sc = lane & 7;
    auto stage = [&](int kt, int buf) {
        LAS uchar* sb = lds + buf * STAGE;
#pragma unroll
        for (int j = 0; j < 4; ++j) { const int rowl = 8 * (wid + 8 * j) + srow; const int c = sc ^ ((rowl >> 1) & 7);
            glds16(A + (size_t)(m0 + rowl) * lda + kt * 64 + c * 8, sb + rowl * 128 + sc * 16); }
#pragma unroll
        for (int j = 0; j < BN / 64; ++j) { const int rowl = 8 * (wid + 8 * j) + srow; const int c = sc ^ ((rowl >> 1) & 7);
            glds16(Bt + (size_t)(n0 + rowl) * ldb + kt * 64 + c * 8, sb + 32768 + rowl * 128 + sc * 16); }
    };
    __syncthreads();
    stage(0, 0);
    for (int kt = 0; kt < nk; ++kt) {
        asm volatile("s_waitcnt vmcnt(0)" ::: "memory");
        __syncthreads();
        if (kt + 1 < nk) stage(kt + 1, (kt + 1) & 1);
        const LAS uchar* sa = lds + (kt & 1) * STAGE;
        const LAS uchar* sbp = sa + 32768;
#pragma unroll
        for (int kk = 0; kk < 2; ++kk) {
            const int cs = ((kk * 4 + fq) ^ (fr >> 1)) * 16;
            bf16x8 bfr[NW];
#pragma unroll
            for (int n = 0; n < NW; ++n) bfr[n] = *(const LAS bf16x8*)(sbp + (wc * (BN / 4) + n * 16 + fr) * 128 + cs);
#pragma unroll
            for (int mh = 0; mh < 2; ++mh) {
                bf16x8 af[4];
#pragma unroll
                for (int m = 0; m < 4; ++m) af[m] = *(const LAS bf16x8*)(sa + (wr * 128 + (4 * mh + m) * 16 + fr) * 128 + cs);
#pragma unroll
                for (int m = 0; m < 4; ++m)
#pragma unroll
                    for (int n = 0; n < NW; ++n) acc[4 * mh + m][n] = __builtin_amdgcn_mfma_f32_16x16x32_bf16(bfr[n], af[m], acc[4 * mh + m][n], 0, 0, 0);
            }
        }
    }
#pragma unroll
    for (int m = 0; m < 8; ++m)
#pragma unroll
        for (int n = 0; n < NW; ++n) epi(acc[m][n], m0 + wr * 128 + m * 16 + fr, n0 + wc * (BN / 4) + n * 16 + 4 * fq);
}

struct EpiStoreBf16 {
    bf16_t* O; int ldc; const float* bias;
    __device__ __forceinline__ void operator()(const f32x4& v, int row, int col) const {
        f32x4 b = bias ? *(const f32x4*)(bias + col) : (f32x4){0.f, 0.f, 0.f, 0.f};
        u32x2 w; w.x = pk_bf16(v[0] + b[0], v[1] + b[1]); w.y = pk_bf16(v[2] + b[2], v[3] + b[3]);
        *(u32x2*)(O + (size_t)row * ldc + col) = w;
    }
};
struct EpiGlu {
    const bf16_t* ZS; bf16_t* CAT; const float* bias;
    __device__ __forceinline__ void operator()(const f32x4& v, int row, int col) const {
        f32x4 b = *(const f32x4*)(bias + col); u32x2 z = *(const u32x2*)(ZS + (size_t)row * 512 + col);
        float o0 = bflo(z.x) * sigmoid_f(v[0] + b[0]), o1 = bfhi(z.x) * sigmoid_f(v[1] + b[1]), o2 = bflo(z.y) * sigmoid_f(v[2] + b[2]), o3 = bfhi(z.y) * sigmoid_f(v[3] + b[3]);
        u32x2 w; w.x = pk_bf16(o0, o1); w.y = pk_bf16(o2, o3);
        *(u32x2*)(CAT + (size_t)row * D + col) = w;
    }
};
struct EpiResid {
    const MKP* p; bool from_input; const float* gate;   const float* bias;
    __device__ __forceinline__ void operator()(const f32x4& v, int row, int col) const {
        const float* xr = from_input ? xin_row(*p, row) : p->X + (size_t)row * D;
        f32x4 x = *(const f32x4*)(xr + col); f32x4 g = *(const f32x4*)(gate + (size_t)tok_cv(row) * 6144 + col);
        f32x4 b = bias ? *(const f32x4*)(bias + col) : (f32x4){0.f, 0.f, 0.f, 0.f};
        f32x4 o; o[0] = x[0] + g[0] * (v[0] + b[0]); o[1] = x[1] + g[1] * (v[1] + b[1]); o[2] = x[2] + g[2] * (v[2] + b[2]); o[3] = x[3] + g[3] * (v[3] + b[3]);
        *(f32x4*)(p->X + (size_t)row * D + col) = o;
    }
};

template <int BN, class Epi>
__device__ __forceinline__ void gemm_phase(const bf16_t* A, int lda, const bf16_t* Bt, int ldb, int K, int M, int N, LAS uchar* lds, Epi& epi) {
    const int nM = M / 256, nN = N / BN, nt = nM * nN;
    for (int t = blockIdx.x; t < nt; t += gridDim.x) { const int pn = t % nN, pm = t / nN; gemm_tile<BN>(A, lda, Bt, ldb, K, pm * 256, pn * BN, lds, epi); }
}

__device__ __forceinline__ void transpose_tile(const float* src, int K, int N, bf16_t* dst, int k0, int n0, LAS uchar* lds) {
    LAS float* tl = (LAS float*)lds;
    int tid = threadIdx.x; asm volatile("" : "+v"(tid));
    __syncthreads();
#pragma unroll
    for (int i = 0; i < 8; ++i) { const int e = tid + NTHR * i, kr = e >> 6, nc = e & 63; tl[nc * 65 + kr] = src[(size_t)(k0 + kr) * N + n0 + nc]; }
    __syncthreads();
#pragma unroll
    for (int i = 0; i < 4; ++i) { const int e = tid + NTHR * i, nr = e >> 5, kp = e & 31;
        *(unsigned*)(dst + (size_t)(n0 + nr) * K + k0 + 2 * kp) = pk_bf16(tl[nr * 65 + 2 * kp], tl[nr * 65 + 2 * kp + 1]); }
}

__device__ __forceinline__ void phase0(const MKP& p, LAS uchar* lds) {
    int tid = threadIdx.x; asm volatile("" : "+v"(tid));
    const int bid = blockIdx.x, G = gridDim.x, wid = tid >> 6, lane = tid & 63;
    const int gtid = bid * NTHR + tid, gthreads = G * NTHR;
    {
        LAS float* sc = (LAS float*)lds;
        LAS float* red = (LAS float*)(lds + 12288);
        bool have = false;
        for (int it = bid; it < 192; it += G) {
            if (!have) { for (int i = tid; i < 3072; i += NTHR) { const int cv = i >> 10, k = i & 1023; const float x = cv == 0 ? p.c_ctx[k] : p.c[(cv - 1) * D + k]; sc[i] = silu_f(x); } have = true; }
            __syncthreads();
            const int l = it / 96, cgp = it % 96, col = cgp * 64 + lane;
            const float* w = p.w_mod + (size_t)l * D * 6144 + col;
            float a0 = 0.f, a1 = 0.f, a2 = 0.f;
#pragma unroll 8
            for (int k = wid * 128; k < wid * 128 + 128; ++k) { const float wv = w[(size_t)k * 6144]; a0 += sc[k] * wv; a1 += sc[1024 + k] * wv; a2 += sc[2048 + k] * wv; }
            red[(wid * 3 + 0) * 64 + lane] = a0; red[(wid * 3 + 1) * 64 + lane] = a1; red[(wid * 3 + 2) * 64 + lane] = a2;
            __syncthreads();
            if (tid < 192) { const int cv = tid >> 6, ln = tid & 63; float s = p.b_mod[l * 6144 + cgp * 64 + ln];
#pragma unroll
                for (int w8 = 0; w8 < 8; ++w8) s += red[(w8 * 3 + cv) * 64 + ln];
                p.modv[(l * 3 + cv) * 6144 + cgp * 64 + ln] = s; }
        }
        __syncthreads();
    }
    {
        const int ntiles[8] = {384, 64, 256, 768, 256, 512, 512, 32};
        int base = 0;
        for (int mi = 0; mi < 8; ++mi) {
            const float* src; int K, N; bf16_t* dst;
            switch (mi) {
                case 0: src = p.w_in_ab; K = 1024; N = 1536; dst = p.WinT; break;
                case 1: src = p.s5_w_glu; K = 512; N = 512; dst = p.WgluT; break;
                case 2: src = p.w_out_ab; K = 1024; N = 1024; dst = p.WoutT; break;
                case 3: src = p.w_in_c; K = 1024; N = 3072; dst = p.WincT; break;
                case 4: src = p.w_out_c; K = 1024; N = 1024; dst = p.WoutcT; break;
                case 5: src = p.peer_wq; K = 1024; N = 2048; dst = p.WqT; break;
                case 6: src = p.peer_wq + (size_t)1024 * 2048; K = 1024; N = 2048; dst = p.WqT + (size_t)2048 * 1024; break;
                default: src = nullptr; K = 64; N = 64; dst = nullptr; break;
            }
            for (int t = (bid + G - (base % G)) % G; t < ntiles[mi]; t += G) {
                if (mi < 7) { const int nkt = K / 64; const int kt = t % nkt, nt = t / nkt; transpose_tile(src, K, N, dst, kt * 64, nt * 64, lds); }
                else { const int m = t & 15; const bool isx = t >= 16;
                    transpose_tile((isx ? p.lru_w_x : p.lru_w_a) + (size_t)m * 4096, 64, 64, (isx ? p.WxT : p.WaT) + (size_t)m * 4096, 0, 0, lds); }
            }
            base += ntiles[mi];
        }
        __syncthreads();
    }
    {
        auto conv = [&](const float* src, bf16_t* dst, size_t n8) {
            for (size_t i = gtid; i < n8; i += gthreads) { const f32x4 a = *(const f32x4*)(src + i * 8), b = *(const f32x4*)(src + i * 8 + 4);
                u32x4 w; w.x = pk_bf16(a[0], a[1]); w.y = pk_bf16(a[2], a[3]); w.z = pk_bf16(b[0], b[1]); w.w = pk_bf16(b[2], b[3]);
                *(u32x4*)(dst + i * 8) = w; }
        };
        conv(p.peer_keys, p.Keysb, (size_t)2 * 16 * 128 * 128 / 8);
        conv(p.peer_u, p.Ub, (size_t)2 * 16384 * 1024 / 8);
        conv(p.peer_v, p.Vb, (size_t)2 * 16384 * 1024 / 8);
    }
    if (gtid < 4096) {
        const int idx = gtid, dg = idx >> 6, pp = idx & 63;
        const double ar = p.s5_a_re[idx], ai = p.s5_a_im[idx], dt = exp((double)p.s5_log_dt[dg]);
        const double mag = exp(ar * dt), abr = mag * cos(ai * dt), abi = mag * sin(ai * dt);
        const double den = ar * ar + ai * ai, nr = abr - 1.0;
        const double cr = (nr * ar + abi * ai) / den, ci = (abi * ar - nr * ai) / den;
        p.abar[idx * 2] = (float)abr; p.abar[idx * 2 + 1] = (float)abi;
        const double m256 = exp(256.0 * ar * dt), a256 = fmod(256.0 * ai * dt, 6.283185307179586476925);
        p.aL[idx * 2] = (float)(m256 * cos(a256)); p.aL[idx * 2 + 1] = (float)(m256 * sin(a256));
        for (int c = 0; c < 16; ++c) { const double br = p.s5_b_re[idx * 16 + c], bi = p.s5_b_im[idx * 16 + c];
            p.Bmat[((size_t)dg * 128 + 2 * pp) * 16 + c] = f2bf((float)(cr * br - ci * bi));
            p.Bmat[((size_t)dg * 128 + 2 * pp + 1) * 16 + c] = f2bf((float)(cr * bi + ci * br));
            p.CmT[((size_t)dg * 16 + c) * 128 + 2 * pp] = f2bf(p.s5_c_re[((size_t)dg * 16 + c) * 64 + pp]);
            p.CmT[((size_t)dg * 16 + c) * 128 + 2 * pp + 1] = f2bf(-p.s5_c_im[((size_t)dg * 16 + c) * 64 + pp]); }
    }
    for (int pi = bid * 8 + wid; pi < 4352; pi += G * 8) {
        const int L = pi < 256 ? 256 : 4096, pos = pi < 256 ? pi : pi - 256; const int j = lane;
        float emb = 0.f;
        if (j == 0) emb = (float)pos / (float)L;
        else if (j < 33) { const int bi = (j - 1) & 15; const float band = 1e-4f + (15.f - 1e-4f) * (float)bi / 15.f;
            const float ang = (6.283185307179586f / (float)L) * (float)pos * band; emb = j <= 16 ? cosf(ang) : -sinf(ang); }
        float a = p.hy_b1[j];
        for (int k = 0; k < 33; ++k) a += __shfl(emb, k) * p.hy_w1[k * 64 + j];
        const float z1 = sinf(p.hy_f1[j] * a);
        float c2 = p.hy_b2[j];
        for (int k = 0; k < 64; ++k) c2 += __shfl(z1, k) * p.hy_w2[k * 64 + j];
        p.Z2[(size_t)pi * 64 + j] = sinf(p.hy_f2[j] * c2);
    }
    if (gtid < 2048) p.NORMSQ[gtid] = 0.f;
}

__device__ __forceinline__ void norm_one(const MKP& p, const float* xr, int t, const float* gvec, const float* modv_l, int sh_chunk, int sc_chunk, bf16_t* hout, float* fout, int lane) {
    f32x4 v[4]; float s = 0.f;
#pragma unroll
    for (int i = 0; i < 4; ++i) { v[i] = *(const f32x4*)(xr + 4 * lane + 256 * i); s += v[i][0] * v[i][0] + v[i][1] * v[i][1] + v[i][2] * v[i][2] + v[i][3] * v[i][3]; }
    s = wave_sum(s);
    const float rstd = rsqrtf(s * (1.f / D) + EPSV);
    const float* mv = modv_l + (size_t)tok_cv(t) * 6144;
#pragma unroll
    for (int i = 0; i < 4; ++i) { const int c = 4 * lane + 256 * i; const f32x4 g = *(const f32x4*)(gvec + c);
        f32x4 y; y[0] = v[i][0] * rstd * g[0]; y[1] = v[i][1] * rstd * g[1]; y[2] = v[i][2] * rstd * g[2]; y[3] = v[i][3] * rstd * g[3];
        if (hout) { const f32x4 sc = *(const f32x4*)(mv + sc_chunk * D + c), sh = *(const f32x4*)(mv + sh_chunk * D + c);
            u32x2 w; w.x = pk_bf16(y[0] * (1.f + sc[0]) + sh[0], y[1] * (1.f + sc[1]) + sh[1]); w.y = pk_bf16(y[2] * (1.f + sc[2]) + sh[2], y[3] * (1.f + sc[3]) + sh[3]);
            *(u32x2*)(hout + (size_t)t * D + c) = w; }
        else *(f32x4*)(fout + (size_t)t * D + c) = y; }
}
__device__ __forceinline__ void norm_phase(const MKP& p, bool from_input, const float* gvec, const float* modv_l, int sh_chunk, int sc_chunk, bf16_t* hout) {
    int tid = threadIdx.x; asm volatile("" : "+v"(tid));
    const int wid = tid >> 6, lane = tid & 63;
    for (int t = blockIdx.x * 8 + wid; t < NTOK; t += gridDim.x * 8)
        norm_one(p, from_input ? xin_row(p, t) : p.X + (size_t)t * D, t, gvec, modv_l, sh_chunk, sc_chunk, hout, nullptr, lane);
}

__device__ __forceinline__ void hyfilt_phase(const MKP& p, LAS uchar* lds) {
    LAS float* z2 = (LAS float*)lds;
    int tid = threadIdx.x; asm volatile("" : "+v"(tid));
    for (int it = blockIdx.x; it < 544; it += gridDim.x) {
        const bool big = it >= 32; const int L = big ? 4096 : 256; const int p0 = (big ? it - 32 : it) * 8; const int pbase = (big ? 256 : 0) + p0;
        __syncthreads();
        z2[tid] = p.Z2[(size_t)pbase * 64 + tid];
        __syncthreads();
        const int col0 = 4 * tid;
        f32x4 acc[8];
#pragma unroll
        for (int q = 0; q < 8; ++q) acc[q] = (f32x4){0.f, 0.f, 0.f, 0.f};
        for (int k = 0; k < 64; ++k) { const f32x4 w = *(const f32x4*)(p.hy_w3 + (size_t)k * 2048 + col0);
#pragma unroll
            for (int q = 0; q < 8; ++q) { const float z = z2[q * 64 + k]; acc[q][0] += z * w[0]; acc[q][1] += z * w[1]; acc[q][2] += z * w[2]; acc[q][3] += z * w[3]; } }
        const f32x4 dec = *(const f32x4*)(p.hy_decay + col0);
        const int dir = col0 >> 10, ch0 = col0 & 1023;
        bf16_t* R = p.Rf + (big ? (size_t)1024 * 512 : 0);
        const int RL = 2 * L;
        float ss[4] = {0.f, 0.f, 0.f, 0.f};
#pragma unroll
        for (int q = 0; q < 8; ++q) { const int pos = p0 + q; const float tt = (float)pos / (float)L;
#pragma unroll
            for (int e = 0; e < 4; ++e) { const float val = acc[q][e] * (__expf(-tt * fabsf(dec[e])) + 0.05f);
                if (dir == 0) { ss[e] += val * val; R[(size_t)(ch0 + e) * RL + (L - 1 - pos)] = f2bf(val); }
                else if (pos >= 1) { ss[e] += val * val; R[(size_t)(ch0 + e) * RL + (L - 1 + pos)] = f2bf(val); } } }
#pragma unroll
        for (int e = 0; e < 4; ++e) unsafeAtomicAdd(p.NORMSQ + (big ? 1024 : 0) + ch0 + e, ss[e]);
    }
}

#define S5ROW 528
__device__ __forceinline__ void s5_task(const MKP& p, int seqid, int g, int seg, int mode, LAS uchar* wl, int lane) {
    asm volatile("" : "+v"(lane));
    const bool ctx = seqid < 32; const int b = ctx ? seqid : seqid - 32;
    const int t0 = ctx ? seqid * 256 : CTX_TOK + b * 4096 + seg * 256;
    const int r = lane & 31, hh = lane >> 5, fr = lane & 15, fq = lane >> 4;
    const bool full = ctx || mode == 1;
    f32x4 yacc[16];
#pragma unroll
    for (int i = 0; i < 16; ++i) yacc[i] = (f32x4){0.f, 0.f, 0.f, 0.f};
#pragma unroll
    for (int d = 0; d < 2; ++d) {
        const int dg = d * 32 + g;
        bf16x8 bm[4], cm[4];
#pragma unroll
        for (int nt = 0; nt < 4; ++nt) bm[nt] = *(const bf16x8*)(p.Bmat + ((size_t)dg * 128 + 32 * nt + r) * 16 + 8 * hh);
#pragma unroll
        for (int ks = 0; ks < 4; ++ks) cm[ks] = *(const bf16x8*)(p.CmT + ((size_t)dg * 16 + fr) * 128 + 32 * ks + 8 * fq);
        const float ar = p.abar[(dg * 64 + lane) * 2], ai = p.abar[(dg * 64 + lane) * 2 + 1];
        float hr = 0.f, hi = 0.f;
        if (!ctx && mode == 1) {
            hr = p.st_re[((b * 2 + d) * 32 + g) * 64 + lane]; hi = p.st_im[((b * 2 + d) * 32 + g) * 64 + lane];
            const float lr = p.aL[(dg * 64 + lane) * 2], li = p.aL[(dg * 64 + lane) * 2 + 1];
            const float* car = p.S5car + ((size_t)((b * 2 + d) * 32 + g) * 16) * 128;
            if (d == 0) { for (int s = 0; s < seg; ++s) { const float sr = car[s * 128 + lane * 2], si = car[s * 128 + lane * 2 + 1]; const float nr = lr * hr - li * hi + sr, ni = lr * hi + li * hr + si; hr = nr; hi = ni; } }
            else { for (int s = 15; s > seg; --s) { const float sr = car[s * 128 + lane * 2], si = car[s * 128 + lane * 2 + 1]; const float nr = lr * hr - li * hi + sr, ni = lr * hi + li * hr + si; hr = nr; hi = ni; } }
        }
#pragma unroll
        for (int step = 0; step < 8; ++step) {
            asm volatile("" ::: "memory");
            const int sb = d == 0 ? step : 7 - step; const int tb = t0 + 32 * sb;
            const bf16x8 uf = *(const bf16x8*)(p.Zb + (size_t)(tb + r) * 1536 + 16 * g + 8 * hh);
#pragma unroll
            for (int nt = 0; nt < 4; ++nt) {
                f32x16 dd = {0.f, 0.f, 0.f, 0.f, 0.f, 0.f, 0.f, 0.f, 0.f, 0.f, 0.f, 0.f, 0.f, 0.f, 0.f, 0.f};
                dd = __builtin_amdgcn_mfma_f32_32x32x16_bf16(bm[nt], uf, dd, 0, 0, 0);
#pragma unroll
                for (int q = 0; q < 4; ++q) { f32x4 w = {dd[4 * q], dd[4 * q + 1], dd[4 * q + 2], dd[4 * q + 3]};
                    *(LAS f32x4*)(wl + r * S5ROW + (32 * nt + 8 * q + 4 * hh) * 4) = w; }
            }
#pragma unroll 4
            for (int jj = 0; jj < 32; ++jj) { const int j = d == 0 ? jj : 31 - jj;
                const f32x2 bu = *(const LAS f32x2*)(wl + j * S5ROW + 8 * lane);
                const float nr = ar * hr - ai * hi + bu[0], ni = ar * hi + ai * hr + bu[1]; hr = nr; hi = ni;
                if (full) *(LAS unsigned*)(wl + j * S5ROW + 4 * lane) = pk_bf16(hr, hi); }
            if (full) {
#pragma unroll
                for (int mt = 0; mt < 2; ++mt) {
#pragma unroll
                    for (int ks = 0; ks < 4; ++ks) { const bf16x8 hf = *(const LAS bf16x8*)(wl + (16 * mt + fr) * S5ROW + 64 * ks + 16 * fq);
                        yacc[sb * 2 + mt] = __builtin_amdgcn_mfma_f32_16x16x32_bf16(cm[ks], hf, yacc[sb * 2 + mt], 0, 0, 0); }
                    if (d == 0) {
                        bf16x8 df = {0, 0, 0, 0, 0, 0, 0, 0}, uf2 = {0, 0, 0, 0, 0, 0, 0, 0};
                        if (fq < 2) { uf2 = *(const bf16x8*)(p.Zb + (size_t)(tb + 16 * mt + fr) * 1536 + 16 * g + 8 * fq);
                            const bf16_t dv = f2bf(p.s5_d[16 * g + fr]);
#pragma unroll
                            for (int j = 0; j < 8; ++j) df[j] = (8 * fq + j == fr) ? (short)dv : (short)0; }
                        yacc[sb * 2 + mt] = __builtin_amdgcn_mfma_f32_16x16x32_bf16(df, uf2, yacc[sb * 2 + mt], 0, 0, 0);
                    }
                }
            }
        }
        if (ctx) { float* nre = p.out + (size_t)NTOK * D; float* nim = nre + 131072;
            nre[((b * 2 + d) * 32 + g) * 64 + lane] = hr; nim[((b * 2 + d) * 32 + g) * 64 + lane] = hi; }
        else if (mode == 0) { float* car = p.S5car + ((size_t)((b * 2 + d) * 32 + g) * 16 + seg) * 128; car[lane * 2] = hr; car[lane * 2 + 1] = hi; }
    }
    if (full) {
#pragma unroll
        for (int tl = 0; tl < 16; ++tl) { const int t = t0 + 16 * tl + fr; const f32x4 y = yacc[tl];
            u32x2 w; w.x = pk_bf16(gelu_f(y[0]), gelu_f(y[1])); w.y = pk_bf16(gelu_f(y[2]), gelu_f(y[3]));
            *(u32x2*)(p.ZS + (size_t)t * 512 + 16 * g + 4 * fq) = w; }
    }
}

#define LRU_XA 144
#define LRU_G 528
__device__ __forceinline__ void lru_task(const MKP& p, int seqid, int h, int seg, int mode, LAS uchar* wl, int lane) {
    asm volatile("" : "+v"(lane));
    const bool ctx = seqid < 32; const int b = ctx ? seqid : seqid - 32;
    const int seqbase = ctx ? seqid * 256 : CTX_TOK + b * 4096;
    const int t0 = seqbase + (ctx ? 0 : seg * 256);
    const int rowlen = ctx ? 256 : 64;
    const int fr = lane & 15, fq = lane >> 4;
    const bool full = ctx || mode == 1;
    const int ch = 64 * h + lane;
    const float cw0 = p.lru_conv_w[ch], cw1 = p.lru_conv_w[512 + ch], cw2 = p.lru_conv_w[1024 + ch], cw3 = p.lru_conv_w[1536 + ch], cb = p.lru_conv_b[ch];
    LAS uchar* xa = wl; LAS uchar* gl = wl + 16 * LRU_XA;
#pragma unroll
    for (int d = 0; d < 2; ++d) {
        bf16x8 wa[4][2], wx[4][2];
#pragma unroll
        for (int nt = 0; nt < 4; ++nt)
#pragma unroll
            for (int ks = 0; ks < 2; ++ks) { const size_t o = ((size_t)(d * 8 + h) * 64 + 16 * nt + fr) * 64 + 32 * ks + 8 * fq;
                wa[nt][ks] = *(const bf16x8*)(p.WaT + o); wx[nt][ks] = *(const bf16x8*)(p.WxT + o); }
        const float ba = p.lru_b_a[d * 512 + ch], bx = p.lru_b_x[d * 512 + ch];
        const float lm = -p.lru_lambda[d * 512 + ch]; const float sp = lm > 20.f ? lm : log1pf(expf(lm));
        float hst = 0.f, aprod = 1.f;
        if (!ctx && mode == 1) {
            hst = p.st_lru[(b * 2 + d) * 512 + ch];
            const float* car = p.LRUcar + (size_t)((b * 2 + d) * 16) * 1024;
            if (d == 0) { for (int s = 0; s < seg; ++s) hst = car[s * 1024 + ch * 2] * hst + car[s * 1024 + ch * 2 + 1]; }
            else { for (int s = 15; s > seg; --s) hst = car[s * 1024 + ch * 2] * hst + car[s * 1024 + ch * 2 + 1]; }
        }
        for (int step = 0; step < 16; ++step) {
            const int sb = d == 0 ? step : 15 - step; const int tb = t0 + 16 * sb;
            const int rs = seqbase + ((tb - seqbase) / rowlen) * rowlen, re = rs + rowlen;
            float xr[19];
#pragma unroll
            for (int i = 0; i < 19; ++i) { const int tt = tb - 2 + i; xr[i] = (tt >= rs && tt < re) ? bf2f(p.Zb[(size_t)tt * 1536 + 512 + ch]) : 0.f; }
            float xb[16];
#pragma unroll
            for (int j = 0; j < 16; ++j) { xb[j] = cb + cw0 * xr[j] + cw1 * xr[j + 1] + cw2 * xr[j + 2] + cw3 * xr[j + 3];
                *(LAS bf16_t*)(xa + j * LRU_XA + 2 * lane) = f2bf(xb[j]); }
            bf16x8 xf[2];
#pragma unroll
            for (int ks = 0; ks < 2; ++ks) xf[ks] = *(const LAS bf16x8*)(xa + fr * LRU_XA + 64 * ks + 16 * fq);
#pragma unroll
            for (int nt = 0; nt < 4; ++nt) {
                f32x4 da = {0.f, 0.f, 0.f, 0.f}, dx = {0.f, 0.f, 0.f, 0.f};
#pragma unroll
                for (int ks = 0; ks < 2; ++ks) { da = __builtin_amdgcn_mfma_f32_16x16x32_bf16(wa[nt][ks], xf[ks], da, 0, 0, 0); dx = __builtin_amdgcn_mfma_f32_16x16x32_bf16(wx[nt][ks], xf[ks], dx, 0, 0, 0); }
                *(LAS f32x4*)(gl + fr * LRU_G + (16 * nt + 4 * fq) * 4) = da;
                *(LAS f32x4*)(gl + fr * LRU_G + 256 + (16 * nt + 4 * fq) * 4) = dx;
            }
            float av[16], bv[16];
#pragma unroll
            for (int j = 0; j < 16; ++j) { const float ra = *(const LAS float*)(gl + j * LRU_G + 4 * lane) + ba, rx = *(const LAS float*)(gl + j * LRU_G + 256 + 4 * lane) + bx;
                const float rg = sigmoid_f(ra), ig = sigmoid_f(rx); const float la = -8.f * rg * sp; av[j] = __expf(la);
                bv[j] = sqrtf(-expm1f(2.f * la)) * (ig * xb[j]); }
#pragma unroll
            for (int jj = 0; jj < 16; ++jj) { const int j = d == 0 ? jj : 15 - jj; hst = av[j] * hst + bv[j]; aprod *= av[j]; bv[j] = hst; }
            if (full) {
#pragma unroll
                for (int j = 0; j < 16; ++j) { const size_t t = tb + j;
                    if (d == 0) p.HS[t * 512 + ch] = bv[j];
                    else { const float hsum = p.HS[t * 512 + ch] + bv[j]; const float xg = bf2f(p.Zb[t * 1536 + 1024 + ch]);
                        p.CAT[t * D + 512 + ch] = f2bf(hsum * gelu_f(xg)); } }
            }
        }
        asm volatile("s_waitcnt vmcnt(0)" ::: "memory");
        if (ctx) { float* nl = p.out + (size_t)NTOK * D + 262144; nl[(b * 2 + d) * 512 + ch] = hst; }
        else if (mode == 0) { float* car = p.LRUcar + (size_t)((b * 2 + d) * 16 + seg) * 1024; car[ch * 2] = aprod; car[ch * 2 + 1] = hst; }
    }
}

__device__ __forceinline__ void scan_phase(const MKP& p, int pass, LAS uchar* lds) {
    int tid = threadIdx.x; asm volatile("" : "+v"(tid));
    const int wid = tid >> 6, lane = tid & 63;
    LAS uchar* wl = lds + wid * 20480;
    for (int task = blockIdx.x * 8 + wid; task < 1920; task += gridDim.x * 8) {
        int seqid, gh, seg, mode;
        if (task < 1024) { seqid = 32 + (task >> 9); seg = (task >> 5) & 15; gh = task & 31; mode = pass; }
        else if (task < 1536) { const int i = (task - 1024) + pass * 512; seqid = i >> 5; gh = i & 31; seg = 0; mode = 1; }
        else if (task < 1792) { const int i = task - 1536; seqid = 32 + (i >> 7); seg = (i >> 3) & 15; gh = i & 7; mode = pass; }
        else { const int i = (task - 1792) + pass * 128; seqid = i >> 3; gh = i & 7; seg = 0; mode = 1; }
        if (task < 1536) s5_task(p, seqid, gh, seg, mode, wl, lane);
        else lru_task(p, seqid, gh, seg, mode, wl, lane);
    }
}

__device__ __forceinline__ unsigned f2key(float f) { const unsigned u = __float_as_uint(f); return u ^ ((unsigned)((int)u >> 31) | 0x80000000u); }
template <int CTRL> __device__ __forceinline__ unsigned dppu(unsigned x) { return (unsigned)__builtin_amdgcn_update_dpp(0, (int)x, CTRL, 0xf, 0xf, false); }
template <int CTRL> __device__ __forceinline__ float dppf(float x) { return __int_as_float(__builtin_amdgcn_update_dpp(0, __float_as_int(x), CTRL, 0xf, 0xf, false)); }
__device__ __forceinline__ unsigned rowmax_u(unsigned x) { unsigned t; t = dppu<0x121>(x); x = x > t ? x : t; t = dppu<0x122>(x); x = x > t ? x : t; t = dppu<0x124>(x); x = x > t ? x : t; t = dppu<0x128>(x); x = x > t ? x : t; return x; }
__device__ __forceinline__ float rowmax_f(float x) { x = fmaxf(x, dppf<0x121>(x)); x = fmaxf(x, dppf<0x122>(x)); x = fmaxf(x, dppf<0x124>(x)); x = fmaxf(x, dppf<0x128>(x)); return x; }
__device__ __forceinline__ float rowsum_f(float x) { x += dppf<0x121>(x); x += dppf<0x122>(x); x += dppf<0x124>(x); x += dppf<0x128>(x); return x; }
#define CEX(a, b) { const unsigned _hi = (a) > (b) ? (a) : (b), _lo = (a) > (b) ? (b) : (a); (a) = _hi; (b) = _lo; }

#define PS_ROW 528
#define PS_SV0 135168
#define PS_SI0 151552

struct EpiQ { bf16_t* Q; int m0, n0;
    __device__ __forceinline__ void operator()(const f32x4& v, int row, int col) const {
        u32x2 w; w.x = pk_bf16(v[0], v[1]); w.y = pk_bf16(v[2], v[3]);
        *(u32x2*)(Q + (size_t)(row - m0) * 256 + (col - n0)) = w; }
};

__device__ __forceinline__ void peer_route_phase(const MKP& p, int layer, LAS uchar* lds, const bf16_t* Hsrc, int qmode) {
    const bf16_t* WqT = p.WqT + (size_t)layer * 2048 * 1024;
    for (int item = blockIdx.x; item < 512; item += gridDim.x) {
        const int h = item & 7, pm = item >> 3;
        const bf16_t* Q; int qld;
        if (qmode == 1) { Q = p.Zb + (size_t)pm * 256 * 2048 + h * 256; qld = 2048; }
        else { bf16_t* Qw = p.Zb + (size_t)item * 65536; Q = Qw; qld = 256;
            EpiQ eq{Qw, pm * 256, h * 256};
            gemm_tile<256>(Hsrc, D, WqT, D, D, pm * 256, h * 256, lds, eq);
            asm volatile("s_waitcnt vmcnt(0)" ::: "memory"); }
        __syncthreads();
        int tid = threadIdx.x; asm volatile("" : "+v"(tid));
        const int wid = tid >> 6, lane = tid & 63, fr = lane & 15, fq = lane >> 4;
        const int rbase = 32 * wid;
        float sv1 = 0.f; int si1 = 0;
        for (int half = 0; half < 2; ++half) {
            f32x4 acc[2][8];
#pragma unroll
            for (int m = 0; m < 2; ++m)
#pragma unroll
                for (int n = 0; n < 8; ++n) acc[m][n] = (f32x4){0.f, 0.f, 0.f, 0.f};
            const bf16_t* kb = p.Keysb + ((size_t)(layer * 16 + h * 2 + half) * 128) * 128;
#pragma unroll
            for (int ks = 0; ks < 4; ++ks) {
                bf16x8 qf[2], kf[8];
#pragma unroll
                for (int m = 0; m < 2; ++m) qf[m] = *(const bf16x8*)(Q + (size_t)(rbase + 16 * m + fr) * qld + half * 128 + 32 * ks + 8 * fq);
#pragma unroll
                for (int n = 0; n < 8; ++n) kf[n] = *(const bf16x8*)(kb + (size_t)(16 * n + fr) * 128 + 32 * ks + 8 * fq);
#pragma unroll
                for (int m = 0; m < 2; ++m)
#pragma unroll
                    for (int n = 0; n < 8; ++n) acc[m][n] = __builtin_amdgcn_mfma_f32_16x16x32_bf16(kf[n], qf[m], acc[m][n], 0, 0, 0);
            }
#pragma unroll
            for (int m = 0; m < 2; ++m)
#pragma unroll
                for (int n = 0; n < 8; ++n) *(LAS f32x4*)(lds + (rbase + 16 * m + fr) * PS_ROW + (16 * n + 4 * fq) * 4) = acc[m][n];
            for (int rg = 0; rg < 8; ++rg) {
                const int row = rbase + 4 * rg + fq; const int q = fr;
                const LAS uchar* srow = lds + row * PS_ROW;
                const f32x4 s0 = *(const LAS f32x4*)(srow + 32 * q), s1 = *(const LAS f32x4*)(srow + 32 * q + 16);
                unsigned k0 = (f2key(s0[0]) & ~127u) | (127u - (8 * q + 0)), k1 = (f2key(s0[1]) & ~127u) | (127u - (8 * q + 1)), k2 = (f2key(s0[2]) & ~127u) | (127u - (8 * q + 2)), k3 = (f2key(s0[3]) & ~127u) | (127u - (8 * q + 3));
                unsigned k4 = (f2key(s1[0]) & ~127u) | (127u - (8 * q + 4)), k5 = (f2key(s1[1]) & ~127u) | (127u - (8 * q + 5)), k6 = (f2key(s1[2]) & ~127u) | (127u - (8 * q + 6)), k7 = (f2key(s1[3]) & ~127u) | (127u - (8 * q + 7));
                CEX(k0, k1) CEX(k2, k3) CEX(k4, k5) CEX(k6, k7)
                CEX(k0, k2) CEX(k1, k3) CEX(k4, k6) CEX(k5, k7)
                CEX(k1, k2) CEX(k5, k6)
                CEX(k0, k4) CEX(k1, k5) CEX(k2, k6) CEX(k3, k7)
                CEX(k2, k4) CEX(k3, k5)
                CEX(k1, k2) CEX(k3, k4) CEX(k5, k6)
                unsigned res = 0;
#pragma unroll
                for (int it = 0; it < 16; ++it) { const unsigned mx = rowmax_u(k0); if (q == it) res = mx;
                    if (k0 == mx) { k0 = k1; k1 = k2; k2 = k3; k3 = k4; k4 = k5; k5 = k6; k6 = k7; k7 = 0u; } }
                const int idx = 127 - (int)(res & 127u);
                const float val = *(const LAS float*)(srow + 4 * idx);
                if (half == 0) { *(LAS float*)(lds + PS_SV0 + (row * 16 + q) * 4) = val; *(LAS uchar*)(lds + PS_SI0 + row * 16 + q) = (uchar)idx; }
                else {
                    sv1 = val; si1 = idx;
                    const float sv0 = *(const LAS float*)(lds + PS_SV0 + (row * 16 + q) * 4); const int si0 = *(const LAS uchar*)(lds + PS_SI0 + row * 16 + q);
                    const int rowlane = lane & 48;
                    unsigned c[16];
#pragma unroll
                    for (int j = 0; j < 16; ++j) { const float s = sv0 + __shfl(sv1, rowlane + j); c[j] = (f2key(s) & ~255u) | (255u - (unsigned)(q * 16 + j)); }
                    unsigned res2 = 0;
#pragma unroll
                    for (int it = 0; it < 16; ++it) { const unsigned mx = rowmax_u(c[0]); if (q == it) res2 = mx;
                        if (c[0] == mx) {
#pragma unroll
                            for (int j = 0; j < 15; ++j) c[j] = c[j + 1];
                            c[15] = 0u; } }
                    const int flat = 255 - (int)(res2 & 255u); const int ii = flat >> 4, jj = flat & 15;
                    const float fv = __shfl(sv0, rowlane + ii) + __shfl(sv1, rowlane + jj);
                    const int e0 = __shfl(si0, rowlane + ii), e1 = __shfl(si1, rowlane + jj);
                    const float mx = rowmax_f(fv); const float ex = __expf(fv - mx); const float sm = rowsum_f(ex);
                    const int t = pm * 256 + row;
                    p.EI[(size_t)t * 128 + h * 16 + q] = e0 * 128 + e1;
                    p.EG[(size_t)t * 128 + h * 16 + q] = ex / sm;
                }
            }
        }
        __syncthreads();
    }
}

__device__ __forceinline__ float dot2bf(unsigned a, unsigned b, float c) { return __builtin_amdgcn_fdot2_f32_bf16(__builtin_bit_cast(bf16x2v, a), __builtin_bit_cast(bf16x2v, b), c, false); }

__device__ __forceinline__ void peer_eval_phase(const MKP& p, int layer, const float* gate  , bool last) {
    int tid = threadIdx.x; asm volatile("" : "+v"(tid));
    const int wid = tid >> 6, lane = tid & 63;
    const bf16_t* U = p.Ub + (size_t)layer * 16384 * 1024; const bf16_t* V = p.Vb + (size_t)layer * 16384 * 1024;
    for (int t = blockIdx.x * 8 + wid; t < NTOK; t += gridDim.x * 8) {
        const u32x4 xa = *(const u32x4*)(p.Hb + (size_t)t * D + 8 * lane), xb = *(const u32x4*)(p.Hb + (size_t)t * D + 512 + 8 * lane);
        float acc[16];
#pragma unroll
        for (int i = 0; i < 16; ++i) acc[i] = 0.f;
        const int* ei = p.EI + (size_t)t * 128; const float* eg = p.EG + (size_t)t * 128;
        for (int e0 = 0; e0 < 128; e0 += 4) {
            int idx[4]; float gw[4]; u32x4 ua[4], ub[4], va[4], vb[4];
#pragma unroll
            for (int i = 0; i < 4; ++i) { idx[i] = __builtin_amdgcn_readfirstlane(ei[e0 + i]); gw[i] = eg[e0 + i]; }
#pragma unroll
            for (int i = 0; i < 4; ++i) { const bf16_t* ur = U + (size_t)idx[i] * D; ua[i] = *(const u32x4*)(ur + 8 * lane); ub[i] = *(const u32x4*)(ur + 512 + 8 * lane); }
#pragma unroll
            for (int i = 0; i < 4; ++i) { const bf16_t* vr = V + (size_t)idx[i] * D; va[i] = *(const u32x4*)(vr + 8 * lane); vb[i] = *(const u32x4*)(vr + 512 + 8 * lane); }
            float s[4];
#pragma unroll
            for (int i = 0; i < 4; ++i) { float a = 0.f;
                a = dot2bf(xa.x, ua[i].x, a); a = dot2bf(xa.y, ua[i].y, a); a = dot2bf(xa.z, ua[i].z, a); a = dot2bf(xa.w, ua[i].w, a);
                a = dot2bf(xb.x, ub[i].x, a); a = dot2bf(xb.y, ub[i].y, a); a = dot2bf(xb.z, ub[i].z, a); a = dot2bf(xb.w, ub[i].w, a);
                s[i] = wave_sum(a); }
#pragma unroll
            for (int i = 0; i < 4; ++i) { const float cf = gw[i] * gelu_f(s[i]);
                acc[0] += cf * bflo(va[i].x); acc[1] += cf * bfhi(va[i].x); acc[2] += cf * bflo(va[i].y); acc[3] += cf * bfhi(va[i].y);
                acc[4] += cf * bflo(va[i].z); acc[5] += cf * bfhi(va[i].z); acc[6] += cf * bflo(va[i].w); acc[7] += cf * bfhi(va[i].w);
                acc[8] += cf * bflo(vb[i].x); acc[9] += cf * bfhi(vb[i].x); acc[10] += cf * bflo(vb[i].y); acc[11] += cf * bfhi(vb[i].y);
                acc[12] += cf * bflo(vb[i].z); acc[13] += cf * bfhi(vb[i].z); acc[14] += cf * bflo(vb[i].w); acc[15] += cf * bfhi(vb[i].w); }
        }
        float* xr = p.X + (size_t)t * D; const float* gt = gate + (size_t)tok_cv(t) * 6144;
        float xn[16]; float ss = 0.f;
#pragma unroll
        for (int hseg = 0; hseg < 2; ++hseg)
#pragma unroll
            for (int v4 = 0; v4 < 2; ++v4) { const int c = 512 * hseg + 8 * lane + 4 * v4; const f32x4 x = *(const f32x4*)(xr + c), g = *(const f32x4*)(gt + c);
                f32x4 o;
#pragma unroll
                for (int e = 0; e < 4; ++e) { o[e] = x[e] + g[e] * acc[8 * hseg + 4 * v4 + e]; xn[8 * hseg + 4 * v4 + e] = o[e]; ss += o[e] * o[e]; }
                *(f32x4*)(xr + c) = o; }
        ss = wave_sum(ss);
        const float rstd = rsqrtf(ss * (1.f / D) + EPSV);
        if (!last) {
            const float* gv = p.norm1_g + D; const float* mv = p.modv + 3 * 6144 + (size_t)tok_cv(t) * 6144;
#pragma unroll
            for (int hseg = 0; hseg < 2; ++hseg) { const int c = 512 * hseg + 8 * lane; float y[8];
#pragma unroll
                for (int e = 0; e < 8; ++e) y[e] = xn[8 * hseg + e] * rstd * gv[c + e] * (1.f + mv[D + c + e]) + mv[c + e];
                u32x4 w; w.x = pk_bf16(y[0], y[1]); w.y = pk_bf16(y[2], y[3]); w.z = pk_bf16(y[4], y[5]); w.w = pk_bf16(y[6], y[7]);
                *(u32x4*)(p.Hb + (size_t)t * D + c) = w; }
        } else {
#pragma unroll
            for (int hseg = 0; hseg < 2; ++hseg)
#pragma unroll
                for (int v4 = 0; v4 < 2; ++v4) { const int c = 512 * hseg + 8 * lane + 4 * v4; const f32x4 g = *(const f32x4*)(p.final_g + c); f32x4 o;
#pragma unroll
                    for (int e = 0; e < 4; ++e) o[e] = xn[8 * hseg + 4 * v4 + e] * rstd * g[e];
                    *(f32x4*)(p.out + (size_t)t * D + c) = o; }
        }
    }
}

__device__ __forceinline__ void hy_conv_phase(const MKP& p, LAS uchar* lds) {
    int tid = threadIdx.x; asm volatile("" : "+v"(tid));
    LAS bf16_t* tl = (LAS bf16_t*)lds;
    for (int item = blockIdx.x; item < 4096; item += gridDim.x) {
        const int tt = item >> 4, cgp = item & 15; const int t0 = tt * 64, c0 = cgp * 64;
        const int tok = tid >> 3, cseg = tid & 7; const int t = t0 + tok; const int c = c0 + 8 * cseg;
        const int rowlen = t < CTX_TOK ? 256 : 64; const int pos = (t < CTX_TOK ? t : t - CTX_TOK) % rowlen;
        const bool vm = pos > 0, vp = pos < rowlen - 1;
        float r[3][8];
#pragma unroll
        for (int part = 0; part < 3; ++part) { const int cc = part * 1024 + c;
            const u32x4 z0 = *(const u32x4*)(p.Zb + (size_t)t * 3072 + cc);
            u32x4 zm = {0u, 0u, 0u, 0u}, zp = {0u, 0u, 0u, 0u};
            if (vm) zm = *(const u32x4*)(p.Zb + (size_t)(t - 1) * 3072 + cc);
            if (vp) zp = *(const u32x4*)(p.Zb + (size_t)(t + 1) * 3072 + cc);
            const unsigned zmu[4] = {zm.x, zm.y, zm.z, zm.w}, z0u[4] = {z0.x, z0.y, z0.z, z0.w}, zpu[4] = {zp.x, zp.y, zp.z, zp.w};
#pragma unroll
            for (int e = 0; e < 8; ++e) { const float a = (e & 1) ? bfhi(zmu[e >> 1]) : bflo(zmu[e >> 1]), b = (e & 1) ? bfhi(z0u[e >> 1]) : bflo(z0u[e >> 1]), cpl = (e & 1) ? bfhi(zpu[e >> 1]) : bflo(zpu[e >> 1]);
                r[part][e] = p.hy_conv_b[cc + e] + p.hy_conv_w[cc + e] * a + p.hy_conv_w[3072 + cc + e] * b + p.hy_conv_w[6144 + cc + e] * cpl; } }
        float vg[8];
#pragma unroll
        for (int e = 0; e < 8; ++e) vg[e] = r[2][e] * r[1][e];
        u32x4 w0, w1;
        w0.x = pk_bf16(r[0][0], r[0][1]); w0.y = pk_bf16(r[0][2], r[0][3]); w0.z = pk_bf16(r[0][4], r[0][5]); w0.w = pk_bf16(r[0][6], r[0][7]);
        w1.x = pk_bf16(vg[0], vg[1]); w1.y = pk_bf16(vg[2], vg[3]); w1.z = pk_bf16(vg[4], vg[5]); w1.w = pk_bf16(vg[6], vg[7]);
        *(u32x4*)(p.X0C + (size_t)t * D + c) = w0;
        *(u32x4*)(p.VG + (size_t)t * D + c) = w1;
        __syncthreads();
#pragma unroll
        for (int e = 0; e < 8; ++e) tl[(8 * cseg + e) * 72 + tok] = f2bf(vg[e]);
        __syncthreads();
        { const int cc = tid >> 3, ts = tid & 7; const u32x4 w = *(const LAS u32x4*)(tl + cc * 72 + 8 * ts);
          *(u32x4*)(p.VT + (size_t)(c0 + cc) * NTOK + t0 + 8 * ts) = w; }
    }
}

#define HL_C1 16448
#define HL_V 32896
#define HL_ACC 49408
__device__ __forceinline__ void hy_long_phase(const MKP& p, LAS uchar* lds) {
    int tid = threadIdx.x; asm volatile("" : "+v"(tid));
    const int wid = tid >> 6, lane = tid & 63, r = lane & 31, hh = lane >> 5;
    for (int item = blockIdx.x; item < 2048; item += gridDim.x) {
        const int pass = item < 1024 ? 1 : 0; const int c = item & 1023;
        const int L = pass ? 4096 : 256, NA = pass ? 64 : 4, RL = 2 * L;
        const bf16_t* R = p.Rf + (pass ? (size_t)1024 * 512 : 0) + (size_t)c * RL;
        const bf16_t* Vc = p.VT + (size_t)c * NTOK + (pass ? CTX_TOK : 0);
        __syncthreads();
        for (int ch = tid; ch < RL / 16; ch += NTHR) {
            const unsigned* src = (const unsigned*)(R + ch * 16);
            unsigned w[9];
#pragma unroll
            for (int i = 0; i < 8; ++i) w[i] = src[i];
            w[8] = (ch * 16 + 16 < RL) ? src[8] : 0u;
            LAS unsigned* d0 = (LAS unsigned*)(lds + ch * 32); LAS unsigned* d1 = (LAS unsigned*)(lds + HL_C1 + ch * 32);
#pragma unroll
            for (int i = 0; i < 8; ++i) { d0[i] = w[i]; d1[i] = (w[i] >> 16) | (w[i + 1] << 16); }
        }
        for (int ch = tid; ch < 1024; ch += NTHR) *(LAS u32x4*)(lds + HL_V + ch * 16) = *(const u32x4*)(Vc + ch * 8);
        for (int i = tid; i < 128 * 65; i += NTHR) *(LAS float*)(lds + HL_ACC + i * 4) = 0.f;
        __syncthreads();
        f32x16 acc[2][4];
#pragma unroll
        for (int mt = 0; mt < 2; ++mt)
#pragma unroll
            for (int nt = 0; nt < 4; ++nt)
#pragma unroll
                for (int e = 0; e < 16; ++e) acc[mt][nt][e] = 0.f;
        const int dlo = -(NA - 1), dhi = NA - 1;
        const int cpo = (r & 1) ? 0 : HL_C1;
        for (int dl = dlo + wid; dl <= dhi; dl += 8) {
            bool act[4]; int vblk[4]; bool vok[4];
#pragma unroll
            for (int nt = 0; nt < 4; ++nt) { const int col = 32 * nt + r; const int a = col % NA; vok[nt] = (a - dl >= 0) && (a - dl < NA); vblk[nt] = vok[nt] ? col - dl : 0;
                act[nt] = __any((int)vok[nt]); }
#pragma unroll
            for (int ks = 0; ks < 4; ++ks) {
                bf16x8 af[2], bfv[4];
#pragma unroll
                for (int mt = 0; mt < 2; ++mt) { const int x = (L - 1) - 64 * dl - 32 * mt - r + 16 * ks + 8 * hh; const int xe = x & ~1;
                    const LAS unsigned* src = (const LAS unsigned*)(lds + cpo + xe * 2);
                    u32x4 w; w.x = src[0]; w.y = src[1]; w.z = src[2]; w.w = src[3]; af[mt] = __builtin_bit_cast(bf16x8, w); }
#pragma unroll
                for (int nt = 0; nt < 4; ++nt) { u32x4 w = *(const LAS u32x4*)(lds + HL_V + vblk[nt] * 128 + (16 * ks + 8 * hh) * 2);
                    if (!vok[nt]) w = (u32x4){0u, 0u, 0u, 0u}; bfv[nt] = __builtin_bit_cast(bf16x8, w); }
#pragma unroll
                for (int nt = 0; nt < 4; ++nt) if (act[nt]) {
#pragma unroll
                    for (int mt = 0; mt < 2; ++mt) acc[mt][nt] = __builtin_amdgcn_mfma_f32_32x32x16_bf16(af[mt], bfv[nt], acc[mt][nt], 0, 0, 0); }
            }
        }
#pragma unroll
        for (int mt = 0; mt < 2; ++mt)
#pragma unroll
            for (int nt = 0; nt < 4; ++nt)
#pragma unroll
                for (int e = 0; e < 16; ++e) { const int i = 32 * mt + (e & 3) + 8 * (e >> 2) + 4 * hh; const int col = 32 * nt + r;
                    atomicAdd((float*)(lds + HL_ACC) + col * 65 + i, acc[mt][nt][e]); }
        __syncthreads();
        { const float nrm = rsqrtf(p.NORMSQ[(pass ? 1024 : 0) + c] + EPSV);
          const int col = tid >> 2, i0 = 16 * (tid & 3); const LAS float* a = (const LAS float*)(lds + HL_ACC) + col * 65 + i0;
          u32x4 w0, w1;
          w0.x = pk_bf16(a[0] * nrm, a[1] * nrm); w0.y = pk_bf16(a[2] * nrm, a[3] * nrm); w0.z = pk_bf16(a[4] * nrm, a[5] * nrm); w0.w = pk_bf16(a[6] * nrm, a[7] * nrm);
          w1.x = pk_bf16(a[8] * nrm, a[9] * nrm); w1.y = pk_bf16(a[10] * nrm, a[11] * nrm); w1.z = pk_bf16(a[12] * nrm, a[13] * nrm); w1.w = pk_bf16(a[14] * nrm, a[15] * nrm);
          bf16_t* dst = p.YT + (size_t)c * NTOK + (pass ? CTX_TOK : 0) + col * 64 + i0;
          *(u32x4*)dst = w0; *(u32x4*)(dst + 8) = w1; }
    }
}

__device__ __forceinline__ void hy_gate_phase(const MKP& p, LAS uchar* lds) {
    int tid = threadIdx.x; asm volatile("" : "+v"(tid));
    LAS bf16_t* tl = (LAS bf16_t*)lds;
    for (int item = blockIdx.x; item < 4096; item += gridDim.x) {
        const int tt = item >> 4, cgp = item & 15; const int t0 = tt * 64, c0 = cgp * 64;
        __syncthreads();
        { const int cc = tid >> 3, ts = tid & 7; *(LAS u32x4*)(tl + cc * 72 + 8 * ts) = *(const u32x4*)(p.YT + (size_t)(c0 + cc) * NTOK + t0 + 8 * ts); }
        __syncthreads();
        const int tok = tid >> 3, cseg = tid & 7; const int t = t0 + tok, c = c0 + 8 * cseg;
        const u32x4 x0 = *(const u32x4*)(p.X0C + (size_t)t * D + c), vgp = *(const u32x4*)(p.VG + (size_t)t * D + c);
        const unsigned x0u[4] = {x0.x, x0.y, x0.z, x0.w}, vgu[4] = {vgp.x, vgp.y, vgp.z, vgp.w};
        float y[8];
#pragma unroll
        for (int e = 0; e < 8; ++e) { const float cv = bf2f(tl[(8 * cseg + e) * 72 + tok]); const float vv = (e & 1) ? bfhi(vgu[e >> 1]) : bflo(vgu[e >> 1]), xx = (e & 1) ? bfhi(x0u[e >> 1]) : bflo(x0u[e >> 1]);
            y[e] = (cv + p.hy_bias[c + e] * vv) * xx; }
        u32x4 w; w.x = pk_bf16(y[0], y[1]); w.y = pk_bf16(y[2], y[3]); w.z = pk_bf16(y[4], y[5]); w.w = pk_bf16(y[6], y[7]);
        *(u32x4*)(p.CAT + (size_t)t * D + c) = w;
    }
}

extern __shared__ __attribute__((aligned(16))) unsigned char smem_raw[];
#define MK_LDS_BYTES 163840

#define GSYNC() do { asm volatile("s_waitcnt vmcnt(0)" ::: "memory"); grid.sync(); \
    if (threadIdx.x == 0) { __builtin_amdgcn_fence(__ATOMIC_ACQUIRE, "agent"); asm volatile("s_waitcnt vmcnt(0)" ::: "memory"); } __syncthreads(); } while (0)

__global__ void __launch_bounds__(NTHR) mega_fwd(MKP p) {
    cg::grid_group grid = cg::this_grid();
    LAS uchar* lds = (LAS uchar*)smem_raw;
    phase0(p, lds);
    GSYNC();
#pragma nounroll
    for (int layer = 0; layer < 2; ++layer) {
        const float* mv = p.modv + layer * 3 * 6144;
        if (layer == 0) {
            norm_phase(p, true, p.norm1_g, mv, 0, 1, p.Hb);
            hyfilt_phase(p, lds);
            GSYNC();
            { EpiStoreBf16 e{p.Zb, 1536, nullptr}; gemm_phase<128>(p.Hb, D, p.WinT, D, D, NTOK, 1536, lds, e); }
            GSYNC();
#pragma nounroll
            for (int pass = 0; pass < 2; ++pass) { scan_phase(p, pass, lds); GSYNC(); }
            { EpiGlu e{p.ZS, p.CAT, p.s5_b_glu}; gemm_phase<128>(p.ZS, 512, p.WgluT, 512, 512, NTOK, 512, lds, e); }
            GSYNC();
        } else {
            { EpiStoreBf16 e{p.Zb, 3072, p.b_in_c}; gemm_phase<256>(p.Hb, D, p.WincT, D, D, NTOK, 3072, lds, e); }
            GSYNC();
            hy_conv_phase(p, lds);
            GSYNC();
            hy_long_phase(p, lds);
            GSYNC();
            hy_gate_phase(p, lds);
            GSYNC();
        }
        { EpiResid e{&p, layer == 0, mv + 2 * D, layer ? p.b_out_c : nullptr}; gemm_phase<256>(p.CAT, D, layer ? p.WoutcT : p.WoutT, D, D, NTOK, D, lds, e); }
        if (p.stop_after == 1 + 2 * layer) return;
        GSYNC();
        norm_phase(p, false, p.norm2_g + layer * D, mv, 3, 4, p.Hb);
        if (p.stop_after == 14 && layer == 0) return;
        GSYNC();
        peer_route_phase(p, layer, lds, p.Hb, 0);
        if (p.stop_after == 15 && layer == 0) return;
        GSYNC();
        peer_eval_phase(p, layer, mv + 5 * D, layer == 1);
        if (p.stop_after == 2 && layer == 0) return;
        if (layer == 0) GSYNC();
    }
}

static void mk_fill_params(MKP& p, void* const* d_in, void* d_out, void* d_ws) {
    const float** f = (const float**)&p;
    for (int i = 0; i < 50; ++i) f[i] = (const float*)d_in[i];
    p.out = (float*)d_out;
    unsigned char* ws = (unsigned char*)d_ws; size_t off = 0;
    auto take = [&](size_t bytes) { unsigned char* q = ws + off; off += (bytes + 255) & ~(size_t)255; return q; };
    p.X = (float*)take((size_t)NTOK * D * 4);
    p.Hb = (bf16_t*)take((size_t)NTOK * D * 2);
    p.Zb = (bf16_t*)take((size_t)NTOK * 3072 * 2);
    p.CAT = (bf16_t*)take((size_t)NTOK * D * 2);
    unsigned char* regA = take((size_t)96 << 20);
    p.ZS = (bf16_t*)regA; p.HS = (float*)(regA + ((size_t)16 << 20)); p.Qs = (bf16_t*)(regA + ((size_t)48 << 20));
    p.EI = (int*)(regA + ((size_t)80 << 20)); p.EG = (float*)(regA + ((size_t)88 << 20));
    p.X0C = (bf16_t*)regA; p.VG = (bf16_t*)(regA + ((size_t)32 << 20)); p.VT = (bf16_t*)(regA + ((size_t)64 << 20));
    p.YT = p.Zb;
    p.Ub = (bf16_t*)take((size_t)2 * 16384 * 1024 * 2); p.Vb = (bf16_t*)take((size_t)2 * 16384 * 1024 * 2);
    p.WinT = (bf16_t*)take((size_t)1536 * 1024 * 2); p.WgluT = (bf16_t*)take((size_t)512 * 512 * 2); p.WoutT = (bf16_t*)take((size_t)1024 * 1024 * 2);
    p.WincT = (bf16_t*)take((size_t)3072 * 1024 * 2); p.WoutcT = (bf16_t*)take((size_t)1024 * 1024 * 2); p.WqT = (bf16_t*)take((size_t)2 * 2048 * 1024 * 2);
    p.Keysb = (bf16_t*)take((size_t)2 * 16 * 128 * 128 * 2); p.WaT = (bf16_t*)take((size_t)16 * 4096 * 2); p.WxT = (bf16_t*)take((size_t)16 * 4096 * 2);
    p.Bmat = (bf16_t*)take((size_t)64 * 128 * 16 * 2); p.CmT = (bf16_t*)take((size_t)64 * 16 * 128 * 2);
    p.abar = (float*)take(4096 * 2 * 4); p.aL = (float*)take(4096 * 2 * 4);
    p.S5car = (float*)take((size_t)2 * 2 * 32 * 16 * 128 * 4); p.LRUcar = (float*)take((size_t)2 * 2 * 16 * 1024 * 4);
    p.modv = (float*)take(2 * 3 * 6144 * 4); p.Z2 = (float*)take((size_t)4352 * 64 * 4); p.NORMSQ = (float*)take(2048 * 4);
    p.Rf = (bf16_t*)take(((size_t)1024 * 512 + (size_t)1024 * 8192) * 2);
    p.stop_after = 0; p.pad0 = 0;
}

#include <string.h>
#ifndef MK_STOP_AFTER
#define MK_STOP_AFTER 0
#endif
extern "C" void kernel_launch(void* const* d_in, const int* in_sizes, int n_in, void* d_out, int out_size, void* d_ws, size_t ws_size, hipStream_t stream) {
    static int grid_blocks = 0;
    if (!grid_blocks) {
        int dev = 0, cus = 0, per_cu = 0;
        (void)hipGetDevice(&dev);
        (void)hipDeviceGetAttribute(&cus, hipDeviceAttributeMultiprocessorCount, dev);
        (void)hipFuncSetAttribute((const void*)mega_fwd, hipFuncAttributeMaxDynamicSharedMemorySize, MK_LDS_BYTES);
        (void)hipOccupancyMaxActiveBlocksPerMultiprocessor(&per_cu, (const void*)mega_fwd, NTHR, MK_LDS_BYTES);
        if (per_cu > 1) per_cu = 1;
        grid_blocks = cus * per_cu; if (grid_blocks > 256) grid_blocks = 256;
        if (grid_blocks < 1) { fprintf(stderr, "mega_fwd: occupancy query returned 0 blocks per CU\n"); grid_blocks = 0; return; }
    }
    MKP p; memset(&p, 0, sizeof(p));
    mk_fill_params(p, d_in, d_out, d_ws);
    p.stop_after = MK_STOP_AFTER;
    void* args[] = {&p};
    hipError_t e = hipLaunchCooperativeKernel((const void*)mega_fwd, dim3(grid_blocks), dim3(NTHR), args, MK_LDS_BYTES, stream);
    if (e != hipSuccess) fprintf(stderr, "cooperative launch failed: %s (grid %d)\n", hipGetErrorString(e), grid_blocks);
#if MK_STOP_AFTER != 0
    nv::naive_tail(MK_STOP_AFTER, d_in, d_out, d_ws, stream);
#endif
}
```

```cpp
#include <hip/hip_runtime.h>
#include <hip/hip_cooperative_groups.h>
#include <stdint.h>
#include <math.h>
#include <stdio.h>
namespace cg = cooperative_groups;

#define D 1024
#define NTOK 16384
#define CTX_TOK 8192
#define EPSV 1e-6f
#define NTHR 512
#define LAS __attribute__((address_space(3)))
#define GAS __attribute__((address_space(1)))

typedef unsigned short bf16_t;
typedef unsigned char uchar;
typedef short bf16x8 __attribute__((ext_vector_type(8)));
typedef float f32x4 __attribute__((ext_vector_type(4)));
typedef float f32x2 __attribute__((ext_vector_type(2)));
typedef float f32x16 __attribute__((ext_vector_type(16)));
typedef unsigned u32x4 __attribute__((ext_vector_type(4)));
typedef unsigned u32x2 __attribute__((ext_vector_type(2)));
typedef __bf16 bf16x2v __attribute__((ext_vector_type(2)));

struct MKP {
    const float *x_prompt, *x_sample, *st_re, *st_im, *st_lru, *c, *c_ctx, *norm1_g, *norm2_g, *w_mod, *b_mod, *w_in_ab,
        *s5_a_re, *s5_a_im, *s5_log_dt, *s5_b_re, *s5_b_im, *s5_c_re, *s5_c_im, *s5_d, *s5_w_glu, *s5_b_glu,
        *lru_conv_w, *lru_conv_b, *lru_w_a, *lru_b_a, *lru_w_x, *lru_b_x, *lru_lambda, *w_out_ab,
        *w_in_c, *b_in_c, *hy_conv_w, *hy_conv_b, *hy_w1, *hy_b1, *hy_f1, *hy_w2, *hy_b2, *hy_f2, *hy_w3, *hy_decay, *hy_bias, *w_out_c, *b_out_c,
        *peer_wq, *peer_keys, *peer_u, *peer_v, *final_g;
    float* out;
    float* X;
    bf16_t* Hb;
    bf16_t* Zb;
    bf16_t* CAT;
    bf16_t* ZS;
    float* HS;
    bf16_t* Qs;
    int* EI; float* EG;
    bf16_t *X0C, *VG, *VT, *YT;
    uchar *Ub, *Vb;
    float *SU, *SV;
    unsigned *bar;
    bf16_t *WinT, *WgluT, *WoutT, *WincT, *WoutcT, *WqT, *Keysb, *WaT, *WxT;
    bf16_t *Bmat, *CmT; float *abar, *aL;
    float *S5car;
    float *LRUcar;
    float *modv;
    float *Z2;
    float *NORMSQ;
    bf16_t *Rf;
    int stop_after; int pad0;
};

__device__ __forceinline__ float bf2f(bf16_t v) { return __uint_as_float((unsigned)v << 16); }
__device__ __forceinline__ float bflo(unsigned p) { return __uint_as_float(p << 16); }
__device__ __forceinline__ float bfhi(unsigned p) { return __uint_as_float(p & 0xffff0000u); }
__device__ __forceinline__ unsigned pk_bf16(float lo, float hi) { const f32x2 v = {lo, hi}; const bf16x2v r = __builtin_convertvector(v, bf16x2v); return __builtin_bit_cast(unsigned, r); }
__device__ __forceinline__ bf16_t f2bf(float x) { return (bf16_t)(pk_bf16(x, 0.f) & 0xffffu); }
__device__ __forceinline__ float sigmoid_f(float x) { return 1.f / (1.f + __expf(-x)); }
__device__ __forceinline__ float gelu_f(float x) { float z = 1.5957691216057308f * (x + 0.044715f * x * x * x); return x / (1.f + __expf(-z)); }
__device__ __forceinline__ float silu_f(float x) { return x / (1.f + __expf(-x)); }
__device__ __forceinline__ int tok_cv(int t) { return t < CTX_TOK ? 0 : 1 + ((t - CTX_TOK) >> 12); }
__device__ __forceinline__ const float* xin_row(const MKP& p, int t) { return t < CTX_TOK ? p.x_prompt + (size_t)t * D : p.x_sample + (size_t)(t - CTX_TOK) * D; }
__device__ __forceinline__ float wave_sum(float v) {
#pragma unroll
    for (int o = 32; o > 0; o >>= 1) v += __shfl_xor(v, o);
    return v;
}
__device__ __forceinline__ void glds16(const void* g, LAS uchar* l) { __builtin_amdgcn_global_load_lds((const GAS void*)g, (LAS void*)l, 16, 0, 0); }

template <int BN, class Epi>
__device__ __forceinline__ void gemm_tile(const bf16_t* A, int lda, const bf16_t* Bt, int ldb, int K, int m0, int n0, LAS uchar* lds, Epi& epi) {
    constexpr int NW = BN / 64;
    constexpr int STAGE = 256 * 128 + BN * 128;
    int tid = threadIdx.x; asm volatile("" : "+v"(tid));
    const int wid = tid >> 6, lane = tid & 63, wr = wid >> 2, wc = wid & 3, fr = lane & 15, fq = lane >> 4;
    f32x4 acc[8][NW];
#pragma unroll
    for (int m = 0; m < 8; ++m)
#pragma unroll
        for (int n = 0; n < NW; ++n) acc[m][n] = (f32x4){0.f, 0.f, 0.f, 0.f};
    const int nk = K >> 6;
    const int srow = lane >> 3, sc = lane & 7;
    auto stage = [&](int kt, int buf) {
        LAS uchar* sb = lds + buf * STAGE;
#pragma unroll
        for (int j = 0; j < 4; ++j) { const int rowl = 8 * (wid + 8 * j) + srow; const int c = sc ^ ((rowl >> 1) & 7);
            glds16(A + (size_t)(m0 + rowl) * lda + kt * 64 + c * 8, sb + rowl * 128 + sc * 16); }
#pragma unroll
        for (int j = 0; j < BN / 64; ++j) { const int rowl = 8 * (wid + 8 * j) + srow; const int c = sc ^ ((rowl >> 1) & 7);
            glds16(Bt + (size_t)(n0 + rowl) * ldb + kt * 64 + c * 8, sb + 32768 + rowl * 128 + sc * 16); }
    };
    __syncthreads();
    stage(0, 0);
    for (int kt = 0; kt < nk; ++kt) {
        asm volatile("s_waitcnt vmcnt(0)" ::: "memory");
        __syncthreads();
        if (kt + 1 < nk) stage(kt + 1, (kt + 1) & 1);
        const LAS uchar* sa = lds + (kt & 1) * STAGE;
        const LAS uchar* sbp = sa + 32768;
#pragma unroll
        for (int kk = 0; kk < 2; ++kk) {
            const int cs = ((kk * 4 + fq) ^ (fr >> 1)) * 16;
            bf16x8 bfr[NW];
#pragma unroll
            for (int n = 0; n < NW; ++n) bfr[n] = *(const LAS bf16x8*)(sbp + (wc * (BN / 4) + n * 16 + fr) * 128 + cs);
#pragma unroll
            for (int mh = 0; mh < 2; ++mh) {
                bf16x8 af[4];
#pragma unroll
                for (int m = 0; m < 4; ++m) af[m] = *(const LAS bf16x8*)(sa + (wr * 128 + (4 * mh + m) * 16 + fr) * 128 + cs);
#pragma unroll
                for (int m = 0; m < 4; ++m)
#pragma unroll
                    for (int n = 0; n < NW; ++n) acc[4 * mh + m][n] = __builtin_amdgcn_mfma_f32_16x16x32_bf16(bfr[n], af[m], acc[4 * mh + m][n], 0, 0, 0);
            }
        }
    }
#pragma unroll
    for (int m = 0; m < 8; ++m)
#pragma unroll
        for (int n = 0; n < NW; ++n) epi(acc[m][n], m0 + wr * 128 + m * 16 + fr, n0 + wc * (BN / 4) + n * 16 + 4 * fq);
}

struct EpiStoreBf16 {
    bf16_t* O; int ldc; const float* bias;
    __device__ __forceinline__ void operator()(const f32x4& v, int row, int col) const {
        f32x4 b = bias ? *(const f32x4*)(bias + col) : (f32x4){0.f, 0.f, 0.f, 0.f};
        u32x2 w; w.x = pk_bf16(v[0] + b[0], v[1] + b[1]); w.y = pk_bf16(v[2] + b[2], v[3] + b[3]);
        *(u32x2*)(O + (size_t)row * ldc + col) = w;
    }
};
struct EpiGlu {
    const bf16_t* ZS; bf16_t* CAT; const float* bias;
    __device__ __forceinline__ void operator()(const f32x4& v, int row, int col) const {
        f32x4 b = *(const f32x4*)(bias + col); u32x2 z = *(const u32x2*)(ZS + (size_t)row * 512 + col);
        float o0 = bflo(z.x) * sigmoid_f(v[0] + b[0]), o1 = bfhi(z.x) * sigmoid_f(v[1] + b[1]), o2 = bflo(z.y) * sigmoid_f(v[2] + b[2]), o3 = bfhi(z.y) * sigmoid_f(v[3] + b[3]);
        u32x2 w; w.x = pk_bf16(o0, o1); w.y = pk_bf16(o2, o3);
        *(u32x2*)(CAT + (size_t)row * D + col) = w;
    }
};
struct EpiResid {
    const MKP* p; bool from_input; const float* gate;   const float* bias;
    __device__ __forceinline__ void operator()(const f32x4& v, int row, int col) const {
        const float* xr = from_input ? xin_row(*p, row) : p->X + (size_t)row * D;
        f32x4 x = *(const f32x4*)(xr + col); f32x4 g = *(const f32x4*)(gate + (size_t)tok_cv(row) * 6144 + col);
        f32x4 b = bias ? *(const f32x4*)(bias + col) : (f32x4){0.f, 0.f, 0.f, 0.f};
        f32x4 o; o[0] = x[0] + g[0] * (v[0] + b[0]); o[1] = x[1] + g[1] * (v[1] + b[1]); o[2] = x[2] + g[2] * (v[2] + b[2]); o[3] = x[3] + g[3] * (v[3] + b[3]);
        *(f32x4*)(p->X + (size_t)row * D + col) = o;
    }
};

template <int BN, class Epi>
__device__ __forceinline__ void gemm_phase(const bf16_t* A, int lda, const bf16_t* Bt, int ldb, int K, int M, int N, LAS uchar* lds, Epi& epi) {
    const int nM = M / 256, nN = N / BN, nt = nM * nN;
    for (int t = blockIdx.x; t < nt; t += gridDim.x) { const int pn = t % nN, pm = t / nN; gemm_tile<BN>(A, lda, Bt, ldb, K, pm * 256, pn * BN, lds, epi); }
}

__device__ __forceinline__ void transpose_tile(const float* src, int K, int N, bf16_t* dst, int k0, int n0, LAS uchar* lds) {
    LAS float* tl = (LAS float*)lds;
    int tid = threadIdx.x; asm volatile("" : "+v"(tid));
    __syncthreads();
#pragma unroll
    for (int i = 0; i < 8; ++i) { const int e = tid + NTHR * i, kr = e >> 6, nc = e & 63; tl[nc * 65 + kr] = src[(size_t)(k0 + kr) * N + n0 + nc]; }
    __syncthreads();
#pragma unroll
    for (int i = 0; i < 4; ++i) { const int e = tid + NTHR * i, nr = e >> 5, kp = e & 31;
        *(unsigned*)(dst + (size_t)(n0 + nr) * K + k0 + 2 * kp) = pk_bf16(tl[nr * 65 + 2 * kp], tl[nr * 65 + 2 * kp + 1]); }
}

__device__ __forceinline__ void phase0(const MKP& p, LAS uchar* lds) {
    int tid = threadIdx.x; asm volatile("" : "+v"(tid));
    const int bid = blockIdx.x, G = gridDim.x, wid = tid >> 6, lane = tid & 63;
    const int gtid = bid * NTHR + tid, gthreads = G * NTHR;
    {
        LAS float* sc = (LAS float*)lds;
        LAS float* red = (LAS float*)(lds + 12288);
        bool have = false;
        for (int it = bid; it < 192; it += G) {
            if (!have) { for (int i = tid; i < 3072; i += NTHR) { const int cv = i >> 10, k = i & 1023; const float x = cv == 0 ? p.c_ctx[k] : p.c[(cv - 1) * D + k]; sc[i] = silu_f(x); } have = true; }
            __syncthreads();
            const int l = it / 96, cgp = it % 96, col = cgp * 64 + lane;
            const float* w = p.w_mod + (size_t)l * D * 6144 + col;
            float a0 = 0.f, a1 = 0.f, a2 = 0.f;
#pragma unroll 8
            for (int k = wid * 128; k < wid * 128 + 128; ++k) { const float wv = w[(size_t)k * 6144]; a0 += sc[k] * wv; a1 += sc[1024 + k] * wv; a2 += sc[2048 + k] * wv; }
            red[(wid * 3 + 0) * 64 + lane] = a0; red[(wid * 3 + 1) * 64 + lane] = a1; red[(wid * 3 + 2) * 64 + lane] = a2;
            __syncthreads();
            if (tid < 192) { const int cv = tid >> 6, ln = tid & 63; float s = p.b_mod[l * 6144 + cgp * 64 + ln];
#pragma unroll
                for (int w8 = 0; w8 < 8; ++w8) s += red[(w8 * 3 + cv) * 64 + ln];
                p.modv[(l * 3 + cv) * 6144 + cgp * 64 + ln] = s; }
        }
        __syncthreads();
    }
    {
        const int ntiles[8] = {384, 64, 256, 768, 256, 512, 512, 32};
        int base = 0;
        for (int mi = 0; mi < 8; ++mi) {
            const float* src; int K, N; bf16_t* dst;
            switch (mi) {
                case 0: src = p.w_in_ab; K = 1024; N = 1536; dst = p.WinT; break;
                case 1: src = p.s5_w_glu; K = 512; N = 512; dst = p.WgluT; break;
                case 2: src = p.w_out_ab; K = 1024; N = 1024; dst = p.WoutT; break;
                case 3: src = p.w_in_c; K = 1024; N = 3072; dst = p.WincT; break;
                case 4: src = p.w_out_c; K = 1024; N = 1024; dst = p.WoutcT; break;
                case 5: src = p.peer_wq; K = 1024; N = 2048; dst = p.WqT; break;
                case 6: src = p.peer_wq + (size_t)1024 * 2048; K = 1024; N = 2048; dst = p.WqT + (size_t)2048 * 1024; break;
                default: src = nullptr; K = 64; N = 64; dst = nullptr; break;
            }
            for (int t = (bid + G - (base % G)) % G; t < ntiles[mi]; t += G) {
                if (mi < 7) { const int nkt = K / 64; const int kt = t % nkt, nt = t / nkt; transpose_tile(src, K, N, dst, kt * 64, nt * 64, lds); }
                else { const int m = t & 15; const bool isx = t >= 16;
                    transpose_tile((isx ? p.lru_w_x : p.lru_w_a) + (size_t)m * 4096, 64, 64, (isx ? p.WxT : p.WaT) + (size_t)m * 4096, 0, 0, lds); }
            }
            base += ntiles[mi];
        }
        __syncthreads();
    }
    {
        auto conv = [&](const float* src, bf16_t* dst, size_t n8) {
            for (size_t i = gtid; i < n8; i += gthreads) { const f32x4 a = *(const f32x4*)(src + i * 8), b = *(const f32x4*)(src + i * 8 + 4);
                u32x4 w; w.x = pk_bf16(a[0], a[1]); w.y = pk_bf16(a[2], a[3]); w.z = pk_bf16(b[0], b[1]); w.w = pk_bf16(b[2], b[3]);
                *(u32x4*)(dst + i * 8) = w; }
        };
        conv(p.peer_keys, p.Keysb, (size_t)2 * 16 * 128 * 128 / 8);
    }
    for (int r = bid * 8 + wid; r < 65536; r += G * 8) {
        const bool isv = r >= 32768; const int rr = r & 32767;
        const float* src = (isv ? p.peer_v : p.peer_u) + (size_t)rr * D;
        f32x4 v[4]; float am = 0.f;
#pragma unroll
        for (int i = 0; i < 4; ++i) { v[i] = *(const f32x4*)(src + 4 * lane + 256 * i);
            am = fmaxf(am, fmaxf(fmaxf(fabsf(v[i][0]), fabsf(v[i][1])), fmaxf(fabsf(v[i][2]), fabsf(v[i][3])))); }
#pragma unroll
        for (int o = 32; o > 0; o >>= 1) am = fmaxf(am, __shfl_xor(am, o));
        const float sc = am > 0.f ? 384.f / am : 1.f;
        uchar* dst = (isv ? p.Vb : p.Ub) + (size_t)rr * D;
#pragma unroll
        for (int i = 0; i < 4; ++i) { int w = 0; w = __builtin_amdgcn_cvt_pk_fp8_f32(v[i][0] * sc, v[i][1] * sc, w, false); w = __builtin_amdgcn_cvt_pk_fp8_f32(v[i][2] * sc, v[i][3] * sc, w, true);
            *(int*)(dst + 4 * lane + 256 * i) = w; }
        if (lane == 0) (isv ? p.SV : p.SU)[rr] = am > 0.f ? am / 384.f : 1.f;
    }
    if (gtid < 4096) {
        const int idx = gtid, dg = idx >> 6, pp = idx & 63;
        const double ar = p.s5_a_re[idx], ai = p.s5_a_im[idx], dt = exp((double)p.s5_log_dt[dg]);
        const double mag = exp(ar * dt), abr = mag * cos(ai * dt), abi = mag * sin(ai * dt);
        const double den = ar * ar + ai * ai, nr = abr - 1.0;
        const double cr = (nr * ar + abi * ai) / den, ci = (abi * ar - nr * ai) / den;
        p.abar[idx * 2] = (float)abr; p.abar[idx * 2 + 1] = (float)abi;
        const double m256 = exp(256.0 * ar * dt), a256 = fmod(256.0 * ai * dt, 6.283185307179586476925);
        p.aL[idx * 2] = (float)(m256 * cos(a256)); p.aL[idx * 2 + 1] = (float)(m256 * sin(a256));
        for (int c = 0; c < 16; ++c) { const double br = p.s5_b_re[idx * 16 + c], bi = p.s5_b_im[idx * 16 + c];
            p.Bmat[((size_t)dg * 128 + 2 * pp) * 16 + c] = f2bf((float)(cr * br - ci * bi));
            p.Bmat[((size_t)dg * 128 + 2 * pp + 1) * 16 + c] = f2bf((float)(cr * bi + ci * br));
            p.CmT[((size_t)dg * 16 + c) * 128 + 2 * pp] = f2bf(p.s5_c_re[((size_t)dg * 16 + c) * 64 + pp]);
            p.CmT[((size_t)dg * 16 + c) * 128 + 2 * pp + 1] = f2bf(-p.s5_c_im[((size_t)dg * 16 + c) * 64 + pp]); }
    }
    for (int pi = bid * 8 + wid; pi < 4352; pi += G * 8) {
        const int L = pi < 256 ? 256 : 4096, pos = pi < 256 ? pi : pi - 256; const int j = lane;
        float emb = 0.f;
        if (j == 0) emb = (float)pos / (float)L;
        else if (j < 33) { const int bi = (j - 1) & 15; const float band = 1e-4f + (15.f - 1e-4f) * (float)bi / 15.f;
            const float ang = (6.283185307179586f / (float)L) * (float)pos * band; emb = j <= 16 ? cosf(ang) : -sinf(ang); }
        float a = p.hy_b1[j];
        for (int k = 0; k < 33; ++k) a += __shfl(emb, k) * p.hy_w1[k * 64 + j];
        const float z1 = sinf(p.hy_f1[j] * a);
        float c2 = p.hy_b2[j];
        for (int k = 0; k < 64; ++k) c2 += __shfl(z1, k) * p.hy_w2[k * 64 + j];
        p.Z2[(size_t)pi * 64 + j] = sinf(p.hy_f2[j] * c2);
    }
    if (gtid < 2048) p.NORMSQ[gtid] = 0.f;
}

__device__ __forceinline__ void norm_one(const MKP& p, const float* xr, int t, const float* gvec, const float* modv_l, int sh_chunk, int sc_chunk, bf16_t* hout, float* fout, int lane) {
    f32x4 v[4]; float s = 0.f;
#pragma unroll
    for (int i = 0; i < 4; ++i) { v[i] = *(const f32x4*)(xr + 4 * lane + 256 * i); s += v[i][0] * v[i][0] + v[i][1] * v[i][1] + v[i][2] * v[i][2] + v[i][3] * v[i][3]; }
    s = wave_sum(s);
    const float rstd = rsqrtf(s * (1.f / D) + EPSV);
    const float* mv = modv_l + (size_t)tok_cv(t) * 6144;
#pragma unroll
    for (int i = 0; i < 4; ++i) { const int c = 4 * lane + 256 * i; const f32x4 g = *(const f32x4*)(gvec + c);
        f32x4 y; y[0] = v[i][0] * rstd * g[0]; y[1] = v[i][1] * rstd * g[1]; y[2] = v[i][2] * rstd * g[2]; y[3] = v[i][3] * rstd * g[3];
        if (hout) { const f32x4 sc = *(const f32x4*)(mv + sc_chunk * D + c), sh = *(const f32x4*)(mv + sh_chunk * D + c);
            u32x2 w; w.x = pk_bf16(y[0] * (1.f + sc[0]) + sh[0], y[1] * (1.f + sc[1]) + sh[1]); w.y = pk_bf16(y[2] * (1.f + sc[2]) + sh[2], y[3] * (1.f + sc[3]) + sh[3]);
            *(u32x2*)(hout + (size_t)t * D + c) = w; }
        else *(f32x4*)(fout + (size_t)t * D + c) = y; }
}
__device__ __forceinline__ void norm_phase(const MKP& p, bool from_input, const float* gvec, const float* modv_l, int sh_chunk, int sc_chunk, bf16_t* hout) {
    int tid = threadIdx.x; asm volatile("" : "+v"(tid));
    const int wid = tid >> 6, lane = tid & 63;
    for (int t = blockIdx.x * 8 + wid; t < NTOK; t += gridDim.x * 8)
        norm_one(p, from_input ? xin_row(p, t) : p.X + (size_t)t * D, t, gvec, modv_l, sh_chunk, sc_chunk, hout, nullptr, lane);
}

__device__ __forceinline__ void hyfilt_phase(const MKP& p, LAS uchar* lds) {
    LAS float* z2 = (LAS float*)lds;
    int tid = threadIdx.x; asm volatile("" : "+v"(tid));
    for (int it = blockIdx.x; it < 544; it += gridDim.x) {
        const bool big = it >= 32; const int L = big ? 4096 : 256; const int p0 = (big ? it - 32 : it) * 8; const int pbase = (big ? 256 : 0) + p0;
        __syncthreads();
        z2[tid] = p.Z2[(size_t)pbase * 64 + tid];
        __syncthreads();
        const int col0 = 4 * tid;
        f32x4 acc[8];
#pragma unroll
        for (int q = 0; q < 8; ++q) acc[q] = (f32x4){0.f, 0.f, 0.f, 0.f};
        for (int k = 0; k < 64; ++k) { const f32x4 w = *(const f32x4*)(p.hy_w3 + (size_t)k * 2048 + col0);
#pragma unroll
            for (int q = 0; q < 8; ++q) { const float z = z2[q * 64 + k]; acc[q][0] += z * w[0]; acc[q][1] += z * w[1]; acc[q][2] += z * w[2]; acc[q][3] += z * w[3]; } }
        const f32x4 dec = *(const f32x4*)(p.hy_decay + col0);
        const int dir = col0 >> 10, ch0 = col0 & 1023;
        bf16_t* R = p.Rf + (big ? (size_t)1024 * 512 : 0);
        const int RL = 2 * L;
        float ss[4] = {0.f, 0.f, 0.f, 0.f};
#pragma unroll
        for (int q = 0; q < 8; ++q) { const int pos = p0 + q; const float tt = (float)pos / (float)L;
#pragma unroll
            for (int e = 0; e < 4; ++e) { const float val = acc[q][e] * (__expf(-tt * fabsf(dec[e])) + 0.05f);
                if (dir == 0) { ss[e] += val * val; R[(size_t)(ch0 + e) * RL + (L - 1 - pos)] = f2bf(val); }
                else if (pos >= 1) { ss[e] += val * val; R[(size_t)(ch0 + e) * RL + (L - 1 + pos)] = f2bf(val); } } }
#pragma unroll
        for (int e = 0; e < 4; ++e) unsafeAtomicAdd(p.NORMSQ + (big ? 1024 : 0) + ch0 + e, ss[e]);
    }
}

#define S5ROW 528
__device__ __forceinline__ void s5_task(const MKP& p, int seqid, int g, int seg, int mode, LAS uchar* wl, int lane) {
    asm volatile("" : "+v"(lane));
    const bool ctx = seqid < 32; const int b = ctx ? seqid : seqid - 32;
    const int t0 = ctx ? seqid * 256 : CTX_TOK + b * 4096 + seg * 256;
    const int r = lane & 31, hh = lane >> 5, fr = lane & 15, fq = lane >> 4;
    const bool full = ctx || mode == 1;
    f32x4 yacc[16];
#pragma unroll
    for (int i = 0; i < 16; ++i) yacc[i] = (f32x4){0.f, 0.f, 0.f, 0.f};
#pragma unroll
    for (int d = 0; d < 2; ++d) {
        const int dg = d * 32 + g;
        bf16x8 bm[4], cm[4];
#pragma unroll
        for (int nt = 0; nt < 4; ++nt) bm[nt] = *(const bf16x8*)(p.Bmat + ((size_t)dg * 128 + 32 * nt + r) * 16 + 8 * hh);
#pragma unroll
        for (int ks = 0; ks < 4; ++ks) cm[ks] = *(const bf16x8*)(p.CmT + ((size_t)dg * 16 + fr) * 128 + 32 * ks + 8 * fq);
        const float ar = p.abar[(dg * 64 + lane) * 2], ai = p.abar[(dg * 64 + lane) * 2 + 1];
        float hr = 0.f, hi = 0.f;
        if (!ctx && mode == 1) {
            hr = p.st_re[((b * 2 + d) * 32 + g) * 64 + lane]; hi = p.st_im[((b * 2 + d) * 32 + g) * 64 + lane];
            const float lr = p.aL[(dg * 64 + lane) * 2], li = p.aL[(dg * 64 + lane) * 2 + 1];
            const float* car = p.S5car + ((size_t)((b * 2 + d) * 32 + g) * 16) * 128;
            if (d == 0) { for (int s = 0; s < seg; ++s) { const float sr = car[s * 128 + lane * 2], si = car[s * 128 + lane * 2 + 1]; const float nr = lr * hr - li * hi + sr, ni = lr * hi + li * hr + si; hr = nr; hi = ni; } }
            else { for (int s = 15; s > seg; --s) { const float sr = car[s * 128 + lane * 2], si = car[s * 128 + lane * 2 + 1]; const float nr = lr * hr - li * hi + sr, ni = lr * hi + li * hr + si; hr = nr; hi = ni; } }
        }
#pragma unroll
        for (int step = 0; step < 8; ++step) {
            asm volatile("" ::: "memory");
            const int sb = d == 0 ? step : 7 - step; const int tb = t0 + 32 * sb;
            const bf16x8 uf = *(const bf16x8*)(p.Zb + (size_t)(tb + r) * 1536 + 16 * g + 8 * hh);
#pragma unroll
            for (int nt = 0; nt < 4; ++nt) {
                f32x16 dd = {0.f, 0.f, 0.f, 0.f, 0.f, 0.f, 0.f, 0.f, 0.f, 0.f, 0.f, 0.f, 0.f, 0.f, 0.f, 0.f};
                dd = __builtin_amdgcn_mfma_f32_32x32x16_bf16(bm[nt], uf, dd, 0, 0, 0);
#pragma unroll
                for (int q = 0; q < 4; ++q) { f32x4 w = {dd[4 * q], dd[4 * q + 1], dd[4 * q + 2], dd[4 * q + 3]};
                    *(LAS f32x4*)(wl + r * S5ROW + (32 * nt + 8 * q + 4 * hh) * 4) = w; }
            }
#pragma unroll 4
            for (int jj = 0; jj < 32; ++jj) { const int j = d == 0 ? jj : 31 - jj;
                const f32x2 bu = *(const LAS f32x2*)(wl + j * S5ROW + 8 * lane);
                const float nr = ar * hr - ai * hi + bu[0], ni = ar * hi + ai * hr + bu[1]; hr = nr; hi = ni;
                if (full) *(LAS unsigned*)(wl + j * S5ROW + 4 * lane) = pk_bf16(hr, hi); }
            if (full) {
#pragma unroll
                for (int mt = 0; mt < 2; ++mt) {
#pragma unroll
                    for (int ks = 0; ks < 4; ++ks) { const bf16x8 hf = *(const LAS bf16x8*)(wl + (16 * mt + fr) * S5ROW + 64 * ks + 16 * fq);
                        yacc[sb * 2 + mt] = __builtin_amdgcn_mfma_f32_16x16x32_bf16(cm[ks], hf, yacc[sb * 2 + mt], 0, 0, 0); }
                    if (d == 0) {
                        bf16x8 df = {0, 0, 0, 0, 0, 0, 0, 0}, uf2 = {0, 0, 0, 0, 0, 0, 0, 0};
                        if (fq < 2) { uf2 = *(const bf16x8*)(p.Zb + (size_t)(tb + 16 * mt + fr) * 1536 + 16 * g + 8 * fq);
                            const bf16_t dv = f2bf(p.s5_d[16 * g + fr]);
#pragma unroll
                            for (int j = 0; j < 8; ++j) df[j] = (8 * fq + j == fr) ? (short)dv : (short)0; }
                        yacc[sb * 2 + mt] = __builtin_amdgcn_mfma_f32_16x16x32_bf16(df, uf2, yacc[sb * 2 + mt], 0, 0, 0);
                    }
                }
            }
        }
        if (ctx) { float* nre = p.out + (size_t)NTOK * D; float* nim = nre + 131072;
            nre[((b * 2 + d) * 32 + g) * 64 + lane] = hr; nim[((b * 2 + d) * 32 + g) * 64 + lane] = hi; }
        else if (mode == 0) { float* car = p.S5car + ((size_t)((b * 2 + d) * 32 + g) * 16 + seg) * 128; car[lane * 2] = hr; car[lane * 2 + 1] = hi; }
    }
    if (full) {
#pragma unroll
        for (int tl = 0; tl < 16; ++tl) { const int t = t0 + 16 * tl + fr; const f32x4 y = yacc[tl];
            u32x2 w; w.x = pk_bf16(gelu_f(y[0]), gelu_f(y[1])); w.y = pk_bf16(gelu_f(y[2]), gelu_f(y[3]));
            *(u32x2*)(p.ZS + (size_t)t * 512 + 16 * g + 4 * fq) = w; }
    }
}

#define LRU_XA 144
#define LRU_G 528
__device__ __forceinline__ void lru_task(const MKP& p, int seqid, int h, int seg, int mode, LAS uchar* wl, int lane) {
    asm volatile("" : "+v"(lane));
    const bool ctx = seqid < 32; const int b = ctx ? seqid : seqid - 32;
    const int seqbase = ctx ? seqid * 256 : CTX_TOK + b * 4096;
    const int t0 = seqbase + (ctx ? 0 : seg * 256);
    const int rowlen = ctx ? 256 : 64;
    const int fr = lane & 15, fq = lane >> 4;
    const bool full = ctx || mode == 1;
    const int ch = 64 * h + lane;
    const float cw0 = p.lru_conv_w[ch], cw1 = p.lru_conv_w[512 + ch], cw2 = p.lru_conv_w[1024 + ch], cw3 = p.lru_conv_w[1536 + ch], cb = p.lru_conv_b[ch];
    LAS uchar* xa = wl; LAS uchar* gl = wl + 16 * LRU_XA;
#pragma unroll
    for (int d = 0; d < 2; ++d) {
        bf16x8 wa[4][2], wx[4][2];
#pragma unroll
        for (int nt = 0; nt < 4; ++nt)
#pragma unroll
            for (int ks = 0; ks < 2; ++ks) { const size_t o = ((size_t)(d * 8 + h) * 64 + 16 * nt + fr) * 64 + 32 * ks + 8 * fq;
                wa[nt][ks] = *(const bf16x8*)(p.WaT + o); wx[nt][ks] = *(const bf16x8*)(p.WxT + o); }
        const float ba = p.lru_b_a[d * 512 + ch], bx = p.lru_b_x[d * 512 + ch];
        const float lm = -p.lru_lambda[d * 512 + ch]; const float sp = lm > 20.f ? lm : log1pf(expf(lm));
        float hst = 0.f, aprod = 1.f;
        if (!ctx && mode == 1) {
            hst = p.st_lru[(b * 2 + d) * 512 + ch];
            const float* car = p.LRUcar + (size_t)((b * 2 + d) * 16) * 1024;
            if (d == 0) { for (int s = 0; s < seg; ++s) hst = car[s * 1024 + ch * 2] * hst + car[s * 1024 + ch * 2 + 1]; }
            else { for (int s = 15; s > seg; --s) hst = car[s * 1024 + ch * 2] * hst + car[s * 1024 + ch * 2 + 1]; }
        }
        for (int step = 0; step < 16; ++step) {
            const int sb = d == 0 ? step : 15 - step; const int tb = t0 + 16 * sb;
            const int rs = seqbase + ((tb - seqbase) / rowlen) * rowlen, re = rs + rowlen;
            float xr[19];
#pragma unroll
            for (int i = 0; i < 19; ++i) { const int tt = tb - 2 + i; xr[i] = (tt >= rs && tt < re) ? bf2f(p.Zb[(size_t)tt * 1536 + 512 + ch]) : 0.f; }
            float xb[16];
#pragma unroll
            for (int j = 0; j < 16; ++j) { xb[j] = cb + cw0 * xr[j] + cw1 * xr[j + 1] + cw2 * xr[j + 2] + cw3 * xr[j + 3];
                *(LAS bf16_t*)(xa + j * LRU_XA + 2 * lane) = f2bf(xb[j]); }
            bf16x8 xf[2];
#pragma unroll
            for (int ks = 0; ks < 2; ++ks) xf[ks] = *(const LAS bf16x8*)(xa + fr * LRU_XA + 64 * ks + 16 * fq);
#pragma unroll
            for (int nt = 0; nt < 4; ++nt) {
                f32x4 da = {0.f, 0.f, 0.f, 0.f}, dx = {0.f, 0.f, 0.f, 0.f};
#pragma unroll
                for (int ks = 0; ks < 2; ++ks) { da = __builtin_amdgcn_mfma_f32_16x16x32_bf16(wa[nt][ks], xf[ks], da, 0, 0, 0); dx = __builtin_amdgcn_mfma_f32_16x16x32_bf16(wx[nt][ks], xf[ks], dx, 0, 0, 0); }
                *(LAS f32x4*)(gl + fr * LRU_G + (16 * nt + 4 * fq) * 4) = da;
                *(LAS f32x4*)(gl + fr * LRU_G + 256 + (16 * nt + 4 * fq) * 4) = dx;
            }
            float av[16], bv[16];
#pragma unroll
            for (int j = 0; j < 16; ++j) { const float ra = *(const LAS float*)(gl + j * LRU_G + 4 * lane) + ba, rx = *(const LAS float*)(gl + j * LRU_G + 256 + 4 * lane) + bx;
                const float rg = sigmoid_f(ra), ig = sigmoid_f(rx); const float la = -8.f * rg * sp; av[j] = __expf(la);
                bv[j] = sqrtf(-expm1f(2.f * la)) * (ig * xb[j]); }
#pragma unroll
            for (int jj = 0; jj < 16; ++jj) { const int j = d == 0 ? jj : 15 - jj; hst = av[j] * hst + bv[j]; aprod *= av[j]; bv[j] = hst; }
            if (full) {
#pragma unroll
                for (int j = 0; j < 16; ++j) { const size_t t = tb + j;
                    if (d == 0) p.HS[t * 512 + ch] = bv[j];
                    else { const float hsum = p.HS[t * 512 + ch] + bv[j]; const float xg = bf2f(p.Zb[t * 1536 + 1024 + ch]);
                        p.CAT[t * D + 512 + ch] = f2bf(hsum * gelu_f(xg)); } }
            }
        }
        asm volatile("s_waitcnt vmcnt(0)" ::: "memory");
        if (ctx) { float* nl = p.out + (size_t)NTOK * D + 262144; nl[(b * 2 + d) * 512 + ch] = hst; }
        else if (mode == 0) { float* car = p.LRUcar + (size_t)((b * 2 + d) * 16 + seg) * 1024; car[ch * 2] = aprod; car[ch * 2 + 1] = hst; }
    }
}

__device__ __forceinline__ void scan_phase(const MKP& p, int pass, LAS uchar* lds) {
    int tid = threadIdx.x; asm volatile("" : "+v"(tid));
    const int wid = tid >> 6, lane = tid & 63;
    LAS uchar* wl = lds + wid * 20480;
    for (int task = blockIdx.x * 8 + wid; task < 1920; task += gridDim.x * 8) {
        int seqid, gh, seg, mode;
        if (task < 1024) { seqid = 32 + (task >> 9); seg = (task >> 5) & 15; gh = task & 31; mode = pass; }
        else if (task < 1536) { const int i = (task - 1024) + pass * 512; seqid = i >> 5; gh = i & 31; seg = 0; mode = 1; }
        else if (task < 1792) { const int i = task - 1536; seqid = 32 + (i >> 7); seg = (i >> 3) & 15; gh = i & 7; mode = pass; }
        else { const int i = (task - 1792) + pass * 128; seqid = i >> 3; gh = i & 7; seg = 0; mode = 1; }
        if (task < 1536) s5_task(p, seqid, gh, seg, mode, wl, lane);
        else lru_task(p, seqid, gh, seg, mode, wl, lane);
    }
}

__device__ __forceinline__ unsigned f2key(float f) { const unsigned u = __float_as_uint(f); return u ^ ((unsigned)((int)u >> 31) | 0x80000000u); }
template <int CTRL> __device__ __forceinline__ unsigned dppu(unsigned x) { return (unsigned)__builtin_amdgcn_update_dpp(0, (int)x, CTRL, 0xf, 0xf, false); }
template <int CTRL> __device__ __forceinline__ float dppf(float x) { return __int_as_float(__builtin_amdgcn_update_dpp(0, __float_as_int(x), CTRL, 0xf, 0xf, false)); }
__device__ __forceinline__ unsigned rowmax_u(unsigned x) { unsigned t; t = dppu<0x121>(x); x = x > t ? x : t; t = dppu<0x122>(x); x = x > t ? x : t; t = dppu<0x124>(x); x = x > t ? x : t; t = dppu<0x128>(x); x = x > t ? x : t; return x; }
__device__ __forceinline__ float rowmax_f(float x) { x = fmaxf(x, dppf<0x121>(x)); x = fmaxf(x, dppf<0x122>(x)); x = fmaxf(x, dppf<0x124>(x)); x = fmaxf(x, dppf<0x128>(x)); return x; }
__device__ __forceinline__ float rowsum_f(float x) { x += dppf<0x121>(x); x += dppf<0x122>(x); x += dppf<0x124>(x); x += dppf<0x128>(x); return x; }
#define CEX(a, b) { const unsigned _hi = (a) > (b) ? (a) : (b), _lo = (a) > (b) ? (b) : (a); (a) = _hi; (b) = _lo; }

#define PS_ROW 528
#define PS_SV0 135168
#define PS_SI0 151552

struct EpiQ { bf16_t* Q; int m0, n0;
    __device__ __forceinline__ void operator()(const f32x4& v, int row, int col) const {
        u32x2 w; w.x = pk_bf16(v[0], v[1]); w.y = pk_bf16(v[2], v[3]);
        *(u32x2*)(Q + (size_t)(row - m0) * 256 + (col - n0)) = w; }
};

__device__ __forceinline__ void peer_route_phase(const MKP& p, int layer, LAS uchar* lds, const bf16_t* Hsrc, int qmode) {
    const bf16_t* WqT = p.WqT + (size_t)layer * 2048 * 1024;
    for (int item = blockIdx.x; item < 512; item += gridDim.x) {
        const int h = item & 7, pm = item >> 3;
        const bf16_t* Q; int qld;
        if (qmode == 1) { Q = p.Zb + (size_t)pm * 256 * 2048 + h * 256; qld = 2048; }
        else { bf16_t* Qw = p.Zb + (size_t)item * 65536; Q = Qw; qld = 256;
            EpiQ eq{Qw, pm * 256, h * 256};
            gemm_tile<256>(Hsrc, D, WqT, D, D, pm * 256, h * 256, lds, eq);
            asm volatile("s_waitcnt vmcnt(0)" ::: "memory"); }
        __syncthreads();
        int tid = threadIdx.x; asm volatile("" : "+v"(tid));
        const int wid = tid >> 6, lane = tid & 63, fr = lane & 15, fq = lane >> 4;
        const int rbase = 32 * wid;
        float sv1 = 0.f; int si1 = 0;
        for (int half = 0; half < 2; ++half) {
            f32x4 acc[2][8];
#pragma unroll
            for (int m = 0; m < 2; ++m)
#pragma unroll
                for (int n = 0; n < 8; ++n) acc[m][n] = (f32x4){0.f, 0.f, 0.f, 0.f};
            const bf16_t* kb = p.Keysb + ((size_t)(layer * 16 + h * 2 + half) * 128) * 128;
#pragma unroll
            for (int ks = 0; ks < 4; ++ks) {
                bf16x8 qf[2], kf[8];
#pragma unroll
                for (int m = 0; m < 2; ++m) qf[m] = *(const bf16x8*)(Q + (size_t)(rbase + 16 * m + fr) * qld + half * 128 + 32 * ks + 8 * fq);
#pragma unroll
                for (int n = 0; n < 8; ++n) kf[n] = *(const bf16x8*)(kb + (size_t)(16 * n + fr) * 128 + 32 * ks + 8 * fq);
#pragma unroll
                for (int m = 0; m < 2; ++m)
#pragma unroll
                    for (int n = 0; n < 8; ++n) acc[m][n] = __builtin_amdgcn_mfma_f32_16x16x32_bf16(kf[n], qf[m], acc[m][n], 0, 0, 0);
            }
#pragma unroll
            for (int m = 0; m < 2; ++m)
#pragma unroll
                for (int n = 0; n < 8; ++n) *(LAS f32x4*)(lds + (rbase + 16 * m + fr) * PS_ROW + (16 * n + 4 * fq) * 4) = acc[m][n];
            for (int rg = 0; rg < 8; ++rg) {
                const int row = rbase + 4 * rg + fq; const int q = fr;
                const LAS uchar* srow = lds + row * PS_ROW;
                const f32x4 s0 = *(const LAS f32x4*)(srow + 32 * q), s1 = *(const LAS f32x4*)(srow + 32 * q + 16);
                unsigned k0 = (f2key(s0[0]) & ~127u) | (127u - (8 * q + 0)), k1 = (f2key(s0[1]) & ~127u) | (127u - (8 * q + 1)), k2 = (f2key(s0[2]) & ~127u) | (127u - (8 * q + 2)), k3 = (f2key(s0[3]) & ~127u) | (127u - (8 * q + 3));
                unsigned k4 = (f2key(s1[0]) & ~127u) | (127u - (8 * q + 4)), k5 = (f2key(s1[1]) & ~127u) | (127u - (8 * q + 5)), k6 = (f2key(s1[2]) & ~127u) | (127u - (8 * q + 6)), k7 = (f2key(s1[3]) & ~127u) | (127u - (8 * q + 7));
                CEX(k0, k1) CEX(k2, k3) CEX(k4, k5) CEX(k6, k7)
                CEX(k0, k2) CEX(k1, k3) CEX(k4, k6) CEX(k5, k7)
                CEX(k1, k2) CEX(k5, k6)
                CEX(k0, k4) CEX(k1, k5) CEX(k2, k6) CEX(k3, k7)
                CEX(k2, k4) CEX(k3, k5)
                CEX(k1, k2) CEX(k3, k4) CEX(k5, k6)
                unsigned res = 0;
#pragma unroll
                for (int it = 0; it < 16; ++it) { const unsigned mx = rowmax_u(k0); if (q == it) res = mx;
                    if (k0 == mx) { k0 = k1; k1 = k2; k2 = k3; k3 = k4; k4 = k5; k5 = k6; k6 = k7; k7 = 0u; } }
                const int idx = 127 - (int)(res & 127u);
                const float val = *(const LAS float*)(srow + 4 * idx);
                if (half == 0) { *(LAS float*)(lds + PS_SV0 + (row * 16 + q) * 4) = val; *(LAS uchar*)(lds + PS_SI0 + row * 16 + q) = (uchar)idx; }
                else {
                    sv1 = val; si1 = idx;
                    const float sv0 = *(const LAS float*)(lds + PS_SV0 + (row * 16 + q) * 4); const int si0 = *(const LAS uchar*)(lds + PS_SI0 + row * 16 + q);
                    const int rowlane = lane & 48;
                    unsigned c[16];
#pragma unroll
                    for (int j = 0; j < 16; ++j) { const float s = sv0 + __shfl(sv1, rowlane + j); c[j] = (f2key(s) & ~255u) | (255u - (unsigned)(q * 16 + j)); }
                    unsigned res2 = 0;
#pragma unroll
                    for (int it = 0; it < 16; ++it) { const unsigned mx = rowmax_u(c[0]); if (q == it) res2 = mx;
                        if (c[0] == mx) {
#pragma unroll
                            for (int j = 0; j < 15; ++j) c[j] = c[j + 1];
                            c[15] = 0u; } }
                    const int flat = 255 - (int)(res2 & 255u); const int ii = flat >> 4, jj = flat & 15;
                    const float fv = __shfl(sv0, rowlane + ii) + __shfl(sv1, rowlane + jj);
                    const int e0 = __shfl(si0, rowlane + ii), e1 = __shfl(si1, rowlane + jj);
                    const float mx = rowmax_f(fv); const float ex = __expf(fv - mx); const float sm = rowsum_f(ex);
                    const int t = pm * 256 + row;
                    p.EI[(size_t)t * 128 + h * 16 + q] = e0 * 128 + e1;
                    p.EG[(size_t)t * 128 + h * 16 + q] = ex / sm;
                }
            }
        }
        __syncthreads();
    }
}

__device__ __forceinline__ f32x2 fp8lo(unsigned w) { return __builtin_amdgcn_cvt_pk_f32_fp8((int)w, false); }
__device__ __forceinline__ f32x2 fp8hi(unsigned w) { return __builtin_amdgcn_cvt_pk_f32_fp8((int)w, true); }
__device__ __forceinline__ float readlane_f(float x, int l) { return __int_as_float(__builtin_amdgcn_readlane(__float_as_int(x), l)); }

__device__ __forceinline__ void peer_eval_phase(const MKP& p, int layer, const float* gate  , bool last) {
    int tid = threadIdx.x; asm volatile("" : "+v"(tid));
    const int wid = tid >> 6, lane = tid & 63;
    const uchar* U = p.Ub + (size_t)layer * 16384 * 1024; const uchar* V = p.Vb + (size_t)layer * 16384 * 1024;
    const float* SU = p.SU + layer * 16384; const float* SV = p.SV + layer * 16384;
    for (int t = blockIdx.x * 8 + wid; t < NTOK; t += gridDim.x * 8) {
        f32x2 xv[8];
        { const u32x4 h0 = *(const u32x4*)(p.Hb + (size_t)t * D + 16 * lane), h1 = *(const u32x4*)(p.Hb + (size_t)t * D + 16 * lane + 8);
          xv[0] = (f32x2){bflo(h0.x), bfhi(h0.x)}; xv[1] = (f32x2){bflo(h0.y), bfhi(h0.y)}; xv[2] = (f32x2){bflo(h0.z), bfhi(h0.z)}; xv[3] = (f32x2){bflo(h0.w), bfhi(h0.w)};
          xv[4] = (f32x2){bflo(h1.x), bfhi(h1.x)}; xv[5] = (f32x2){bflo(h1.y), bfhi(h1.y)}; xv[6] = (f32x2){bflo(h1.z), bfhi(h1.z)}; xv[7] = (f32x2){bflo(h1.w), bfhi(h1.w)}; }
        const int ei0 = p.EI[(size_t)t * 128 + lane], ei1 = p.EI[(size_t)t * 128 + 64 + lane];
        const float du0 = SU[ei0], du1 = SU[ei1];
        const float gv0 = p.EG[(size_t)t * 128 + lane] * SV[ei0], gv1 = p.EG[(size_t)t * 128 + 64 + lane] * SV[ei1];
        f32x2 acc[8];
#pragma unroll
        for (int i = 0; i < 8; ++i) acc[i] = (f32x2){0.f, 0.f};
        u32x4 uA[4], vA[4], uB[4], vB[4];
#define PE_LOAD(UU, VV, g) { _Pragma("unroll") for (int i = 0; i < 4; ++i) { const int e = 4 * (g) + i; \
            const int idx = __builtin_amdgcn_readlane(e < 64 ? ei0 : ei1, e & 63); \
            UU[i] = *(const u32x4*)(U + (size_t)idx * D + 16 * lane); VV[i] = *(const u32x4*)(V + (size_t)idx * D + 16 * lane); } }
#define PE_COMPUTE(UU, VV, g) { float d0, d1, d2, d3; \
            { f32x2 a; \
              a = xv[0] * fp8lo(UU[0].x); a = xv[1] * fp8hi(UU[0].x) + a; a = xv[2] * fp8lo(UU[0].y) + a; a = xv[3] * fp8hi(UU[0].y) + a; a = xv[4] * fp8lo(UU[0].z) + a; a = xv[5] * fp8hi(UU[0].z) + a; a = xv[6] * fp8lo(UU[0].w) + a; a = xv[7] * fp8hi(UU[0].w) + a; d0 = a[0] + a[1]; \
              a = xv[0] * fp8lo(UU[1].x); a = xv[1] * fp8hi(UU[1].x) + a; a = xv[2] * fp8lo(UU[1].y) + a; a = xv[3] * fp8hi(UU[1].y) + a; a = xv[4] * fp8lo(UU[1].z) + a; a = xv[5] * fp8hi(UU[1].z) + a; a = xv[6] * fp8lo(UU[1].w) + a; a = xv[7] * fp8hi(UU[1].w) + a; d1 = a[0] + a[1]; \
              a = xv[0] * fp8lo(UU[2].x); a = xv[1] * fp8hi(UU[2].x) + a; a = xv[2] * fp8lo(UU[2].y) + a; a = xv[3] * fp8hi(UU[2].y) + a; a = xv[4] * fp8lo(UU[2].z) + a; a = xv[5] * fp8hi(UU[2].z) + a; a = xv[6] * fp8lo(UU[2].w) + a; a = xv[7] * fp8hi(UU[2].w) + a; d2 = a[0] + a[1]; \
              a = xv[0] * fp8lo(UU[3].x); a = xv[1] * fp8hi(UU[3].x) + a; a = xv[2] * fp8lo(UU[3].y) + a; a = xv[3] * fp8hi(UU[3].y) + a; a = xv[4] * fp8lo(UU[3].z) + a; a = xv[5] * fp8hi(UU[3].z) + a; a = xv[6] * fp8lo(UU[3].w) + a; a = xv[7] * fp8hi(UU[3].w) + a; d3 = a[0] + a[1]; } \
              \
            float k0 = (lane & 1) ? d1 : d0, s0 = (lane & 1) ? d0 : d1, k1 = (lane & 1) ? d3 : d2, s1 = (lane & 1) ? d2 : d3; \
            k0 += dppf<0xB1>(s0); k1 += dppf<0xB1>(s1); \
            float kk = (lane & 2) ? k1 : k0, ss = (lane & 2) ? k0 : k1; \
            kk += dppf<0x4E>(ss); kk += dppf<0x124>(kk); kk += dppf<0x128>(kk); kk += __shfl_xor(kk, 16); kk += __shfl_xor(kk, 32); \
            _Pragma("unroll") for (int i = 0; i < 4; ++i) { const int e = 4 * (g) + i; \
                const float sdot = readlane_f(kk, i) * readlane_f(e < 64 ? du0 : du1, e & 63); \
                const float cf = readlane_f(e < 64 ? gv0 : gv1, e & 63) * gelu_f(sdot); const f32x2 c2 = {cf, cf}; \
                acc[0] = c2 * fp8lo(VV[i].x) + acc[0]; acc[1] = c2 * fp8hi(VV[i].x) + acc[1]; acc[2] = c2 * fp8lo(VV[i].y) + acc[2]; acc[3] = c2 * fp8hi(VV[i].y) + acc[3]; \
                acc[4] = c2 * fp8lo(VV[i].z) + acc[4]; acc[5] = c2 * fp8hi(VV[i].z) + acc[5]; acc[6] = c2 * fp8lo(VV[i].w) + acc[6]; acc[7] = c2 * fp8hi(VV[i].w) + acc[7]; } }
        PE_LOAD(uA, vA, 0)
        for (int g = 0; g < 32; g += 2) {
            PE_LOAD(uB, vB, g + 1)
            PE_COMPUTE(uA, vA, g)
            if (g + 2 < 32) PE_LOAD(uA, vA, g + 2)
            PE_COMPUTE(uB, vB, g + 1)
        }
#undef PE_LOAD
#undef PE_COMPUTE
        float* xr = p.X + (size_t)t * D + 16 * lane; const float* gt = gate + (size_t)tok_cv(t) * 6144 + 16 * lane;
        float xn[16]; float ssq = 0.f;
#pragma unroll
        for (int v4 = 0; v4 < 4; ++v4) { const f32x4 x = *(const f32x4*)(xr + 4 * v4), gg = *(const f32x4*)(gt + 4 * v4); f32x4 o;
            o[0] = x[0] + gg[0] * acc[2 * v4][0]; o[1] = x[1] + gg[1] * acc[2 * v4][1]; o[2] = x[2] + gg[2] * acc[2 * v4 + 1][0]; o[3] = x[3] + gg[3] * acc[2 * v4 + 1][1];
#pragma unroll
            for (int e = 0; e < 4; ++e) { xn[4 * v4 + e] = o[e]; ssq += o[e] * o[e]; }
            *(f32x4*)(xr + 4 * v4) = o; }
        ssq = wave_sum(ssq);
        const float rstd = rsqrtf(ssq * (1.f / D) + EPSV);
        if (!last) {
            const float* gv = p.norm1_g + D + 16 * lane; const float* mv = p.modv + 3 * 6144 + (size_t)tok_cv(t) * 6144 + 16 * lane;
            float y[16];
#pragma unroll
            for (int e = 0; e < 16; ++e) y[e] = xn[e] * rstd * gv[e] * (1.f + mv[D + e]) + mv[e];
            u32x4 w0, w1; w0.x = pk_bf16(y[0], y[1]); w0.y = pk_bf16(y[2], y[3]); w0.z = pk_bf16(y[4], y[5]); w0.w = pk_bf16(y[6], y[7]);
            w1.x = pk_bf16(y[8], y[9]); w1.y = pk_bf16(y[10], y[11]); w1.z = pk_bf16(y[12], y[13]); w1.w = pk_bf16(y[14], y[15]);
            *(u32x4*)(p.Hb + (size_t)t * D + 16 * lane) = w0; *(u32x4*)(p.Hb + (size_t)t * D + 16 * lane + 8) = w1;
        } else {
#pragma unroll
            for (int v4 = 0; v4 < 4; ++v4) { const f32x4 gg = *(const f32x4*)(p.final_g + 16 * lane + 4 * v4); f32x4 o;
#pragma unroll
                for (int e = 0; e < 4; ++e) o[e] = xn[4 * v4 + e] * rstd * gg[e];
                *(f32x4*)(p.out + (size_t)t * D + 16 * lane + 4 * v4) = o; }
        }
    }
}

__device__ __forceinline__ void hy_conv_phase(const MKP& p, LAS uchar* lds) {
    int tid = threadIdx.x; asm volatile("" : "+v"(tid));
    LAS bf16_t* tl = (LAS bf16_t*)lds;
    for (int item = blockIdx.x; item < 4096; item += gridDim.x) {
        const int tt = item >> 4, cgp = item & 15; const int t0 = tt * 64, c0 = cgp * 64;
        const int tok = tid >> 3, cseg = tid & 7; const int t = t0 + tok; const int c = c0 + 8 * cseg;
        const int rowlen = t < CTX_TOK ? 256 : 64; const int pos = (t < CTX_TOK ? t : t - CTX_TOK) % rowlen;
        const bool vm = pos > 0, vp = pos < rowlen - 1;
        float r[3][8];
#pragma unroll
        for (int part = 0; part < 3; ++part) { const int cc = part * 1024 + c;
            const u32x4 z0 = *(const u32x4*)(p.Zb + (size_t)t * 3072 + cc);
            u32x4 zm = {0u, 0u, 0u, 0u}, zp = {0u, 0u, 0u, 0u};
            if (vm) zm = *(const u32x4*)(p.Zb + (size_t)(t - 1) * 3072 + cc);
            if (vp) zp = *(const u32x4*)(p.Zb + (size_t)(t + 1) * 3072 + cc);
            const unsigned zmu[4] = {zm.x, zm.y, zm.z, zm.w}, z0u[4] = {z0.x, z0.y, z0.z, z0.w}, zpu[4] = {zp.x, zp.y, zp.z, zp.w};
#pragma unroll
            for (int e = 0; e < 8; ++e) { const float a = (e & 1) ? bfhi(zmu[e >> 1]) : bflo(zmu[e >> 1]), b = (e & 1) ? bfhi(z0u[e >> 1]) : bflo(z0u[e >> 1]), cpl = (e & 1) ? bfhi(zpu[e >> 1]) : bflo(zpu[e >> 1]);
                r[part][e] = p.hy_conv_b[cc + e] + p.hy_conv_w[cc + e] * a + p.hy_conv_w[3072 + cc + e] * b + p.hy_conv_w[6144 + cc + e] * cpl; } }
        float vg[8];
#pragma unroll
        for (int e = 0; e < 8; ++e) vg[e] = r[2][e] * r[1][e];
        u32x4 w0, w1;
        w0.x = pk_bf16(r[0][0], r[0][1]); w0.y = pk_bf16(r[0][2], r[0][3]); w0.z = pk_bf16(r[0][4], r[0][5]); w0.w = pk_bf16(r[0][6], r[0][7]);
        w1.x = pk_bf16(vg[0], vg[1]); w1.y = pk_bf16(vg[2], vg[3]); w1.z = pk_bf16(vg[4], vg[5]); w1.w = pk_bf16(vg[6], vg[7]);
        *(u32x4*)(p.X0C + (size_t)t * D + c) = w0;
        *(u32x4*)(p.VG + (size_t)t * D + c) = w1;
        __syncthreads();
#pragma unroll
        for (int e = 0; e < 8; ++e) tl[(8 * cseg + e) * 72 + tok] = f2bf(vg[e]);
        __syncthreads();
        { const int cc = tid >> 3, ts = tid & 7; const u32x4 w = *(const LAS u32x4*)(tl + cc * 72 + 8 * ts);
          *(u32x4*)(p.VT + (size_t)(c0 + cc) * NTOK + t0 + 8 * ts) = w; }
    }
}

#define HL_C1 16448
#define HL_V 32896
#define HL_ACC 49408
__device__ __forceinline__ void hy_long_phase(const MKP& p, LAS uchar* lds) {
    int tid = threadIdx.x; asm volatile("" : "+v"(tid));
    const int wid = tid >> 6, lane = tid & 63, r = lane & 31, hh = lane >> 5;
    for (int item = blockIdx.x; item < 2048; item += gridDim.x) {
        const int pass = item < 1024 ? 1 : 0; const int c = item & 1023;
        const int L = pass ? 4096 : 256, NA = pass ? 64 : 4, RL = 2 * L;
        const bf16_t* R = p.Rf + (pass ? (size_t)1024 * 512 : 0) + (size_t)c * RL;
        const bf16_t* Vc = p.VT + (size_t)c * NTOK + (pass ? CTX_TOK : 0);
        __syncthreads();
        for (int ch = tid; ch < RL / 16; ch += NTHR) {
            const unsigned* src = (const unsigned*)(R + ch * 16);
            unsigned w[9];
#pragma unroll
            for (int i = 0; i < 8; ++i) w[i] = src[i];
            w[8] = (ch * 16 + 16 < RL) ? src[8] : 0u;
            LAS unsigned* d0 = (LAS unsigned*)(lds + ch * 32); LAS unsigned* d1 = (LAS unsigned*)(lds + HL_C1 + ch * 32);
#pragma unroll
            for (int i = 0; i < 8; ++i) { d0[i] = w[i]; d1[i] = (w[i] >> 16) | (w[i + 1] << 16); }
        }
        for (int ch = tid; ch < 1024; ch += NTHR) *(LAS u32x4*)(lds + HL_V + ch * 16) = *(const u32x4*)(Vc + ch * 8);
        for (int i = tid; i < 128 * 65; i += NTHR) *(LAS float*)(lds + HL_ACC + i * 4) = 0.f;
        __syncthreads();
        f32x16 acc[2][4];
#pragma unroll
        for (int mt = 0; mt < 2; ++mt)
#pragma unroll
            for (int nt = 0; nt < 4; ++nt)
#pragma unroll
                for (int e = 0; e < 16; ++e) acc[mt][nt][e] = 0.f;
        const int dlo = -(NA - 1), dhi = NA - 1;
        const int cpo = (r & 1) ? 0 : HL_C1;
        for (int dl = dlo + wid; dl <= dhi; dl += 8) {
            bool act[4]; int vblk[4]; bool vok[4];
#pragma unroll
            for (int nt = 0; nt < 4; ++nt) { const int col = 32 * nt + r; const int a = col % NA; vok[nt] = (a - dl >= 0) && (a - dl < NA); vblk[nt] = vok[nt] ? col - dl : 0;
                act[nt] = __any((int)vok[nt]); }
#pragma unroll
            for (int ks = 0; ks < 4; ++ks) {
                bf16x8 af[2], bfv[4];
#pragma unroll
                for (int mt = 0; mt < 2; ++mt) { const int x = (L - 1) - 64 * dl - 32 * mt - r + 16 * ks + 8 * hh; const int xe = x & ~1;
                    const LAS unsigned* src = (const LAS unsigned*)(lds + cpo + xe * 2);
                    u32x4 w; w.x = src[0]; w.y = src[1]; w.z = src[2]; w.w = src[3]; af[mt] = __builtin_bit_cast(bf16x8, w); }
#pragma unroll
                for (int nt = 0; nt < 4; ++nt) { u32x4 w = *(const LAS u32x4*)(lds + HL_V + vblk[nt] * 128 + (16 * ks + 8 * hh) * 2);
                    if (!vok[nt]) w = (u32x4){0u, 0u, 0u, 0u}; bfv[nt] = __builtin_bit_cast(bf16x8, w); }
#pragma unroll
                for (int nt = 0; nt < 4; ++nt) if (act[nt]) {
#pragma unroll
                    for (int mt = 0; mt < 2; ++mt) acc[mt][nt] = __builtin_amdgcn_mfma_f32_32x32x16_bf16(af[mt], bfv[nt], acc[mt][nt], 0, 0, 0); }
            }
        }
#pragma unroll
        for (int mt = 0; mt < 2; ++mt)
#pragma unroll
            for (int nt = 0; nt < 4; ++nt)
#pragma unroll
                for (int e = 0; e < 16; ++e) { const int i = 32 * mt + (e & 3) + 8 * (e >> 2) + 4 * hh; const int col = 32 * nt + r;
                    atomicAdd((float*)(lds + HL_ACC) + col * 65 + i, acc[mt][nt][e]); }
        __syncthreads();
        { const float nrm = rsqrtf(p.NORMSQ[(pass ? 1024 : 0) + c] + EPSV);
          const int col = tid >> 2, i0 = 16 * (tid & 3); const LAS float* a = (const LAS float*)(lds + HL_ACC) + col * 65 + i0;
          u32x4 w0, w1;
          w0.x = pk_bf16(a[0] * nrm, a[1] * nrm); w0.y = pk_bf16(a[2] * nrm, a[3] * nrm); w0.z = pk_bf16(a[4] * nrm, a[5] * nrm); w0.w = pk_bf16(a[6] * nrm, a[7] * nrm);
          w1.x = pk_bf16(a[8] * nrm, a[9] * nrm); w1.y = pk_bf16(a[10] * nrm, a[11] * nrm); w1.z = pk_bf16(a[12] * nrm, a[13] * nrm); w1.w = pk_bf16(a[14] * nrm, a[15] * nrm);
          bf16_t* dst = p.YT + (size_t)c * NTOK + (pass ? CTX_TOK : 0) + col * 64 + i0;
          *(u32x4*)dst = w0; *(u32x4*)(dst + 8) = w1; }
    }
}

__device__ __forceinline__ void hy_gate_phase(const MKP& p, LAS uchar* lds) {
    int tid = threadIdx.x; asm volatile("" : "+v"(tid));
    LAS bf16_t* tl = (LAS bf16_t*)lds;
    for (int item = blockIdx.x; item < 4096; item += gridDim.x) {
        const int tt = item >> 4, cgp = item & 15; const int t0 = tt * 64, c0 = cgp * 64;
        __syncthreads();
        { const int cc = tid >> 3, ts = tid & 7; *(LAS u32x4*)(tl + cc * 72 + 8 * ts) = *(const u32x4*)(p.YT + (size_t)(c0 + cc) * NTOK + t0 + 8 * ts); }
        __syncthreads();
        const int tok = tid >> 3, cseg = tid & 7; const int t = t0 + tok, c = c0 + 8 * cseg;
        const u32x4 x0 = *(const u32x4*)(p.X0C + (size_t)t * D + c), vgp = *(const u32x4*)(p.VG + (size_t)t * D + c);
        const unsigned x0u[4] = {x0.x, x0.y, x0.z, x0.w}, vgu[4] = {vgp.x, vgp.y, vgp.z, vgp.w};
        float y[8];
#pragma unroll
        for (int e = 0; e < 8; ++e) { const float cv = bf2f(tl[(8 * cseg + e) * 72 + tok]); const float vv = (e & 1) ? bfhi(vgu[e >> 1]) : bflo(vgu[e >> 1]), xx = (e & 1) ? bfhi(x0u[e >> 1]) : bflo(x0u[e >> 1]);
            y[e] = (cv + p.hy_bias[c + e] * vv) * xx; }
        u32x4 w; w.x = pk_bf16(y[0], y[1]); w.y = pk_bf16(y[2], y[3]); w.z = pk_bf16(y[4], y[5]); w.w = pk_bf16(y[6], y[7]);
        *(u32x4*)(p.CAT + (size_t)t * D + c) = w;
    }
}

extern __shared__ __attribute__((aligned(16))) unsigned char smem_raw[];
#define MK_LDS_BYTES 163840

#define XB_TMO      128
#define XB_XCNT(j)  (256  + 64 * (j))
#define XB_XSUB(j)  (1280 + 64 * (j))
#define XB_XGEN(j)  (2304 + 64 * (j))
#define XB_TOP      3328
#define XB_TOPGEN   3392
#define XCD_BAR_WORDS 3456
#define XB_SPIN_CAP (1u << 20)
__device__ __forceinline__ unsigned xb_ld(unsigned* q) { return __hip_atomic_load(q, __ATOMIC_RELAXED, __HIP_MEMORY_SCOPE_AGENT); }
__device__ __forceinline__ unsigned xb_add(unsigned* q, unsigned v) { return __hip_atomic_fetch_add(q, v, __ATOMIC_RELAXED, __HIP_MEMORY_SCOPE_AGENT); }
__device__ __forceinline__ unsigned xb_xcc_id() { return (unsigned)__builtin_amdgcn_s_getreg((3 << 11) | 20) & 0xFu; }
#define XB_SPIN(cond, bar) do { unsigned _sp = 0; while (cond) { __builtin_amdgcn_s_sleep(1); \
    if ((++_sp & 255u) == 0u) { if (xb_ld(&(bar)[XB_TMO])) break; if (_sp > XB_SPIN_CAP) { atomicAdd(&(bar)[XB_TMO], 1u); break; } } } } while (0)
struct XcdBarrier { unsigned* bar; unsigned x; volatile LAS unsigned* st; };
__device__ __forceinline__ XcdBarrier xcd_barrier_post(unsigned* bar, volatile LAS unsigned* st) {
    XcdBarrier b; b.bar = bar; b.x = xb_xcc_id(); b.st = st;
    if (threadIdx.x == 0) (void)xb_add(&bar[XB_XCNT(b.x)], 1u);
    return b;
}
__device__ __forceinline__ void xcd_barrier_complete(unsigned* bar, unsigned x, unsigned& nloc, unsigned& nx) {
    const unsigned G = gridDim.x * gridDim.y * gridDim.z;
    unsigned sum, cnt, mine, sp = 0u;
    for (;;) {
        sum = 0u; cnt = 0u; mine = 0u;
#pragma unroll
        for (unsigned j = 0; j < 16; ++j) { const unsigned c = xb_ld(&bar[XB_XCNT(j)]); sum += c; cnt += (c > 0u) ? 1u : 0u; mine = (j == x) ? c : mine; }
        if (sum == G) break;
        __builtin_amdgcn_s_sleep(1);
        if ((++sp & 255u) == 0u) { if (xb_ld(&bar[XB_TMO])) break; if (sp > XB_SPIN_CAP) { atomicAdd(&bar[XB_TMO], 1u); break; } }
    }
    nloc = mine > 0u ? mine : 1u; nx = cnt > 0u ? cnt : 1u;
}
__device__ __forceinline__ void xcd_barrier(const XcdBarrier& b) {
    asm volatile("s_waitcnt vmcnt(0)" ::: "memory");
    __syncthreads();
    if (threadIdx.x == 0) {
        unsigned* bar = b.bar;
        __builtin_amdgcn_s_waitcnt(0);
        unsigned nloc = b.st[0], nx = b.st[1];
        if (nloc == 0u) { xcd_barrier_complete(bar, b.x, nloc, nx); b.st[0] = nloc; b.st[1] = nx; }
        const unsigned old = xb_add(&bar[XB_XSUB(b.x)], 1u);
        const unsigned gen = old / nloc;
        if (old + 1u == (gen + 1u) * nloc) {
            __builtin_amdgcn_fence(__ATOMIC_RELEASE, "agent");
            asm volatile("s_waitcnt vmcnt(0)" ::: "memory");
            const unsigned og = xb_add(&bar[XB_TOP], 1u);
            const unsigned tg = og / nx;
            if (og + 1u == (tg + 1u) * nx) xb_add(&bar[XB_TOPGEN], 1u);
            else XB_SPIN(xb_ld(&bar[XB_TOPGEN]) == tg, bar);
            __builtin_amdgcn_fence(__ATOMIC_ACQUIRE, "agent");
            xb_add(&bar[XB_XGEN(b.x)], 1u);
            asm volatile("s_waitcnt vmcnt(0)" ::: "memory");
        } else {
            XB_SPIN(xb_ld(&bar[XB_XGEN(b.x)]) == gen, bar);
            __builtin_amdgcn_fence(__ATOMIC_ACQUIRE, "agent");
            asm volatile("s_waitcnt vmcnt(0)" ::: "memory");
        }
    }
    __syncthreads();
}
#define MK_BAR_LDS_OFF (MK_LDS_BYTES - 16)

#define GSYNC_CG() do { asm volatile("s_waitcnt vmcnt(0)" ::: "memory"); grid.sync(); \
    if (threadIdx.x == 0) { __builtin_amdgcn_fence(__ATOMIC_ACQUIRE, "agent"); asm volatile("s_waitcnt vmcnt(0)" ::: "memory"); } __syncthreads(); } while (0)
#define GSYNC() xcd_barrier(xb)

__global__ void __launch_bounds__(NTHR) mega_fwd(MKP p) {
    cg::grid_group grid = cg::this_grid();
    LAS uchar* lds = (LAS uchar*)smem_raw;
    volatile LAS unsigned* xst = (volatile LAS unsigned*)(lds + MK_BAR_LDS_OFF);
    if (threadIdx.x == 0) { xst[0] = 0u; xst[1] = 0u; }
    __syncthreads();
    const XcdBarrier xb = xcd_barrier_post(p.bar, xst);
    phase0(p, lds);
    GSYNC_CG();
#pragma nounroll
    for (int layer = 0; layer < 2; ++layer) {
        const float* mv = p.modv + layer * 3 * 6144;
        if (layer == 0) {
            norm_phase(p, true, p.norm1_g, mv, 0, 1, p.Hb);
            hyfilt_phase(p, lds);
            GSYNC();
            { EpiStoreBf16 e{p.Zb, 1536, nullptr}; gemm_phase<128>(p.Hb, D, p.WinT, D, D, NTOK, 1536, lds, e); }
            GSYNC();
#pragma nounroll
            for (int pass = 0; pass < 2; ++pass) { scan_phase(p, pass, lds); GSYNC(); }
            { EpiGlu e{p.ZS, p.CAT, p.s5_b_glu}; gemm_phase<128>(p.ZS, 512, p.WgluT, 512, 512, NTOK, 512, lds, e); }
            GSYNC();
        } else {
            { EpiStoreBf16 e{p.Zb, 3072, p.b_in_c}; gemm_phase<256>(p.Hb, D, p.WincT, D, D, NTOK, 3072, lds, e); }
            GSYNC();
            hy_conv_phase(p, lds);
            GSYNC();
            hy_long_phase(p, lds);
            GSYNC();
            hy_gate_phase(p, lds);
            GSYNC();
        }
        { EpiResid e{&p, layer == 0, mv + 2 * D, layer ? p.b_out_c : nullptr}; gemm_phase<256>(p.CAT, D, layer ? p.WoutcT : p.WoutT, D, D, NTOK, D, lds, e); }
        if (p.stop_after == 1 + 2 * layer) return;
        GSYNC();
        norm_phase(p, false, p.norm2_g + layer * D, mv, 3, 4, p.Hb);
        if (p.stop_after == 14 && layer == 0) return;
        GSYNC();
        peer_route_phase(p, layer, lds, p.Hb, 0);
        if (p.stop_after == 15 && layer == 0) return;
        GSYNC();
        peer_eval_phase(p, layer, mv + 5 * D, layer == 1);
        if (p.stop_after == 2 && layer == 0) return;
        if (layer == 0) GSYNC();
    }
}

static void mk_fill_params(MKP& p, void* const* d_in, void* d_out, void* d_ws) {
    const float** f = (const float**)&p;
    for (int i = 0; i < 50; ++i) f[i] = (const float*)d_in[i];
    p.out = (float*)d_out;
    unsigned char* ws = (unsigned char*)d_ws; size_t off = 0;
    auto take = [&](size_t bytes) { unsigned char* q = ws + off; off += (bytes + 255) & ~(size_t)255; return q; };
    p.X = (float*)take((size_t)NTOK * D * 4);
    p.Hb = (bf16_t*)take((size_t)NTOK * D * 2);
    p.Zb = (bf16_t*)take((size_t)NTOK * 3072 * 2);
    p.CAT = (bf16_t*)take((size_t)NTOK * D * 2);
    unsigned char* regA = take((size_t)96 << 20);
    p.ZS = (bf16_t*)regA; p.HS = (float*)(regA + ((size_t)16 << 20)); p.Qs = (bf16_t*)(regA + ((size_t)48 << 20));
    p.EI = (int*)(regA + ((size_t)80 << 20)); p.EG = (float*)(regA + ((size_t)88 << 20));
    p.X0C = (bf16_t*)regA; p.VG = (bf16_t*)(regA + ((size_t)32 << 20)); p.VT = (bf16_t*)(regA + ((size_t)64 << 20));
    p.YT = p.Zb;
    p.Ub = (uchar*)take((size_t)2 * 16384 * 1024); p.Vb = (uchar*)take((size_t)2 * 16384 * 1024);
    p.SU = (float*)take(2 * 16384 * 4); p.SV = (float*)take(2 * 16384 * 4); p.bar = (unsigned*)take(16384);
    p.WinT = (bf16_t*)take((size_t)1536 * 1024 * 2); p.WgluT = (bf16_t*)take((size_t)512 * 512 * 2); p.WoutT = (bf16_t*)take((size_t)1024 * 1024 * 2);
    p.WincT = (bf16_t*)take((size_t)3072 * 1024 * 2); p.WoutcT = (bf16_t*)take((size_t)1024 * 1024 * 2); p.WqT = (bf16_t*)take((size_t)2 * 2048 * 1024 * 2);
    p.Keysb = (bf16_t*)take((size_t)2 * 16 * 128 * 128 * 2); p.WaT = (bf16_t*)take((size_t)16 * 4096 * 2); p.WxT = (bf16_t*)take((size_t)16 * 4096 * 2);
    p.Bmat = (bf16_t*)take((size_t)64 * 128 * 16 * 2); p.CmT = (bf16_t*)take((size_t)64 * 16 * 128 * 2);
    p.abar = (float*)take(4096 * 2 * 4); p.aL = (float*)take(4096 * 2 * 4);
    p.S5car = (float*)take((size_t)2 * 2 * 32 * 16 * 128 * 4); p.LRUcar = (float*)take((size_t)2 * 2 * 16 * 1024 * 4);
    p.modv = (float*)take(2 * 3 * 6144 * 4); p.Z2 = (float*)take((size_t)4352 * 64 * 4); p.NORMSQ = (float*)take(2048 * 4);
    p.Rf = (bf16_t*)take(((size_t)1024 * 512 + (size_t)1024 * 8192) * 2);
    p.stop_after = 0; p.pad0 = 0;
}

#include <string.h>
#ifndef MK_STOP_AFTER
#define MK_STOP_AFTER 0
#endif
extern "C" void kernel_launch(void* const* d_in, const int* in_sizes, int n_in, void* d_out, int out_size, void* d_ws, size_t ws_size, hipStream_t stream) {
    static int grid_blocks = 0;
    if (!grid_blocks) {
        int dev = 0, cus = 0, per_cu = 0;
        (void)hipGetDevice(&dev);
        (void)hipDeviceGetAttribute(&cus, hipDeviceAttributeMultiprocessorCount, dev);
        (void)hipFuncSetAttribute((const void*)mega_fwd, hipFuncAttributeMaxDynamicSharedMemorySize, MK_LDS_BYTES);
        (void)hipOccupancyMaxActiveBlocksPerMultiprocessor(&per_cu, (const void*)mega_fwd, NTHR, MK_LDS_BYTES);
        if (per_cu > 1) per_cu = 1;
        grid_blocks = cus * per_cu; if (grid_blocks > 256) grid_blocks = 256;
        if (grid_blocks < 1) { fprintf(stderr, "mega_fwd: occupancy query returned 0 blocks per CU\n"); grid_blocks = 0; return; }
    }
    MKP p; memset(&p, 0, sizeof(p));
    mk_fill_params(p, d_in, d_out, d_ws);
    p.stop_after = MK_STOP_AFTER;
    (void)hipMemsetAsync(p.bar, 0, XCD_BAR_WORDS * 4, stream);
    void* args[] = {&p};
    hipError_t e = hipLaunchCooperativeKernel((const void*)mega_fwd, dim3(grid_blocks), dim3(NTHR), args, MK_LDS_BYTES, stream);
    if (e != hipSuccess) fprintf(stderr, "cooperative launch failed: %s (grid %d)\n", hipGetErrorString(e), grid_blocks);
#if MK_STOP_AFTER != 0
    nv::naive_tail(MK_STOP_AFTER, d_in, d_out, d_ws, stream);
#endif
}
```

```cpp
#include <hip/hip_runtime.h>
#include <hip/hip_cooperative_groups.h>
#include <stdint.h>
#include <math.h>
#include <stdio.h>
namespace cg = cooperative_groups;

#define D 1024
#define NTOK 16384
#define CTX_TOK 8192
#define EPSV 1e-6f
#define NTHR 512
#define LAS __attribute__((address_space(3)))
#define GAS __attribute__((address_space(1)))

typedef unsigned short bf16_t;
typedef unsigned char uchar;
typedef short bf16x8 __attribute__((ext_vector_type(8)));
typedef float f32x4 __attribute__((ext_vector_type(4)));
typedef float f32x2 __attribute__((ext_vector_type(2)));
typedef float f32x16 __attribute__((ext_vector_type(16)));
typedef unsigned u32x4 __attribute__((ext_vector_type(4)));
typedef unsigned u32x2 __attribute__((ext_vector_type(2)));
typedef __bf16 bf16x2v __attribute__((ext_vector_type(2)));

struct MKP {
    const float *x_prompt, *x_sample, *st_re, *st_im, *st_lru, *c, *c_ctx, *norm1_g, *norm2_g, *w_mod, *b_mod, *w_in_ab,
        *s5_a_re, *s5_a_im, *s5_log_dt, *s5_b_re, *s5_b_im, *s5_c_re, *s5_c_im, *s5_d, *s5_w_glu, *s5_b_glu,
        *lru_conv_w, *lru_conv_b, *lru_w_a, *lru_b_a, *lru_w_x, *lru_b_x, *lru_lambda, *w_out_ab,
        *w_in_c, *b_in_c, *hy_conv_w, *hy_conv_b, *hy_w1, *hy_b1, *hy_f1, *hy_w2, *hy_b2, *hy_f2, *hy_w3, *hy_decay, *hy_bias, *w_out_c, *b_out_c,
        *peer_wq, *peer_keys, *peer_u, *peer_v, *final_g;
    float* out;
    float* X;
    bf16_t* Hb;
    bf16_t* Zb;
    bf16_t* CAT;
    bf16_t* ZS;
    float* HS;
    bf16_t* Qs;
    int* EI; float* EG;
    bf16_t *X0C, *VG, *VT, *YT;
    uchar *Ub, *Vb;
    float *SU, *SV;
    unsigned *bar;
    bf16_t *WinT, *WgluT, *WoutT, *WincT, *WoutcT, *WqT, *Keysb, *WaT, *WxT;
    bf16_t *Bmat, *CmT; float *abar, *aL;
    float *S5car;
    float *LRUcar;
    float *modv;
    float *Z2;
    float *NORMSQ;
    bf16_t *Rf;
    int stop_after; int pad0;
};

__device__ __forceinline__ float bf2f(bf16_t v) { return __uint_as_float((unsigned)v << 16); }
__device__ __forceinline__ float bflo(unsigned p) { return __uint_as_float(p << 16); }
__device__ __forceinline__ float bfhi(unsigned p) { return __uint_as_float(p & 0xffff0000u); }
__device__ __forceinline__ unsigned pk_bf16(float lo, float hi) { const f32x2 v = {lo, hi}; const bf16x2v r = __builtin_convertvector(v, bf16x2v); return __builtin_bit_cast(unsigned, r); }
__device__ __forceinline__ bf16_t f2bf(float x) { return (bf16_t)(pk_bf16(x, 0.f) & 0xffffu); }
__device__ __forceinline__ float sigmoid_f(float x) { return 1.f / (1.f + __expf(-x)); }
__device__ __forceinline__ float gelu_f(float x) { float z = 1.5957691216057308f * (x + 0.044715f * x * x * x); return x / (1.f + __expf(-z)); }
__device__ __forceinline__ float silu_f(float x) { return x / (1.f + __expf(-x)); }
__device__ __forceinline__ int tok_cv(int t) { return t < CTX_TOK ? 0 : 1 + ((t - CTX_TOK) >> 12); }
__device__ __forceinline__ const float* xin_row(const MKP& p, int t) { return t < CTX_TOK ? p.x_prompt + (size_t)t * D : p.x_sample + (size_t)(t - CTX_TOK) * D; }
__device__ __forceinline__ float wave_sum(float v) {
#pragma unroll
    for (int o = 32; o > 0; o >>= 1) v += __shfl_xor(v, o);
    return v;
}
__device__ __forceinline__ void glds16(const void* g, LAS uchar* l) { __builtin_amdgcn_global_load_lds((const GAS void*)g, (LAS void*)l, 16, 0, 0); }

template <int BN, class Epi>
__device__ __forceinline__ void gemm_tile(const bf16_t* A, int lda, const bf16_t* Bt, int ldb, int K, int m0, int n0, LAS uchar* lds, Epi& epi) {
    constexpr int NW = BN / 64;
    constexpr int STAGE = 256 * 128 + BN * 128;
    int tid = threadIdx.x; asm volatile("" : "+v"(tid));
    const int wid = tid >> 6, lane = tid & 63, wr = wid >> 2, wc = wid & 3, fr = lane & 15, fq = lane >> 4;
    f32x4 acc[8][NW];
#pragma unroll
    for (int m = 0; m < 8; ++m)
#pragma unroll
        for (int n = 0; n < NW; ++n) acc[m][n] = (f32x4){0.f, 0.f, 0.f, 0.f};
    const int nk = K >> 6;
    const int srow = lane >> 3, sc = lane & 7;
    auto stage = [&](int kt, int buf) {
        LAS uchar* sb = lds + buf * STAGE;
#pragma unroll
        for (int j = 0; j < 4; ++j) { const int rowl = 8 * (wid + 8 * j) + srow; const int c = sc ^ ((rowl >> 1) & 7);
            glds16(A + (size_t)(m0 + rowl) * lda + kt * 64 + c * 8, sb + rowl * 128 + sc * 16); }
#pragma unroll
        for (int j = 0; j < BN / 64; ++j) { const int rowl = 8 * (wid + 8 * j) + srow; const int c = sc ^ ((rowl >> 1) & 7);
            glds16(Bt + (size_t)(n0 + rowl) * ldb + kt * 64 + c * 8, sb + 32768 + rowl * 128 + sc * 16); }
    };
    __syncthreads();
    stage(0, 0);
    for (int kt = 0; kt < nk; ++kt) {
        asm volatile("s_waitcnt vmcnt(0)" ::: "memory");
        __syncthreads();
        if (kt + 1 < nk) stage(kt + 1, (kt + 1) & 1);
        const LAS uchar* sa = lds + (kt & 1) * STAGE;
        const LAS uchar* sbp = sa + 32768;
#pragma unroll
        for (int kk = 0; kk < 2; ++kk) {
            const int cs = ((kk * 4 + fq) ^ (fr >> 1)) * 16;
            bf16x8 bfr[NW];
#pragma unroll
            for (int n = 0; n < NW; ++n) bfr[n] = *(const LAS bf16x8*)(sbp + (wc * (BN / 4) + n * 16 + fr) * 128 + cs);
#pragma unroll
            for (int mh = 0; mh < 2; ++mh) {
                bf16x8 af[4];
#pragma unroll
                for (int m = 0; m < 4; ++m) af[m] = *(const LAS bf16x8*)(sa + (wr * 128 + (4 * mh + m) * 16 + fr) * 128 + cs);
#pragma unroll
                for (int m = 0; m < 4; ++m)
#pragma unroll
                    for (int n = 0; n < NW; ++n) acc[4 * mh + m][n] = __builtin_amdgcn_mfma_f32_16x16x32_bf16(bfr[n], af[m], acc[4 * mh + m][n], 0, 0, 0);
            }
        }
    }
#pragma unroll
    for (int m = 0; m < 8; ++m)
#pragma unroll
        for (int n = 0; n < NW; ++n) epi(acc[m][n], m0 + wr * 128 + m * 16 + fr, n0 + wc * (BN / 4) + n * 16 + 4 * fq);
}

struct EpiStoreBf16 {
    bf16_t* O; int ldc; const float* bias;
    __device__ __forceinline__ void operator()(const f32x4& v, int row, int col) const {
        f32x4 b = bias ? *(const f32x4*)(bias + col) : (f32x4){0.f, 0.f, 0.f, 0.f};
        u32x2 w; w.x = pk_bf16(v[0] + b[0], v[1] + b[1]); w.y = pk_bf16(v[2] + b[2], v[3] + b[3]);
        *(u32x2*)(O + (size_t)row * ldc + col) = w;
    }
};
struct EpiGlu {
    const bf16_t* ZS; bf16_t* CAT; const float* bias;
    __device__ __forceinline__ void operator()(const f32x4& v, int row, int col) const {
        f32x4 b = *(const f32x4*)(bias + col); u32x2 z = *(const u32x2*)(ZS + (size_t)row * 512 + col);
        float o0 = bflo(z.x) * sigmoid_f(v[0] + b[0]), o1 = bfhi(z.x) * sigmoid_f(v[1] + b[1]), o2 = bflo(z.y) * sigmoid_f(v[2] + b[2]), o3 = bfhi(z.y) * sigmoid_f(v[3] + b[3]);
        u32x2 w; w.x = pk_bf16(o0, o1); w.y = pk_bf16(o2, o3);
        *(u32x2*)(CAT + (size_t)row * D + col) = w;
    }
};
struct EpiResid {
    const MKP* p; bool from_input; const float* gate;   const float* bias;
    __device__ __forceinline__ void operator()(const f32x4& v, int row, int col) const {
        const float* xr = from_input ? xin_row(*p, row) : p->X + (size_t)row * D;
        f32x4 x = *(const f32x4*)(xr + col); f32x4 g = *(const f32x4*)(gate + (size_t)tok_cv(row) * 6144 + col);
        f32x4 b = bias ? *(const f32x4*)(bias + col) : (f32x4){0.f, 0.f, 0.f, 0.f};
        f32x4 o; o[0] = x[0] + g[0] * (v[0] + b[0]); o[1] = x[1] + g[1] * (v[1] + b[1]); o[2] = x[2] + g[2] * (v[2] + b[2]); o[3] = x[3] + g[3] * (v[3] + b[3]);
        *(f32x4*)(p->X + (size_t)row * D + col) = o;
    }
};

template <int BN, class Epi>
__device__ __forceinline__ void gemm_phase(const bf16_t* A, int lda, const bf16_t* Bt, int ldb, int K, int M, int N, LAS uchar* lds, Epi& epi) {
    const int nM = M / 256, nN = N / BN, nt = nM * nN;
    for (int t = blockIdx.x; t < nt; t += gridDim.x) { const int pn = t % nN, pm = t / nN; gemm_tile<BN>(A, lda, Bt, ldb, K, pm * 256, pn * BN, lds, epi); }
}

__device__ __forceinline__ void transpose_tile(const float* src, int K, int N, bf16_t* dst, int k0, int n0, LAS uchar* lds) {
    LAS float* tl = (LAS float*)lds;
    int tid = threadIdx.x; asm volatile("" : "+v"(tid));
    __syncthreads();
#pragma unroll
    for (int i = 0; i < 8; ++i) { const int e = tid + NTHR * i, kr = e >> 6, nc = e & 63; tl[nc * 65 + kr] = src[(size_t)(k0 + kr) * N + n0 + nc]; }
    __syncthreads();
#pragma unroll
    for (int i = 0; i < 4; ++i) { const int e = tid + NTHR * i, nr = e >> 5, kp = e & 31;
        *(unsigned*)(dst + (size_t)(n0 + nr) * K + k0 + 2 * kp) = pk_bf16(tl[nr * 65 + 2 * kp], tl[nr * 65 + 2 * kp + 1]); }
}

__device__ __forceinline__ void phase0(const MKP& p, LAS uchar* lds) {
    int tid = threadIdx.x; asm volatile("" : "+v"(tid));
    const int bid = blockIdx.x, G = gridDim.x, wid = tid >> 6, lane = tid & 63;
    const int gtid = bid * NTHR + tid, gthreads = G * NTHR;
    {
        LAS float* sc = (LAS float*)lds;
        LAS float* red = (LAS float*)(lds + 12288);
        bool have = false;
        for (int it = bid; it < 192; it += G) {
            if (!have) { for (int i = tid; i < 3072; i += NTHR) { const int cv = i >> 10, k = i & 1023; const float x = cv == 0 ? p.c_ctx[k] : p.c[(cv - 1) * D + k]; sc[i] = silu_f(x); } have = true; }
            __syncthreads();
            const int l = it / 96, cgp = it % 96, col = cgp * 64 + lane;
            const float* w = p.w_mod + (size_t)l * D * 6144 + col;
            float a0 = 0.f, a1 = 0.f, a2 = 0.f;
#pragma unroll 8
            for (int k = wid * 128; k < wid * 128 + 128; ++k) { const float wv = w[(size_t)k * 6144]; a0 += sc[k] * wv; a1 += sc[1024 + k] * wv; a2 += sc[2048 + k] * wv; }
            red[(wid * 3 + 0) * 64 + lane] = a0; red[(wid * 3 + 1) * 64 + lane] = a1; red[(wid * 3 + 2) * 64 + lane] = a2;
            __syncthreads();
            if (tid < 192) { const int cv = tid >> 6, ln = tid & 63; float s = p.b_mod[l * 6144 + cgp * 64 + ln];
#pragma unroll
                for (int w8 = 0; w8 < 8; ++w8) s += red[(w8 * 3 + cv) * 64 + ln];
                p.modv[(l * 3 + cv) * 6144 + cgp * 64 + ln] = s; }
        }
        __syncthreads();
    }
    {
        const int ntiles[8] = {384, 64, 256, 768, 256, 512, 512, 32};
        int base = 0;
        for (int mi = 0; mi < 8; ++mi) {
            const float* src; int K, N; bf16_t* dst;
            switch (mi) {
                case 0: src = p.w_in_ab; K = 1024; N = 1536; dst = p.WinT; break;
                case 1: src = p.s5_w_glu; K = 512; N = 512; dst = p.WgluT; break;
                case 2: src = p.w_out_ab; K = 1024; N = 1024; dst = p.WoutT; break;
                case 3: src = p.w_in_c; K = 1024; N = 3072; dst = p.WincT; break;
                case 4: src = p.w_out_c; K = 1024; N = 1024; dst = p.WoutcT; break;
                case 5: src = p.peer_wq; K = 1024; N = 2048; dst = p.WqT; break;
                case 6: src = p.peer_wq + (size_t)1024 * 2048; K = 1024; N = 2048; dst = p.WqT + (size_t)2048 * 1024; break;
                default: src = nullptr; K = 64; N = 64; dst = nullptr; break;
            }
            for (int t = (bid + G - (base % G)) % G; t < ntiles[mi]; t += G) {
                if (mi < 7) { const int nkt = K / 64; const int kt = t % nkt, nt = t / nkt; transpose_tile(src, K, N, dst, kt * 64, nt * 64, lds); }
                else { const int m = t & 15; const bool isx = t >= 16;
                    transpose_tile((isx ? p.lru_w_x : p.lru_w_a) + (size_t)m * 4096, 64, 64, (isx ? p.WxT : p.WaT) + (size_t)m * 4096, 0, 0, lds); }
            }
            base += ntiles[mi];
        }
        __syncthreads();
    }
    {
        auto conv = [&](const float* src, bf16_t* dst, size_t n8) {
            for (size_t i = gtid; i < n8; i += gthreads) { const f32x4 a = *(const f32x4*)(src + i * 8), b = *(const f32x4*)(src + i * 8 + 4);
                u32x4 w; w.x = pk_bf16(a[0], a[1]); w.y = pk_bf16(a[2], a[3]); w.z = pk_bf16(b[0], b[1]); w.w = pk_bf16(b[2], b[3]);
                *(u32x4*)(dst + i * 8) = w; }
        };
        conv(p.peer_keys, p.Keysb, (size_t)2 * 16 * 128 * 128 / 8);
    }
    for (int r = __builtin_amdgcn_readfirstlane(bid * 8 + wid); r < 65536; r += G * 8) {
        const bool isv = r >= 32768; const int rr = r & 32767;
        const float* src = (isv ? p.peer_v : p.peer_u) + (size_t)rr * D;
        f32x4 v[4]; float am = 0.f;
#pragma unroll
        for (int i = 0; i < 4; ++i) { v[i] = *(const f32x4*)(src + 4 * lane + 256 * i);
            am = fmaxf(am, fmaxf(fmaxf(fabsf(v[i][0]), fabsf(v[i][1])), fmaxf(fabsf(v[i][2]), fabsf(v[i][3])))); }
#pragma unroll
        for (int o = 32; o > 0; o >>= 1) am = fmaxf(am, __shfl_xor(am, o));
        const float sc = am > 0.f ? 384.f / am : 1.f;
        uchar* dst = (isv ? p.Vb : p.Ub) + (size_t)rr * D;
#pragma unroll
        for (int i = 0; i < 4; ++i) { int w = 0; w = __builtin_amdgcn_cvt_pk_fp8_f32(v[i][0] * sc, v[i][1] * sc, w, false); w = __builtin_amdgcn_cvt_pk_fp8_f32(v[i][2] * sc, v[i][3] * sc, w, true);
            *(int*)(dst + 4 * lane + 256 * i) = w; }
        if (lane == 0) (isv ? p.SV : p.SU)[rr] = am > 0.f ? am / 384.f : 1.f;
    }
    if (gtid < 4096) {
        const int idx = gtid, dg = idx >> 6, pp = idx & 63;
        const double ar = p.s5_a_re[idx], ai = p.s5_a_im[idx], dt = exp((double)p.s5_log_dt[dg]);
        const double mag = exp(ar * dt), abr = mag * cos(ai * dt), abi = mag * sin(ai * dt);
        const double den = ar * ar + ai * ai, nr = abr - 1.0;
        const double cr = (nr * ar + abi * ai) / den, ci = (abi * ar - nr * ai) / den;
        p.abar[idx * 2] = (float)abr; p.abar[idx * 2 + 1] = (float)abi;
        const double m256 = exp(256.0 * ar * dt), a256 = fmod(256.0 * ai * dt, 6.283185307179586476925);
        p.aL[idx * 2] = (float)(m256 * cos(a256)); p.aL[idx * 2 + 1] = (float)(m256 * sin(a256));
        for (int c = 0; c < 16; ++c) { const double br = p.s5_b_re[idx * 16 + c], bi = p.s5_b_im[idx * 16 + c];
            p.Bmat[((size_t)dg * 128 + 2 * pp) * 16 + c] = f2bf((float)(cr * br - ci * bi));
            p.Bmat[((size_t)dg * 128 + 2 * pp + 1) * 16 + c] = f2bf((float)(cr * bi + ci * br));
            p.CmT[((size_t)dg * 16 + c) * 128 + 2 * pp] = f2bf(p.s5_c_re[((size_t)dg * 16 + c) * 64 + pp]);
            p.CmT[((size_t)dg * 16 + c) * 128 + 2 * pp + 1] = f2bf(-p.s5_c_im[((size_t)dg * 16 + c) * 64 + pp]); }
    }
    for (int pi = __builtin_amdgcn_readfirstlane(bid * 8 + wid); pi < 4352; pi += G * 8) {
        const int L = pi < 256 ? 256 : 4096, pos = pi < 256 ? pi : pi - 256; const int j = lane;
        float emb = 0.f;
        if (j == 0) emb = (float)pos / (float)L;
        else if (j < 33) { const int bi = (j - 1) & 15; const float band = 1e-4f + (15.f - 1e-4f) * (float)bi / 15.f;
            const float ang = (6.283185307179586f / (float)L) * (float)pos * band; emb = j <= 16 ? cosf(ang) : -sinf(ang); }
        float a = p.hy_b1[j];
        for (int k = 0; k < 33; ++k) a += __shfl(emb, k) * p.hy_w1[k * 64 + j];
        const float z1 = sinf(p.hy_f1[j] * a);
        float c2 = p.hy_b2[j];
        for (int k = 0; k < 64; ++k) c2 += __shfl(z1, k) * p.hy_w2[k * 64 + j];
        p.Z2[(size_t)pi * 64 + j] = sinf(p.hy_f2[j] * c2);
    }
    if (gtid < 2048) p.NORMSQ[gtid] = 0.f;
}

__device__ __forceinline__ void norm_one(const MKP& p, const float* xr, int t, const float* gvec, const float* modv_l, int sh_chunk, int sc_chunk, bf16_t* hout, float* fout, int lane) {
    f32x4 v[4]; float s = 0.f;
#pragma unroll
    for (int i = 0; i < 4; ++i) { v[i] = *(const f32x4*)(xr + 4 * lane + 256 * i); s += v[i][0] * v[i][0] + v[i][1] * v[i][1] + v[i][2] * v[i][2] + v[i][3] * v[i][3]; }
    s = wave_sum(s);
    const float rstd = rsqrtf(s * (1.f / D) + EPSV);
    const float* mv = modv_l + (size_t)tok_cv(t) * 6144;
#pragma unroll
    for (int i = 0; i < 4; ++i) { const int c = 4 * lane + 256 * i; const f32x4 g = *(const f32x4*)(gvec + c);
        f32x4 y; y[0] = v[i][0] * rstd * g[0]; y[1] = v[i][1] * rstd * g[1]; y[2] = v[i][2] * rstd * g[2]; y[3] = v[i][3] * rstd * g[3];
        if (hout) { const f32x4 sc = *(const f32x4*)(mv + sc_chunk * D + c), sh = *(const f32x4*)(mv + sh_chunk * D + c);
            u32x2 w; w.x = pk_bf16(y[0] * (1.f + sc[0]) + sh[0], y[1] * (1.f + sc[1]) + sh[1]); w.y = pk_bf16(y[2] * (1.f + sc[2]) + sh[2], y[3] * (1.f + sc[3]) + sh[3]);
            *(u32x2*)(hout + (size_t)t * D + c) = w; }
        else *(f32x4*)(fout + (size_t)t * D + c) = y; }
}
__device__ __forceinline__ void norm_phase(const MKP& p, bool from_input, const float* gvec, const float* modv_l, int sh_chunk, int sc_chunk, bf16_t* hout) {
    int tid = threadIdx.x; asm volatile("" : "+v"(tid));
    const int wid = tid >> 6, lane = tid & 63;
    for (int t = __builtin_amdgcn_readfirstlane(blockIdx.x * 8 + wid); t < NTOK; t += gridDim.x * 8)
        norm_one(p, from_input ? xin_row(p, t) : p.X + (size_t)t * D, t, gvec, modv_l, sh_chunk, sc_chunk, hout, nullptr, lane);
}

__device__ __forceinline__ void hyfilt_phase(const MKP& p, LAS uchar* lds) {
    LAS float* z2 = (LAS float*)lds;
    int tid = threadIdx.x; asm volatile("" : "+v"(tid));
    for (int it = blockIdx.x; it < 544; it += gridDim.x) {
        const bool big = it >= 32; const int L = big ? 4096 : 256; const int p0 = (big ? it - 32 : it) * 8; const int pbase = (big ? 256 : 0) + p0;
        __syncthreads();
        z2[tid] = p.Z2[(size_t)pbase * 64 + tid];
        __syncthreads();
        const int col0 = 4 * tid;
        f32x4 acc[8];
#pragma unroll
        for (int q = 0; q < 8; ++q) acc[q] = (f32x4){0.f, 0.f, 0.f, 0.f};
        for (int k = 0; k < 64; ++k) { const f32x4 w = *(const f32x4*)(p.hy_w3 + (size_t)k * 2048 + col0);
#pragma unroll
            for (int q = 0; q < 8; ++q) { const float z = z2[q * 64 + k]; acc[q][0] += z * w[0]; acc[q][1] += z * w[1]; acc[q][2] += z * w[2]; acc[q][3] += z * w[3]; } }
        const f32x4 dec = *(const f32x4*)(p.hy_decay + col0);
        const int dir = col0 >> 10, ch0 = col0 & 1023;
        bf16_t* R = p.Rf + (big ? (size_t)1024 * 512 : 0);
        const int RL = 2 * L;
        float ss[4] = {0.f, 0.f, 0.f, 0.f};
#pragma unroll
        for (int q = 0; q < 8; ++q) { const int pos = p0 + q; const float tt = (float)pos / (float)L;
#pragma unroll
            for (int e = 0; e < 4; ++e) { const float val = acc[q][e] * (__expf(-tt * fabsf(dec[e])) + 0.05f);
                if (dir == 0) { ss[e] += val * val; R[(size_t)(ch0 + e) * RL + (L - 1 - pos)] = f2bf(val); }
                else if (pos >= 1) { ss[e] += val * val; R[(size_t)(ch0 + e) * RL + (L - 1 + pos)] = f2bf(val); } } }
#pragma unroll
        for (int e = 0; e < 4; ++e) unsafeAtomicAdd(p.NORMSQ + (big ? 1024 : 0) + ch0 + e, ss[e]);
    }
}

#define S5ROW 528
__device__ __forceinline__ float fsigmoid(float x) { return __builtin_amdgcn_rcpf(1.f + __expf(-x)); }
__device__ __forceinline__ float fgelu(float x) { const float z = 1.5957691216057308f * (x + 0.044715f * x * x * x); return x * __builtin_amdgcn_rcpf(1.f + __expf(-z)); }
__device__ __forceinline__ float one_minus_exp(float y) { const float t = y * (1.f + y * (0.5f + y * (0.16666667f + y * 0.041666668f))); return y > -0.125f ? -t : 1.f - __expf(y); }

__device__ __forceinline__ void s5_task(const MKP& p, int seqid, int g, int seg, int mode, LAS uchar* wl, int lane) {
    asm volatile("" : "+v"(lane));
    const bool ctx = seqid < 32; const int b = ctx ? seqid : seqid - 32;
    const int t0 = ctx ? seqid * 256 : CTX_TOK + b * 4096 + seg * 256;
    const int r = lane & 31, hh = lane >> 5, fr = lane & 15, fq = lane >> 4;
    const bool full = ctx || mode == 1;
    f32x4 yacc[16];
#pragma unroll
    for (int i = 0; i < 16; ++i) yacc[i] = (f32x4){0.f, 0.f, 0.f, 0.f};
#pragma unroll
    for (int d = 0; d < 2; ++d) {
        const int dg = d * 32 + g;
        bf16x8 bm[4], cm[4];
#pragma unroll
        for (int nt = 0; nt < 4; ++nt) bm[nt] = *(const bf16x8*)(p.Bmat + ((size_t)dg * 128 + 32 * nt + r) * 16 + 8 * hh);
#pragma unroll
        for (int ks = 0; ks < 4; ++ks) cm[ks] = *(const bf16x8*)(p.CmT + ((size_t)dg * 16 + fr) * 128 + 32 * ks + 8 * fq);
        const float ar = p.abar[(dg * 64 + lane) * 2], ai = p.abar[(dg * 64 + lane) * 2 + 1];
        float hr = 0.f, hi = 0.f;
        if (!ctx && mode == 1) {
            hr = p.st_re[((b * 2 + d) * 32 + g) * 64 + lane]; hi = p.st_im[((b * 2 + d) * 32 + g) * 64 + lane];
            const float lr = p.aL[(dg * 64 + lane) * 2], li = p.aL[(dg * 64 + lane) * 2 + 1];
            const float* car = p.S5car + ((size_t)((b * 2 + d) * 32 + g) * 16) * 128;
            if (d == 0) { for (int s = 0; s < seg; ++s) { const float sr = car[s * 128 + lane * 2], si = car[s * 128 + lane * 2 + 1]; const float nr = lr * hr - li * hi + sr, ni = lr * hi + li * hr + si; hr = nr; hi = ni; } }
            else { for (int s = 15; s > seg; --s) { const float sr = car[s * 128 + lane * 2], si = car[s * 128 + lane * 2 + 1]; const float nr = lr * hr - li * hi + sr, ni = lr * hi + li * hr + si; hr = nr; hi = ni; } }
        }
        bf16x8 ufa[8];
#pragma unroll
        for (int sbb = 0; sbb < 8; ++sbb) ufa[sbb] = *(const bf16x8*)(p.Zb + (size_t)(t0 + 32 * sbb + r) * 1536 + 16 * g + 8 * hh);
#pragma unroll
        for (int step = 0; step < 8; ++step) {
            asm volatile("" ::: "memory");
            const int sb = d == 0 ? step : 7 - step;
            const bf16x8 uf = ufa[sb];
#pragma unroll
            for (int nt = 0; nt < 4; ++nt) {
                f32x16 dd = {0.f, 0.f, 0.f, 0.f, 0.f, 0.f, 0.f, 0.f, 0.f, 0.f, 0.f, 0.f, 0.f, 0.f, 0.f, 0.f};
                dd = __builtin_amdgcn_mfma_f32_32x32x16_bf16(bm[nt], uf, dd, 0, 0, 0);
#pragma unroll
                for (int q = 0; q < 4; ++q) { f32x4 w = {dd[4 * q], dd[4 * q + 1], dd[4 * q + 2], dd[4 * q + 3]};
                    *(LAS f32x4*)(wl + r * S5ROW + (32 * nt + 8 * q + 4 * hh) * 4) = w; }
            }
#pragma unroll 4
            for (int jj = 0; jj < 32; ++jj) { const int j = d == 0 ? jj : 31 - jj;
                const f32x2 bu = *(const LAS f32x2*)(wl + j * S5ROW + 8 * lane);
                const float nr = ar * hr - ai * hi + bu[0], ni = ar * hi + ai * hr + bu[1]; hr = nr; hi = ni;
                if (full) *(LAS unsigned*)(wl + j * S5ROW + 4 * lane) = pk_bf16(hr, hi); }
            if (full) {
#pragma unroll
                for (int mt = 0; mt < 2; ++mt) {
#pragma unroll
                    for (int ks = 0; ks < 4; ++ks) { const bf16x8 hf = *(const LAS bf16x8*)(wl + (16 * mt + fr) * S5ROW + 64 * ks + 16 * fq);
                        yacc[sb * 2 + mt] = __builtin_amdgcn_mfma_f32_16x16x32_bf16(cm[ks], hf, yacc[sb * 2 + mt], 0, 0, 0); }
                }
            }
        }
        if (ctx) { float* nre = p.out + (size_t)NTOK * D; float* nim = nre + 131072;
            nre[((b * 2 + d) * 32 + g) * 64 + lane] = hr; nim[((b * 2 + d) * 32 + g) * 64 + lane] = hi; }
        else if (mode == 0) { float* car = p.S5car + ((size_t)((b * 2 + d) * 32 + g) * 16 + seg) * 128; car[lane * 2] = hr; car[lane * 2 + 1] = hi; }
    }
    if (full) {
        const f32x4 dsk = *(const f32x4*)(p.s5_d + 16 * g + 4 * fq);
#pragma unroll
        for (int tl = 0; tl < 16; ++tl) { const int t = t0 + 16 * tl + fr; f32x4 y = yacc[tl];
            const u32x2 uu = *(const u32x2*)(p.Zb + (size_t)t * 1536 + 16 * g + 4 * fq);
            y[0] += dsk[0] * bflo(uu.x); y[1] += dsk[1] * bfhi(uu.x); y[2] += dsk[2] * bflo(uu.y); y[3] += dsk[3] * bfhi(uu.y);
            u32x2 w; w.x = pk_bf16(fgelu(y[0]), fgelu(y[1])); w.y = pk_bf16(fgelu(y[2]), fgelu(y[3]));
            *(u32x2*)(p.ZS + (size_t)t * 512 + 16 * g + 4 * fq) = w; }
    }
}

#define LRU_XA 144
#define LRU_G 528
__device__ __forceinline__ void lru_task(const MKP& p, int ck, int h, int mode, LAS uchar* wl, int lane) {
    asm volatile("" : "+v"(lane));
    const bool ctx = ck < 128; const int b = ctx ? (ck >> 2) : ((ck - 128) >> 6); const int cis = ctx ? (ck & 3) : ((ck - 128) & 63); const int nch = ctx ? 4 : 64;
    const int seqbase = ctx ? b * 256 : CTX_TOK + b * 4096;
    const int t0 = ck * 64;
    const int rowlen = ctx ? 256 : 64;
    const int rs = seqbase + ((t0 - seqbase) / rowlen) * rowlen, re = rs + rowlen;
    const int fr = lane & 15, fq = lane >> 4;
    const int ch = 64 * h + lane;
    LAS uchar* xa = wl; LAS uchar* gl = wl + 64 * LRU_XA;
    {
        const float cw0 = p.lru_conv_w[ch], cw1 = p.lru_conv_w[512 + ch], cw2 = p.lru_conv_w[1024 + ch], cw3 = p.lru_conv_w[1536 + ch], cb = p.lru_conv_b[ch];
        float xr[67];
#pragma unroll
        for (int i = 0; i < 67; ++i) { const int tt = t0 - 2 + i; const int tc = tt < rs ? rs : (tt >= re ? re - 1 : tt);
            const float v = bf2f(p.Zb[(size_t)tc * 1536 + 512 + ch]); xr[i] = (tt >= rs && tt < re) ? v : 0.f; }
#pragma unroll
        for (int j = 0; j < 64; ++j) *(LAS bf16_t*)(xa + j * LRU_XA + 2 * lane) = f2bf(cb + cw0 * xr[j] + cw1 * xr[j + 1] + cw2 * xr[j + 2] + cw3 * xr[j + 3]);
    }
    unsigned hp[32];
#pragma unroll
    for (int d = 0; d < 2; ++d) {
        bf16x8 wa[4][2], wx[4][2];
#pragma unroll
        for (int nt = 0; nt < 4; ++nt)
#pragma unroll
            for (int ks = 0; ks < 2; ++ks) { const size_t o = ((size_t)(d * 8 + h) * 64 + 16 * nt + fr) * 64 + 32 * ks + 8 * fq;
                wa[nt][ks] = *(const bf16x8*)(p.WaT + o); wx[nt][ks] = *(const bf16x8*)(p.WxT + o); }
        const float ba = p.lru_b_a[d * 512 + ch], bx = p.lru_b_x[d * 512 + ch];
        const float lm = -p.lru_lambda[d * 512 + ch]; const float sp8 = -8.f * (lm > 20.f ? lm : log1pf(expf(lm)));
        float hst = 0.f, aprod = 1.f;
        if (mode == 1) {
            hst = ctx ? 0.f : p.st_lru[(b * 2 + d) * 512 + ch];
            const float* car = p.LRUcar + ((size_t)(ck - cis) * 2 + d) * 1024 + ch * 2;
            if (d == 0) { for (int s = 0; s < cis; ++s) { const f32x2 c2 = *(const f32x2*)(car + (size_t)s * 2048); hst = c2[0] * hst + c2[1]; } }
            else { for (int s = nch - 1; s > cis; --s) { const f32x2 c2 = *(const f32x2*)(car + (size_t)s * 2048); hst = c2[0] * hst + c2[1]; } }
        }
#pragma unroll
        for (int step = 0; step < 4; ++step) {
            const int sb = d == 0 ? step : 3 - step;
            bf16x8 xf[2];
#pragma unroll
            for (int ks = 0; ks < 2; ++ks) xf[ks] = *(const LAS bf16x8*)(xa + (16 * sb + fr) * LRU_XA + 64 * ks + 16 * fq);
#pragma unroll
            for (int nt = 0; nt < 4; ++nt) {
                f32x4 da = {0.f, 0.f, 0.f, 0.f}, dx = {0.f, 0.f, 0.f, 0.f};
#pragma unroll
                for (int ks = 0; ks < 2; ++ks) { da = __builtin_amdgcn_mfma_f32_16x16x32_bf16(wa[nt][ks], xf[ks], da, 0, 0, 0); dx = __builtin_amdgcn_mfma_f32_16x16x32_bf16(wx[nt][ks], xf[ks], dx, 0, 0, 0); }
                *(LAS f32x4*)(gl + fr * LRU_G + (16 * nt + 4 * fq) * 4) = da;
                *(LAS f32x4*)(gl + fr * LRU_G + 256 + (16 * nt + 4 * fq) * 4) = dx;
            }
            float xg[16];
            if (d == 1 && mode == 1) {
#pragma unroll
                for (int j = 0; j < 16; ++j) xg[j] = bf2f(p.Zb[(size_t)(t0 + 16 * sb + j) * 1536 + 1024 + ch]);
            }
            float av[16], bv[16];
#pragma unroll
            for (int j = 0; j < 16; ++j) { const float ra = *(const LAS float*)(gl + j * LRU_G + 4 * lane) + ba, rx = *(const LAS float*)(gl + j * LRU_G + 256 + 4 * lane) + bx;
                const float xbv = bf2f(*(const LAS bf16_t*)(xa + (16 * sb + j) * LRU_XA + 2 * lane));
                const float la = sp8 * fsigmoid(ra); av[j] = __expf(la);
                bv[j] = __builtin_amdgcn_sqrtf(one_minus_exp(2.f * la)) * (fsigmoid(rx) * xbv); }
#pragma unroll
            for (int jj = 0; jj < 16; ++jj) { const int j = d == 0 ? jj : 15 - jj; hst = av[j] * hst + bv[j]; aprod *= av[j]; bv[j] = hst; }
            if (mode == 1) {
                if (d == 0) {
#pragma unroll
                    for (int k = 0; k < 8; ++k) hp[8 * sb + k] = pk_bf16(bv[2 * k], bv[2 * k + 1]);
                } else {
#pragma unroll
                    for (int j = 0; j < 16; ++j) { const unsigned pk = hp[8 * sb + (j >> 1)]; const float hf = (j & 1) ? bfhi(pk) : bflo(pk);
                        p.CAT[(size_t)(t0 + 16 * sb + j) * D + 512 + ch] = f2bf((hf + bv[j]) * fgelu(xg[j])); }
                }
            }
        }
        if (mode == 0) { float* car = p.LRUcar + ((size_t)ck * 2 + d) * 1024 + ch * 2; *(f32x2*)car = (f32x2){aprod, hst}; }
        else if (ctx && ((d == 0 && cis == 3) || (d == 1 && cis == 0))) { float* nl = p.out + (size_t)NTOK * D + 262144; nl[(b * 2 + d) * 512 + ch] = hst; }
    }
}

__device__ __forceinline__ void scan_phase(const MKP& p, int pass, LAS uchar* lds, int which = 3) {
    int tid = threadIdx.x; asm volatile("" : "+v"(tid));
    const int wid = tid >> 6, lane = tid & 63;
    LAS uchar* wl = lds + wid * 20480;
    const int gw = __builtin_amdgcn_readfirstlane(blockIdx.x * 8 + wid), GW = gridDim.x * 8;
    if (which & 1)
    for (int task = gw; task < 1536; task += GW) {
        int seqid, g, seg, mode;
        if (task < 1024) { seqid = 32 + (task >> 9); seg = (task >> 5) & 15; g = task & 31; mode = pass; }
        else { const int i = (task - 1024) + pass * 512; seqid = i >> 5; g = i & 31; seg = 0; mode = 1; }
        s5_task(p, seqid, g, seg, mode, wl, lane);
    }
    asm volatile("" ::: "memory");
    if (which & 2)
    for (int i = (gw + GW - (1536 % GW)) % GW; i < 2048; i += GW) lru_task(p, i >> 3, i & 7, pass, wl, lane);
}

__device__ __forceinline__ unsigned f2key(float f) { const unsigned u = __float_as_uint(f); return u ^ ((unsigned)((int)u >> 31) | 0x80000000u); }
template <int CTRL> __device__ __forceinline__ unsigned dppu(unsigned x) { return (unsigned)__builtin_amdgcn_update_dpp(0, (int)x, CTRL, 0xf, 0xf, false); }
template <int CTRL> __device__ __forceinline__ float dppf(float x) { return __int_as_float(__builtin_amdgcn_update_dpp(0, __float_as_int(x), CTRL, 0xf, 0xf, false)); }
__device__ __forceinline__ unsigned rowmax_u(unsigned x) { unsigned t; t = dppu<0x121>(x); x = x > t ? x : t; t = dppu<0x122>(x); x = x > t ? x : t; t = dppu<0x124>(x); x = x > t ? x : t; t = dppu<0x128>(x); x = x > t ? x : t; return x; }
__device__ __forceinline__ float rowmax_f(float x) { x = fmaxf(x, dppf<0x121>(x)); x = fmaxf(x, dppf<0x122>(x)); x = fmaxf(x, dppf<0x124>(x)); x = fmaxf(x, dppf<0x128>(x)); return x; }
__device__ __forceinline__ float rowsum_f(float x) { x += dppf<0x121>(x); x += dppf<0x122>(x); x += dppf<0x124>(x); x += dppf<0x128>(x); return x; }
#define CEX(a, b) { const unsigned _hi = (a) > (b) ? (a) : (b), _lo = (a) > (b) ? (b) : (a); (a) = _hi; (b) = _lo; }

#define PS_ROW 528
#define PS_SV0 135168
#define PS_SI0 151552

struct EpiQ { bf16_t* Q; int m0, n0;
    __device__ __forceinline__ void operator()(const f32x4& v, int row, int col) const {
        u32x2 w; w.x = pk_bf16(v[0], v[1]); w.y = pk_bf16(v[2], v[3]);
        *(u32x2*)(Q + (size_t)(row - m0) * 256 + (col - n0)) = w; }
};

__device__ __forceinline__ void peer_route_phase(const MKP& p, int layer, LAS uchar* lds, const bf16_t* Hsrc, int qmode) {
    const bf16_t* WqT = p.WqT + (size_t)layer * 2048 * 1024;
    for (int item = blockIdx.x; item < 512; item += gridDim.x) {
        const int h = item & 7, pm = item >> 3;
        const bf16_t* Q; int qld;
        if (qmode == 1) { Q = p.Zb + (size_t)pm * 256 * 2048 + h * 256; qld = 2048; }
        else { bf16_t* Qw = p.Zb + (size_t)item * 65536; Q = Qw; qld = 256;
            EpiQ eq{Qw, pm * 256, h * 256};
            gemm_tile<256>(Hsrc, D, WqT, D, D, pm * 256, h * 256, lds, eq);
            asm volatile("s_waitcnt vmcnt(0)" ::: "memory"); }
        __syncthreads();
        int tid = threadIdx.x; asm volatile("" : "+v"(tid));
        const int wid = tid >> 6, lane = tid & 63, fr = lane & 15, fq = lane >> 4;
        const int rbase = 32 * wid;
        float sv1 = 0.f; int si1 = 0;
        for (int half = 0; half < 2; ++half) {
            f32x4 acc[2][8];
#pragma unroll
            for (int m = 0; m < 2; ++m)
#pragma unroll
                for (int n = 0; n < 8; ++n) acc[m][n] = (f32x4){0.f, 0.f, 0.f, 0.f};
            const bf16_t* kb = p.Keysb + ((size_t)(layer * 16 + h * 2 + half) * 128) * 128;
#pragma unroll
            for (int ks = 0; ks < 4; ++ks) {
                bf16x8 qf[2], kf[8];
#pragma unroll
                for (int m = 0; m < 2; ++m) qf[m] = *(const bf16x8*)(Q + (size_t)(rbase + 16 * m + fr) * qld + half * 128 + 32 * ks + 8 * fq);
#pragma unroll
                for (int n = 0; n < 8; ++n) kf[n] = *(const bf16x8*)(kb + (size_t)(16 * n + fr) * 128 + 32 * ks + 8 * fq);
#pragma unroll
                for (int m = 0; m < 2; ++m)
#pragma unroll
                    for (int n = 0; n < 8; ++n) acc[m][n] = __builtin_amdgcn_mfma_f32_16x16x32_bf16(kf[n], qf[m], acc[m][n], 0, 0, 0);
            }
#pragma unroll
            for (int m = 0; m < 2; ++m)
#pragma unroll
                for (int n = 0; n < 8; ++n) *(LAS f32x4*)(lds + (rbase + 16 * m + fr) * PS_ROW + (16 * n + 4 * fq) * 4) = acc[m][n];
            for (int rg = 0; rg < 8; ++rg) {
                const int row = rbase + 4 * rg + fq; const int q = fr;
                const LAS uchar* srow = lds + row * PS_ROW;
                const f32x4 s0 = *(const LAS f32x4*)(srow + 32 * q), s1 = *(const LAS f32x4*)(srow + 32 * q + 16);
                unsigned k0 = (f2key(s0[0]) & ~127u) | (127u - (8 * q + 0)), k1 = (f2key(s0[1]) & ~127u) | (127u - (8 * q + 1)), k2 = (f2key(s0[2]) & ~127u) | (127u - (8 * q + 2)), k3 = (f2key(s0[3]) & ~127u) | (127u - (8 * q + 3));
                unsigned k4 = (f2key(s1[0]) & ~127u) | (127u - (8 * q + 4)), k5 = (f2key(s1[1]) & ~127u) | (127u - (8 * q + 5)), k6 = (f2key(s1[2]) & ~127u) | (127u - (8 * q + 6)), k7 = (f2key(s1[3]) & ~127u) | (127u - (8 * q + 7));
                CEX(k0, k1) CEX(k2, k3) CEX(k4, k5) CEX(k6, k7)
                CEX(k0, k2) CEX(k1, k3) CEX(k4, k6) CEX(k5, k7)
                CEX(k1, k2) CEX(k5, k6)
                CEX(k0, k4) CEX(k1, k5) CEX(k2, k6) CEX(k3, k7)
                CEX(k2, k4) CEX(k3, k5)
                CEX(k1, k2) CEX(k3, k4) CEX(k5, k6)
                unsigned res = 0;
#pragma unroll
                for (int it = 0; it < 16; ++it) { const unsigned mx = rowmax_u(k0); if (q == it) res = mx;
                    if (k0 == mx) { k0 = k1; k1 = k2; k2 = k3; k3 = k4; k4 = k5; k5 = k6; k6 = k7; k7 = 0u; } }
                const int idx = 127 - (int)(res & 127u);
                const float val = *(const LAS float*)(srow + 4 * idx);
                if (half == 0) { *(LAS float*)(lds + PS_SV0 + (row * 16 + q) * 4) = val; *(LAS uchar*)(lds + PS_SI0 + row * 16 + q) = (uchar)idx; }
                else {
                    sv1 = val; si1 = idx;
                    const float sv0 = *(const LAS float*)(lds + PS_SV0 + (row * 16 + q) * 4); const int si0 = *(const LAS uchar*)(lds + PS_SI0 + row * 16 + q);
                    const int rowlane = lane & 48;
                    unsigned c[16];
#pragma unroll
                    for (int j = 0; j < 16; ++j) { const float s = sv0 + __shfl(sv1, rowlane + j); c[j] = (f2key(s) & ~255u) | (255u - (unsigned)(q * 16 + j)); }
                    unsigned res2 = 0;
#pragma unroll
                    for (int it = 0; it < 16; ++it) { const unsigned mx = rowmax_u(c[0]); if (q == it) res2 = mx;
                        if (c[0] == mx) {
#pragma unroll
                            for (int j = 0; j < 15; ++j) c[j] = c[j + 1];
                            c[15] = 0u; } }
                    const int flat = 255 - (int)(res2 & 255u); const int ii = flat >> 4, jj = flat & 15;
                    const float fv = __shfl(sv0, rowlane + ii) + __shfl(sv1, rowlane + jj);
                    const int e0 = __shfl(si0, rowlane + ii), e1 = __shfl(si1, rowlane + jj);
                    const float mx = rowmax_f(fv); const float ex = __expf(fv - mx); const float sm = rowsum_f(ex);
                    const int t = pm * 256 + row;
                    p.EI[(size_t)t * 128 + h * 16 + q] = e0 * 128 + e1;
                    p.EG[(size_t)t * 128 + h * 16 + q] = ex / sm;
                }
            }
        }
        __syncthreads();
    }
}

__device__ __forceinline__ f32x2 fp8lo(unsigned w) { return __builtin_amdgcn_cvt_pk_f32_fp8((int)w, false); }
__device__ __forceinline__ f32x2 fp8hi(unsigned w) { return __builtin_amdgcn_cvt_pk_f32_fp8((int)w, true); }
__device__ __forceinline__ float readlane_f(float x, int l) { return __int_as_float(__builtin_amdgcn_readlane(__float_as_int(x), l)); }

__device__ __forceinline__ void peer_eval_phase(const MKP& p, int layer, const float* gate  , bool last, bool dry) {
    int tid = threadIdx.x; asm volatile("" : "+v"(tid));
    const int wid = tid >> 6, lane = tid & 63;
    const uchar* U = p.Ub + (size_t)layer * 16384 * 1024; const uchar* V = p.Vb + (size_t)layer * 16384 * 1024;
    const float* SU = p.SU + layer * 16384; const float* SV = p.SV + layer * 16384;
    for (int t = __builtin_amdgcn_readfirstlane(blockIdx.x * 8 + wid); t < NTOK; t += gridDim.x * 8) {
        f32x2 xv[8];
        { const u32x4 h0 = *(const u32x4*)(p.Hb + (size_t)t * D + 16 * lane), h1 = *(const u32x4*)(p.Hb + (size_t)t * D + 16 * lane + 8);
          xv[0] = (f32x2){bflo(h0.x), bfhi(h0.x)}; xv[1] = (f32x2){bflo(h0.y), bfhi(h0.y)}; xv[2] = (f32x2){bflo(h0.z), bfhi(h0.z)}; xv[3] = (f32x2){bflo(h0.w), bfhi(h0.w)};
          xv[4] = (f32x2){bflo(h1.x), bfhi(h1.x)}; xv[5] = (f32x2){bflo(h1.y), bfhi(h1.y)}; xv[6] = (f32x2){bflo(h1.z), bfhi(h1.z)}; xv[7] = (f32x2){bflo(h1.w), bfhi(h1.w)}; }
        const int ei0 = p.EI[(size_t)t * 128 + lane], ei1 = p.EI[(size_t)t * 128 + 64 + lane];
        const float du0 = SU[ei0], du1 = SU[ei1];
        const float gv0 = p.EG[(size_t)t * 128 + lane] * SV[ei0], gv1 = p.EG[(size_t)t * 128 + 64 + lane] * SV[ei1];
        f32x2 acc[8];
#pragma unroll
        for (int i = 0; i < 8; ++i) acc[i] = (f32x2){0.f, 0.f};
        u32x4 uA[4], vA[4], uB[4], vB[4];
#define PE_LOAD(UU, VV, g) { _Pragma("unroll") for (int i = 0; i < 4; ++i) { const int e = 4 * (g) + i; \
            const int idx = __builtin_amdgcn_readlane(e < 64 ? ei0 : ei1, e & 63); \
            UU[i] = *(const u32x4*)(U + (size_t)idx * D + 16 * lane); VV[i] = *(const u32x4*)(V + (size_t)idx * D + 16 * lane); } }
#define PE_COMPUTE(UU, VV, g) { float d0, d1, d2, d3; \
            { f32x2 a; \
              a = xv[0] * fp8lo(UU[0].x); a = xv[1] * fp8hi(UU[0].x) + a; a = xv[2] * fp8lo(UU[0].y) + a; a = xv[3] * fp8hi(UU[0].y) + a; a = xv[4] * fp8lo(UU[0].z) + a; a = xv[5] * fp8hi(UU[0].z) + a; a = xv[6] * fp8lo(UU[0].w) + a; a = xv[7] * fp8hi(UU[0].w) + a; d0 = a[0] + a[1]; \
              a = xv[0] * fp8lo(UU[1].x); a = xv[1] * fp8hi(UU[1].x) + a; a = xv[2] * fp8lo(UU[1].y) + a; a = xv[3] * fp8hi(UU[1].y) + a; a = xv[4] * fp8lo(UU[1].z) + a; a = xv[5] * fp8hi(UU[1].z) + a; a = xv[6] * fp8lo(UU[1].w) + a; a = xv[7] * fp8hi(UU[1].w) + a; d1 = a[0] + a[1]; \
              a = xv[0] * fp8lo(UU[2].x); a = xv[1] * fp8hi(UU[2].x) + a; a = xv[2] * fp8lo(UU[2].y) + a; a = xv[3] * fp8hi(UU[2].y) + a; a = xv[4] * fp8lo(UU[2].z) + a; a = xv[5] * fp8hi(UU[2].z) + a; a = xv[6] * fp8lo(UU[2].w) + a; a = xv[7] * fp8hi(UU[2].w) + a; d2 = a[0] + a[1]; \
              a = xv[0] * fp8lo(UU[3].x); a = xv[1] * fp8hi(UU[3].x) + a; a = xv[2] * fp8lo(UU[3].y) + a; a = xv[3] * fp8hi(UU[3].y) + a; a = xv[4] * fp8lo(UU[3].z) + a; a = xv[5] * fp8hi(UU[3].z) + a; a = xv[6] * fp8lo(UU[3].w) + a; a = xv[7] * fp8hi(UU[3].w) + a; d3 = a[0] + a[1]; } \
              \
            float k0 = (lane & 1) ? d1 : d0, s0 = (lane & 1) ? d0 : d1, k1 = (lane & 1) ? d3 : d2, s1 = (lane & 1) ? d2 : d3; \
            k0 += dppf<0xB1>(s0); k1 += dppf<0xB1>(s1); \
            float kk = (lane & 2) ? k1 : k0, ss = (lane & 2) ? k0 : k1; \
            kk += dppf<0x4E>(ss); kk += dppf<0x124>(kk); kk += dppf<0x128>(kk); kk += __shfl_xor(kk, 16); kk += __shfl_xor(kk, 32); \
            _Pragma("unroll") for (int i = 0; i < 4; ++i) { const int e = 4 * (g) + i; \
                const float sdot = readlane_f(kk, i) * readlane_f(e < 64 ? du0 : du1, e & 63); \
                const float cf = readlane_f(e < 64 ? gv0 : gv1, e & 63) * gelu_f(sdot); const f32x2 c2 = {cf, cf}; \
                acc[0] = c2 * fp8lo(VV[i].x) + acc[0]; acc[1] = c2 * fp8hi(VV[i].x) + acc[1]; acc[2] = c2 * fp8lo(VV[i].y) + acc[2]; acc[3] = c2 * fp8hi(VV[i].y) + acc[3]; \
                acc[4] = c2 * fp8lo(VV[i].z) + acc[4]; acc[5] = c2 * fp8hi(VV[i].z) + acc[5]; acc[6] = c2 * fp8lo(VV[i].w) + acc[6]; acc[7] = c2 * fp8hi(VV[i].w) + acc[7]; } }
        PE_LOAD(uA, vA, 0)
        for (int g = 0; g < 32; g += 2) {
            PE_LOAD(uB, vB, g + 1)
            PE_COMPUTE(uA, vA, g)
            if (g + 2 < 32) PE_LOAD(uA, vA, g + 2)
            PE_COMPUTE(uB, vB, g + 1)
        }
#undef PE_LOAD
#undef PE_COMPUTE
        float* xr = p.X + (size_t)t * D + 16 * lane; const float* gt = gate + (size_t)tok_cv(t) * 6144 + 16 * lane;
        float xn[16]; float ssq = 0.f;
#pragma unroll
        for (int v4 = 0; v4 < 4; ++v4) { const f32x4 x = *(const f32x4*)(xr + 4 * v4), gg = *(const f32x4*)(gt + 4 * v4); f32x4 o;
            o[0] = x[0] + gg[0] * acc[2 * v4][0]; o[1] = x[1] + gg[1] * acc[2 * v4][1]; o[2] = x[2] + gg[2] * acc[2 * v4 + 1][0]; o[3] = x[3] + gg[3] * acc[2 * v4 + 1][1];
#pragma unroll
            for (int e = 0; e < 4; ++e) { xn[4 * v4 + e] = o[e]; ssq += o[e] * o[e]; }
            if (!dry) *(f32x4*)(xr + 4 * v4) = o; }
        ssq = wave_sum(ssq);
        if (dry) { if (ssq == 12345.678f) p.NORMSQ[lane] = ssq; continue; }
        const float rstd = rsqrtf(ssq * (1.f / D) + EPSV);
        if (!last) {
            const float* gv = p.norm1_g + D + 16 * lane; const float* mv = p.modv + 3 * 6144 + (size_t)tok_cv(t) * 6144 + 16 * lane;
            float y[16];
#pragma unroll
            for (int e = 0; e < 16; ++e) y[e] = xn[e] * rstd * gv[e] * (1.f + mv[D + e]) + mv[e];
            u32x4 w0, w1; w0.x = pk_bf16(y[0], y[1]); w0.y = pk_bf16(y[2], y[3]); w0.z = pk_bf16(y[4], y[5]); w0.w = pk_bf16(y[6], y[7]);
            w1.x = pk_bf16(y[8], y[9]); w1.y = pk_bf16(y[10], y[11]); w1.z = pk_bf16(y[12], y[13]); w1.w = pk_bf16(y[14], y[15]);
            *(u32x4*)(p.Hb + (size_t)t * D + 16 * lane) = w0; *(u32x4*)(p.Hb + (size_t)t * D + 16 * lane + 8) = w1;
        } else {
#pragma unroll
            for (int v4 = 0; v4 < 4; ++v4) { const f32x4 gg = *(const f32x4*)(p.final_g + 16 * lane + 4 * v4); f32x4 o;
#pragma unroll
                for (int e = 0; e < 4; ++e) o[e] = xn[4 * v4 + e] * rstd * gg[e];
                *(f32x4*)(p.out + (size_t)t * D + 16 * lane + 4 * v4) = o; }
        }
    }
}

__device__ __forceinline__ void hy_conv_phase(const MKP& p, LAS uchar* lds) {
    int tid = threadIdx.x; asm volatile("" : "+v"(tid));
    LAS bf16_t* tl = (LAS bf16_t*)lds;
    for (int item = blockIdx.x; item < 4096; item += gridDim.x) {
        const int tt = item >> 4, cgp = item & 15; const int t0 = tt * 64, c0 = cgp * 64;
        const int tok = tid >> 3, cseg = tid & 7; const int t = t0 + tok; const int c = c0 + 8 * cseg;
        const int rowlen = t < CTX_TOK ? 256 : 64; const int pos = (t < CTX_TOK ? t : t - CTX_TOK) % rowlen;
        const bool vm = pos > 0, vp = pos < rowlen - 1;
        float r[3][8];
#pragma unroll
        for (int part = 0; part < 3; ++part) { const int cc = part * 1024 + c;
            const u32x4 z0 = *(const u32x4*)(p.Zb + (size_t)t * 3072 + cc);
            u32x4 zm = *(const u32x4*)(p.Zb + (size_t)(vm ? t - 1 : t) * 3072 + cc), zp = *(const u32x4*)(p.Zb + (size_t)(vp ? t + 1 : t) * 3072 + cc);
            if (!vm) zm = (u32x4){0u, 0u, 0u, 0u};
            if (!vp) zp = (u32x4){0u, 0u, 0u, 0u};
            const unsigned zmu[4] = {zm.x, zm.y, zm.z, zm.w}, z0u[4] = {z0.x, z0.y, z0.z, z0.w}, zpu[4] = {zp.x, zp.y, zp.z, zp.w};
#pragma unroll
            for (int e = 0; e < 8; ++e) { const float a = (e & 1) ? bfhi(zmu[e >> 1]) : bflo(zmu[e >> 1]), b = (e & 1) ? bfhi(z0u[e >> 1]) : bflo(z0u[e >> 1]), cpl = (e & 1) ? bfhi(zpu[e >> 1]) : bflo(zpu[e >> 1]);
                r[part][e] = p.hy_conv_b[cc + e] + p.hy_conv_w[cc + e] * a + p.hy_conv_w[3072 + cc + e] * b + p.hy_conv_w[6144 + cc + e] * cpl; } }
        float vg[8];
#pragma unroll
        for (int e = 0; e < 8; ++e) vg[e] = r[2][e] * r[1][e];
        u32x4 w0, w1;
        w0.x = pk_bf16(r[0][0], r[0][1]); w0.y = pk_bf16(r[0][2], r[0][3]); w0.z = pk_bf16(r[0][4], r[0][5]); w0.w = pk_bf16(r[0][6], r[0][7]);
        w1.x = pk_bf16(vg[0], vg[1]); w1.y = pk_bf16(vg[2], vg[3]); w1.z = pk_bf16(vg[4], vg[5]); w1.w = pk_bf16(vg[6], vg[7]);
        *(u32x4*)(p.X0C + (size_t)t * D + c) = w0;
        *(u32x4*)(p.VG + (size_t)t * D + c) = w1;
        __syncthreads();
#pragma unroll
        for (int e = 0; e < 8; ++e) tl[(8 * cseg + e) * 72 + tok] = f2bf(vg[e]);
        __syncthreads();
        { const int cc = tid >> 3, ts = tid & 7; const u32x4 w = *(const LAS u32x4*)(tl + cc * 72 + 8 * ts);
          *(u32x4*)(p.VT + (size_t)(c0 + cc) * NTOK + t0 + 8 * ts) = w; }
    }
}

#define HL_C1 16448
#define HL_V 32896
#define HL_ACC 51456
#define HL_VS 144
__device__ __forceinline__ void hy_long_phase(const MKP& p, LAS uchar* lds, int variant = 0) {
    int tid = threadIdx.x; asm volatile("" : "+v"(tid));
    const int wid = tid >> 6, lane = tid & 63, r = lane & 31, hh = lane >> 5;
    for (int item = blockIdx.x; item < 2048; item += gridDim.x) {
        const int pass = item < 1024 ? 1 : 0; const int c = item & 1023;
        const int L = pass ? 4096 : 256, NA = pass ? 64 : 4, RL = 2 * L;
        const bf16_t* R = p.Rf + (pass ? (size_t)1024 * 512 : 0) + (size_t)c * RL;
        const bf16_t* Vc = p.VT + (size_t)c * NTOK + (pass ? CTX_TOK : 0);
        __syncthreads();
        for (int ch = tid; ch < RL / 16; ch += NTHR) {
            const unsigned* src = (const unsigned*)(R + ch * 16);
            unsigned w[9];
#pragma unroll
            for (int i = 0; i < 8; ++i) w[i] = src[i];
            w[8] = (ch * 16 + 16 < RL) ? src[8] : 0u;
            LAS unsigned* d0 = (LAS unsigned*)(lds + ch * 32); LAS unsigned* d1 = (LAS unsigned*)(lds + HL_C1 + ch * 32);
#pragma unroll
            for (int i = 0; i < 8; ++i) { d0[i] = w[i]; d1[i] = (w[i] >> 16) | (w[i + 1] << 16); }
        }
        for (int ch = tid; ch < 1024; ch += NTHR) *(LAS u32x4*)(lds + HL_V + (ch >> 3) * HL_VS + (ch & 7) * 16) = *(const u32x4*)(Vc + ch * 8);
        __syncthreads();
        f32x16 acc[2][4];
#pragma unroll
        for (int mt = 0; mt < 2; ++mt)
#pragma unroll
            for (int nt = 0; nt < 4; ++nt)
#pragma unroll
                for (int e = 0; e < 16; ++e) acc[mt][nt][e] = 0.f;
        const int dlo = -(NA - 1), dhi = NA - 1;
        const int cpo = (r & 1) ? 0 : HL_C1;
        for (int dl = dlo + wid; dl <= ((variant & 2) ? dlo - 1 : dhi); dl += 8) {
            int voff[4]; bool vok[4];
#pragma unroll
            for (int nt = 0; nt < 4; ++nt) { const int col = 32 * nt + r; const int a = col % NA; vok[nt] = (a - dl >= 0) && (a - dl < NA); voff[nt] = HL_V + (vok[nt] ? col - dl : 0) * HL_VS + 16 * hh; }
            const int xbase = (L - 1) - 64 * dl - r + 8 * hh;
#pragma unroll
            for (int ks = 0; ks < 4; ++ks) {
                bf16x8 af[2], bfv[4];
#pragma unroll
                for (int mt = 0; mt < 2; ++mt) { const int x = xbase - 32 * mt + 16 * ks; const int xe = x & ~1;
                    const LAS unsigned* src = (const LAS unsigned*)(lds + cpo + xe * 2);
                    u32x4 w; w.x = src[0]; w.y = src[1]; w.z = src[2]; w.w = src[3]; af[mt] = __builtin_bit_cast(bf16x8, w); }
#pragma unroll
                for (int nt = 0; nt < 4; ++nt) { u32x4 w = *(const LAS u32x4*)(lds + voff[nt] + 32 * ks);
                    if (!vok[nt]) w = (u32x4){0u, 0u, 0u, 0u}; bfv[nt] = __builtin_bit_cast(bf16x8, w); }
#pragma unroll
                for (int nt = 0; nt < 4; ++nt)
#pragma unroll
                    for (int mt = 0; mt < 2; ++mt) acc[mt][nt] = __builtin_amdgcn_mfma_f32_32x32x16_bf16(af[mt], bfv[nt], acc[mt][nt], 0, 0, 0);
            }
        }
#pragma unroll
        for (int w = 0; w < 8; ++w) {
            if (wid == w && !(variant & 1)) {
#pragma unroll
                for (int mt = 0; mt < 2; ++mt)
#pragma unroll
                    for (int nt = 0; nt < 4; ++nt)
#pragma unroll
                        for (int q = 0; q < 4; ++q) { LAS f32x4* ap = (LAS f32x4*)(lds + HL_ACC + ((32 * nt + r) * 68 + 32 * mt + 8 * q + 4 * hh) * 4);
                            f32x4 v = {acc[mt][nt][4 * q], acc[mt][nt][4 * q + 1], acc[mt][nt][4 * q + 2], acc[mt][nt][4 * q + 3]};
                            if (w > 0) v += *ap;
                            *ap = v; }
            }
            __syncthreads();
        }
        { const float nrm = rsqrtf(p.NORMSQ[(pass ? 1024 : 0) + c] + EPSV);
          const int col = tid >> 2, i0 = 16 * (tid & 3); const LAS float* a = (const LAS float*)(lds + HL_ACC) + col * 68 + i0;
          u32x4 w0, w1;
          w0.x = pk_bf16(a[0] * nrm, a[1] * nrm); w0.y = pk_bf16(a[2] * nrm, a[3] * nrm); w0.z = pk_bf16(a[4] * nrm, a[5] * nrm); w0.w = pk_bf16(a[6] * nrm, a[7] * nrm);
          w1.x = pk_bf16(a[8] * nrm, a[9] * nrm); w1.y = pk_bf16(a[10] * nrm, a[11] * nrm); w1.z = pk_bf16(a[12] * nrm, a[13] * nrm); w1.w = pk_bf16(a[14] * nrm, a[15] * nrm);
          bf16_t* dst = p.YT + (size_t)c * NTOK + (pass ? CTX_TOK : 0) + col * 64 + i0;
          if (variant == 0) { *(u32x4*)dst = w0; *(u32x4*)(dst + 8) = w1; } else if (nrm == 123.456f) { *(u32x4*)dst = w0; } }
    }
}

__device__ __forceinline__ void hy_gate_phase(const MKP& p, LAS uchar* lds) {
    int tid = threadIdx.x; asm volatile("" : "+v"(tid));
    LAS bf16_t* tl = (LAS bf16_t*)lds;
    for (int item = blockIdx.x; item < 4096; item += gridDim.x) {
        const int tt = item >> 4, cgp = item & 15; const int t0 = tt * 64, c0 = cgp * 64;
        __syncthreads();
        { const int cc = tid >> 3, ts = tid & 7; *(LAS u32x4*)(tl + cc * 72 + 8 * ts) = *(const u32x4*)(p.YT + (size_t)(c0 + cc) * NTOK + t0 + 8 * ts); }
        __syncthreads();
        const int tok = tid >> 3, cseg = tid & 7; const int t = t0 + tok, c = c0 + 8 * cseg;
        const u32x4 x0 = *(const u32x4*)(p.X0C + (size_t)t * D + c), vgp = *(const u32x4*)(p.VG + (size_t)t * D + c);
        const unsigned x0u[4] = {x0.x, x0.y, x0.z, x0.w}, vgu[4] = {vgp.x, vgp.y, vgp.z, vgp.w};
        float y[8];
#pragma unroll
        for (int e = 0; e < 8; ++e) { const float cv = bf2f(tl[(8 * cseg + e) * 72 + tok]); const float vv = (e & 1) ? bfhi(vgu[e >> 1]) : bflo(vgu[e >> 1]), xx = (e & 1) ? bfhi(x0u[e >> 1]) : bflo(x0u[e >> 1]);
            y[e] = (cv + p.hy_bias[c + e] * vv) * xx; }
        u32x4 w; w.x = pk_bf16(y[0], y[1]); w.y = pk_bf16(y[2], y[3]); w.z = pk_bf16(y[4], y[5]); w.w = pk_bf16(y[6], y[7]);
        *(u32x4*)(p.CAT + (size_t)t * D + c) = w;
    }
}

extern __shared__ __attribute__((aligned(16))) unsigned char smem_raw[];
#define MK_LDS_BYTES 163840

#define XB_TMO      128
#define XB_XCNT(j)  (256  + 64 * (j))
#define XB_XSUB(j)  (1280 + 64 * (j))
#define XB_XGEN(j)  (2304 + 64 * (j))
#define XB_TOP      3328
#define XB_TOPGEN   3392
#define XCD_BAR_WORDS 3456
#define XB_SPIN_CAP (1u << 20)
__device__ __forceinline__ unsigned xb_ld(unsigned* q) { return __hip_atomic_load(q, __ATOMIC_RELAXED, __HIP_MEMORY_SCOPE_AGENT); }
__device__ __forceinline__ unsigned xb_add(unsigned* q, unsigned v) { return __hip_atomic_fetch_add(q, v, __ATOMIC_RELAXED, __HIP_MEMORY_SCOPE_AGENT); }
__device__ __forceinline__ unsigned xb_xcc_id() { return (unsigned)__builtin_amdgcn_s_getreg((3 << 11) | 20) & 0xFu; }
#define XB_SPIN(cond, bar) do { unsigned _sp = 0; while (cond) { __builtin_amdgcn_s_sleep(1); \
    if ((++_sp & 255u) == 0u) { if (xb_ld(&(bar)[XB_TMO])) break; if (_sp > XB_SPIN_CAP) { atomicAdd(&(bar)[XB_TMO], 1u); break; } } } } while (0)
struct XcdBarrier { unsigned* bar; unsigned x; volatile LAS unsigned* st; };
__device__ __forceinline__ XcdBarrier xcd_barrier_post(unsigned* bar, volatile LAS unsigned* st) {
    XcdBarrier b; b.bar = bar; b.x = xb_xcc_id(); b.st = st;
    if (threadIdx.x == 0) (void)xb_add(&bar[XB_XCNT(b.x)], 1u);
    return b;
}
__device__ __forceinline__ void xcd_barrier_complete(unsigned* bar, unsigned x, unsigned& nloc, unsigned& nx) {
    const unsigned G = gridDim.x * gridDim.y * gridDim.z;
    unsigned sum, cnt, mine, sp = 0u;
    for (;;) {
        sum = 0u; cnt = 0u; mine = 0u;
#pragma unroll
        for (unsigned j = 0; j < 16; ++j) { const unsigned c = xb_ld(&bar[XB_XCNT(j)]); sum += c; cnt += (c > 0u) ? 1u : 0u; mine = (j == x) ? c : mine; }
        if (sum == G) break;
        __builtin_amdgcn_s_sleep(1);
        if ((++sp & 255u) == 0u) { if (xb_ld(&bar[XB_TMO])) break; if (sp > XB_SPIN_CAP) { atomicAdd(&bar[XB_TMO], 1u); break; } }
    }
    nloc = mine > 0u ? mine : 1u; nx = cnt > 0u ? cnt : 1u;
}
__device__ __forceinline__ void xcd_barrier(const XcdBarrier& b) {
    asm volatile("s_waitcnt vmcnt(0)" ::: "memory");
    __syncthreads();
    if (threadIdx.x == 0) {
        unsigned* bar = b.bar;
        __builtin_amdgcn_s_waitcnt(0);
        unsigned nloc = b.st[0], nx = b.st[1];
        if (nloc == 0u) { xcd_barrier_complete(bar, b.x, nloc, nx); b.st[0] = nloc; b.st[1] = nx; }
        const unsigned old = xb_add(&bar[XB_XSUB(b.x)], 1u);
        const unsigned gen = old / nloc;
        if (old + 1u == (gen + 1u) * nloc) {
            __builtin_amdgcn_fence(__ATOMIC_RELEASE, "agent");
            asm volatile("s_waitcnt vmcnt(0)" ::: "memory");
            const unsigned og = xb_add(&bar[XB_TOP], 1u);
            const unsigned tg = og / nx;
            if (og + 1u == (tg + 1u) * nx) xb_add(&bar[XB_TOPGEN], 1u);
            else XB_SPIN(xb_ld(&bar[XB_TOPGEN]) == tg, bar);
            __builtin_amdgcn_fence(__ATOMIC_ACQUIRE, "agent");
            xb_add(&bar[XB_XGEN(b.x)], 1u);
            asm volatile("s_waitcnt vmcnt(0)" ::: "memory");
        } else {
            XB_SPIN(xb_ld(&bar[XB_XGEN(b.x)]) == gen, bar);
            __builtin_amdgcn_fence(__ATOMIC_ACQUIRE, "agent");
            asm volatile("s_waitcnt vmcnt(0)" ::: "memory");
        }
    }
    __syncthreads();
}
#define MK_BAR_LDS_OFF (MK_LDS_BYTES - 16)

#define GSYNC_CG() do { asm volatile("s_waitcnt vmcnt(0)" ::: "memory"); grid.sync(); \
    if (threadIdx.x == 0) { __builtin_amdgcn_fence(__ATOMIC_ACQUIRE, "agent"); asm volatile("s_waitcnt vmcnt(0)" ::: "memory"); } __syncthreads(); } while (0)
#define GSYNC() xcd_barrier(xb)

#ifndef MK_PROBE
#define MK_PROBE 0
#endif
#define REP(bit) for (int _r = 0; _r < (((MK_PROBE) >> (bit)) & 1) + 1; ++_r)
__global__ void __launch_bounds__(NTHR) mega_fwd(MKP p) {
    cg::grid_group grid = cg::this_grid();
    LAS uchar* lds = (LAS uchar*)smem_raw;
    volatile LAS unsigned* xst = (volatile LAS unsigned*)(lds + MK_BAR_LDS_OFF);
    if (threadIdx.x == 0) { xst[0] = 0u; xst[1] = 0u; }
    __syncthreads();
    const XcdBarrier xb = xcd_barrier_post(p.bar, xst);
    REP(0) { phase0(p, lds); GSYNC_CG(); }
#pragma nounroll
    for (int layer = 0; layer < 2; ++layer) {
        const float* mv = p.modv + layer * 3 * 6144;
        if (layer == 0) {
            REP(1) { norm_phase(p, true, p.norm1_g, mv, 0, 1, p.Hb); if (_r == 0) hyfilt_phase(p, lds); GSYNC(); }
            REP(2) { EpiStoreBf16 e{p.Zb, 1536, nullptr}; gemm_phase<128>(p.Hb, D, p.WinT, D, D, NTOK, 1536, lds, e); GSYNC(); }
            REP(3) {
#pragma nounroll
                for (int pass = 0; pass < 2; ++pass) { scan_phase(p, pass, lds, _r == 0 ? 3 : (((MK_PROBE) >> 9) & 3) ? (((MK_PROBE) >> 9) & 3) : 3); GSYNC(); } }
            REP(2) { EpiGlu e{p.ZS, p.CAT, p.s5_b_glu}; gemm_phase<128>(p.ZS, 512, p.WgluT, 512, 512, NTOK, 512, lds, e); GSYNC(); }
        } else {
            REP(2) { EpiStoreBf16 e{p.Zb, 3072, p.b_in_c}; gemm_phase<256>(p.Hb, D, p.WincT, D, D, NTOK, 3072, lds, e); GSYNC(); }
            REP(4) { hy_conv_phase(p, lds); GSYNC(); }
            REP(5) { hy_long_phase(p, lds, _r == 0 ? 0 : (((MK_PROBE) >> 11) & 3)); GSYNC(); }
            REP(4) { hy_gate_phase(p, lds); GSYNC(); }
        }
        { EpiResid e{&p, layer == 0, mv + 2 * D, layer ? p.b_out_c : nullptr}; gemm_phase<256>(p.CAT, D, layer ? p.WoutcT : p.WoutT, D, D, NTOK, D, lds, e); }
        GSYNC();
        REP(1) { norm_phase(p, false, p.norm2_g + layer * D, mv, 3, 4, p.Hb); GSYNC(); }
        REP(6) { peer_route_phase(p, layer, lds, p.Hb, 0); GSYNC(); }
#if (MK_PROBE >> 7) & 1
        peer_eval_phase(p, layer, mv + 5 * D, layer == 1, true); GSYNC();
#endif
        peer_eval_phase(p, layer, mv + 5 * D, layer == 1, false);
        if (layer == 0) GSYNC();
#if (MK_PROBE >> 8) & 1
        for (int _r = 0; _r < 10; ++_r) GSYNC();
#endif
    }
}

static void mk_fill_params(MKP& p, void* const* d_in, void* d_out, void* d_ws) {
    const float** f = (const float**)&p;
    for (int i = 0; i < 50; ++i) f[i] = (const float*)d_in[i];
    p.out = (float*)d_out;
    unsigned char* ws = (unsigned char*)d_ws; size_t off = 0;
    auto take = [&](size_t bytes) { unsigned char* q = ws + off; off += (bytes + 255) & ~(size_t)255; return q; };
    p.X = (float*)take((size_t)NTOK * D * 4);
    p.Hb = (bf16_t*)take((size_t)NTOK * D * 2);
    p.Zb = (bf16_t*)take((size_t)NTOK * 3072 * 2);
    p.CAT = (bf16_t*)take((size_t)NTOK * D * 2);
    unsigned char* regA = take((size_t)96 << 20);
    p.ZS = (bf16_t*)regA; p.HS = (float*)(regA + ((size_t)16 << 20)); p.Qs = (bf16_t*)(regA + ((size_t)48 << 20));
    p.EI = (int*)(regA + ((size_t)80 << 20)); p.EG = (float*)(regA + ((size_t)88 << 20));
    p.X0C = (bf16_t*)regA; p.VG = (bf16_t*)(regA + ((size_t)32 << 20)); p.VT = (bf16_t*)(regA + ((size_t)64 << 20));
    p.YT = p.Zb;
    p.Ub = (uchar*)take((size_t)2 * 16384 * 1024); p.Vb = (uchar*)take((size_t)2 * 16384 * 1024);
    p.SU = (float*)take(2 * 16384 * 4); p.SV = (float*)take(2 * 16384 * 4); p.bar = (unsigned*)take(16384);
    p.WinT = (bf16_t*)take((size_t)1536 * 1024 * 2); p.WgluT = (bf16_t*)take((size_t)512 * 512 * 2); p.WoutT = (bf16_t*)take((size_t)1024 * 1024 * 2);
    p.WincT = (bf16_t*)take((size_t)3072 * 1024 * 2); p.WoutcT = (bf16_t*)take((size_t)1024 * 1024 * 2); p.WqT = (bf16_t*)take((size_t)2 * 2048 * 1024 * 2);
    p.Keysb = (bf16_t*)take((size_t)2 * 16 * 128 * 128 * 2); p.WaT = (bf16_t*)take((size_t)16 * 4096 * 2); p.WxT = (bf16_t*)take((size_t)16 * 4096 * 2);
    p.Bmat = (bf16_t*)take((size_t)64 * 128 * 16 * 2); p.CmT = (bf16_t*)take((size_t)64 * 16 * 128 * 2);
    p.abar = (float*)take(4096 * 2 * 4); p.aL = (float*)take(4096 * 2 * 4);
    p.S5car = (float*)take((size_t)2 * 2 * 32 * 16 * 128 * 4); p.LRUcar = (float*)take((size_t)256 * 2 * 1024 * 4);
    p.modv = (float*)take(2 * 3 * 6144 * 4); p.Z2 = (float*)take((size_t)4352 * 64 * 4); p.NORMSQ = (float*)take(2048 * 4);
    p.Rf = (bf16_t*)take(((size_t)1024 * 512 + (size_t)1024 * 8192) * 2);
    p.stop_after = 0; p.pad0 = 0;
}

#include <string.h>
#ifndef MK_STOP_AFTER
#define MK_STOP_AFTER 0
#endif
extern "C" void kernel_launch(void* const* d_in, const int* in_sizes, int n_in, void* d_out, int out_size, void* d_ws, size_t ws_size, hipStream_t stream) {
    static int grid_blocks = 0;
    if (!grid_blocks) {
        int dev = 0, cus = 0, per_cu = 0;
        (void)hipGetDevice(&dev);
        (void)hipDeviceGetAttribute(&cus, hipDeviceAttributeMultiprocessorCount, dev);
        (void)hipFuncSetAttribute((const void*)mega_fwd, hipFuncAttributeMaxDynamicSharedMemorySize, MK_LDS_BYTES);
        (void)hipOccupancyMaxActiveBlocksPerMultiprocessor(&per_cu, (const void*)mega_fwd, NTHR, MK_LDS_BYTES);
        if (per_cu > 1) per_cu = 1;
        grid_blocks = cus * per_cu; if (grid_blocks > 256) grid_blocks = 256;
        if (grid_blocks < 1) { fprintf(stderr, "mega_fwd: occupancy query returned 0 blocks per CU\n"); grid_blocks = 0; return; }
    }
    MKP p; memset(&p, 0, sizeof(p));
    mk_fill_params(p, d_in, d_out, d_ws);
    p.stop_after = MK_STOP_AFTER;
    (void)hipMemsetAsync(p.bar, 0, XCD_BAR_WORDS * 4, stream);
    void* args[] = {&p};
    hipError_t e = hipLaunchCooperativeKernel((const void*)mega_fwd, dim3(grid_blocks), dim3(NTHR), args, MK_LDS_BYTES, stream);
    if (e != hipSuccess) fprintf(stderr, "cooperative launch failed: %s (grid %d)\n", hipGetErrorString(e), grid_blocks);
#if MK_STOP_AFTER != 0
    nv::naive_tail(MK_STOP_AFTER, d_in, d_out, d_ws, stream);
#endif
}
```

```cpp
#include <hip/hip_runtime.h>
#include <hip/hip_cooperative_groups.h>
#include <stdint.h>
#include <math.h>
#include <stdio.h>
#include <type_traits>
namespace cg = cooperative_groups;

#define D 1024
#define NTOK 16384
#define CTX_TOK 8192
#define EPSV 1e-6f
#define NTHR 512
#define LAS __attribute__((address_space(3)))
#define GAS __attribute__((address_space(1)))

typedef unsigned short bf16_t;
typedef unsigned char uchar;
typedef short bf16x8 __attribute__((ext_vector_type(8)));
typedef float f32x4 __attribute__((ext_vector_type(4)));
typedef float f32x2 __attribute__((ext_vector_type(2)));
typedef float f32x16 __attribute__((ext_vector_type(16)));
typedef unsigned u32x4 __attribute__((ext_vector_type(4)));
typedef unsigned u32x2 __attribute__((ext_vector_type(2)));
typedef unsigned u32x6p __attribute__((ext_vector_type(6)));
typedef __bf16 bf16x2v __attribute__((ext_vector_type(2)));

struct MKP {
    const float *x_prompt, *x_sample, *st_re, *st_im, *st_lru, *c, *c_ctx, *norm1_g, *norm2_g, *w_mod, *b_mod, *w_in_ab,
        *s5_a_re, *s5_a_im, *s5_log_dt, *s5_b_re, *s5_b_im, *s5_c_re, *s5_c_im, *s5_d, *s5_w_glu, *s5_b_glu,
        *lru_conv_w, *lru_conv_b, *lru_w_a, *lru_b_a, *lru_w_x, *lru_b_x, *lru_lambda, *w_out_ab,
        *w_in_c, *b_in_c, *hy_conv_w, *hy_conv_b, *hy_w1, *hy_b1, *hy_f1, *hy_w2, *hy_b2, *hy_f2, *hy_w3, *hy_decay, *hy_bias, *w_out_c, *b_out_c,
        *peer_wq, *peer_keys, *peer_u, *peer_v, *final_g;
    float* out;
    float* X;
    bf16_t* Hb;
    bf16_t* Zb;
    bf16_t* CAT;
    bf16_t* ZS;
    float* HS;
    bf16_t* Qs;
    int* EI; float* EG;
    bf16_t *X0C, *VG, *VT, *YT;
    uchar *Ub, *Vb;
    float *SU, *SV;
    unsigned *bar;
    bf16_t *WinT, *WgluT, *WoutT, *WincT, *WoutcT, *WqT, *Keysb, *WaT, *WxT;
    bf16_t *Bmat, *CmT; float *abar, *aL;
    float *S5car;
    float *LRUcar;
    float *modv;
    float *Z2;
    float *NORMSQ;
    float *PSQ;
    bf16_t *Rf;
    int stop_after; int pad0;
};

__device__ __forceinline__ float bf2f(bf16_t v) { return __uint_as_float((unsigned)v << 16); }
__device__ __forceinline__ float bflo(unsigned p) { return __uint_as_float(p << 16); }
__device__ __forceinline__ float bfhi(unsigned p) { return __uint_as_float(p & 0xffff0000u); }
__device__ __forceinline__ unsigned pk_bf16(float lo, float hi) { const f32x2 v = {lo, hi}; const bf16x2v r = __builtin_convertvector(v, bf16x2v); return __builtin_bit_cast(unsigned, r); }
__device__ __forceinline__ bf16_t f2bf(float x) { return (bf16_t)(pk_bf16(x, 0.f) & 0xffffu); }
__device__ __forceinline__ float sigmoid_f(float x) { return 1.f / (1.f + __expf(-x)); }
__device__ __forceinline__ float gelu_f(float x) { float z = 1.5957691216057308f * (x + 0.044715f * x * x * x); return x / (1.f + __expf(-z)); }
__device__ __forceinline__ float silu_f(float x) { return x / (1.f + __expf(-x)); }
__device__ __forceinline__ int tok_cv(int t) { return t < CTX_TOK ? 0 : 1 + ((t - CTX_TOK) >> 12); }
__device__ __forceinline__ const float* xin_row(const MKP& p, int t) { return t < CTX_TOK ? p.x_prompt + (size_t)t * D : p.x_sample + (size_t)(t - CTX_TOK) * D; }
__device__ __forceinline__ float wave_sum(float v) {
#pragma unroll
    for (int o = 32; o > 0; o >>= 1) v += __shfl_xor(v, o);
    return v;
}
__device__ __forceinline__ void glds16(const void* g, LAS uchar* l) { __builtin_amdgcn_global_load_lds((const GAS void*)g, (LAS void*)l, 16, 0, 0); }

template <int BN, class Epi>
__device__ __forceinline__ void gemm_tile(const bf16_t* A, int lda, const bf16_t* Bt, int ldb, int K, int m0, int n0, LAS uchar* lds, Epi& epi) {
    constexpr int NW = BN / 64;
    constexpr int STAGE = 256 * 128 + BN * 128;
    int tid = threadIdx.x; asm volatile("" : "+v"(tid));
    const int wid = tid >> 6, lane = tid & 63, wr = wid >> 2, wc = wid & 3, fr = lane & 15, fq = lane >> 4;
    f32x4 acc[8][NW];
#pragma unroll
    for (int m = 0; m < 8; ++m)
#pragma unroll
        for (int n = 0; n < NW; ++n) acc[m][n] = (f32x4){0.f, 0.f, 0.f, 0.f};
    const int nk = K >> 6;
    const int srow = lane >> 3, sc = lane & 7;
    auto stage = [&](int kt, int buf) {
        LAS uchar* sb = lds + buf * STAGE;
#pragma unroll
        for (int j = 0; j < 4; ++j) { const int rowl = 8 * (wid + 8 * j) + srow; const int c = sc ^ ((rowl >> 1) & 7);
            glds16(A + (size_t)(m0 + rowl) * lda + kt * 64 + c * 8, sb + rowl * 128 + sc * 16); }
#pragma unroll
        for (int j = 0; j < BN / 64; ++j) { const int rowl = 8 * (wid + 8 * j) + srow; const int c = sc ^ ((rowl >> 1) & 7);
            glds16(Bt + (size_t)(n0 + rowl) * ldb + kt * 64 + c * 8, sb + 32768 + rowl * 128 + sc * 16); }
    };
    __syncthreads();
    stage(0, 0);
    for (int kt = 0; kt < nk; ++kt) {
        asm volatile("s_waitcnt vmcnt(0)" ::: "memory");
        __syncthreads();
        if (kt + 1 < nk) stage(kt + 1, (kt + 1) & 1);
        const LAS uchar* sa = lds + (kt & 1) * STAGE;
        const LAS uchar* sbp = sa + 32768;
#pragma unroll
        for (int kk = 0; kk < 2; ++kk) {
            const int cs = ((kk * 4 + fq) ^ (fr >> 1)) * 16;
            bf16x8 bfr[NW];
#pragma unroll
            for (int n = 0; n < NW; ++n) bfr[n] = *(const LAS bf16x8*)(sbp + (wc * (BN / 4) + n * 16 + fr) * 128 + cs);
#pragma unroll
            for (int mh = 0; mh < 2; ++mh) {
                bf16x8 af[4];
#pragma unroll
                for (int m = 0; m < 4; ++m) af[m] = *(const LAS bf16x8*)(sa + (wr * 128 + (4 * mh + m) * 16 + fr) * 128 + cs);
#pragma unroll
                for (int m = 0; m < 4; ++m)
#pragma unroll
                    for (int n = 0; n < NW; ++n) acc[4 * mh + m][n] = __builtin_amdgcn_mfma_f32_16x16x32_bf16(bfr[n], af[m], acc[4 * mh + m][n], 0, 0, 0);
            }
        }
    }
    typename Epi::Pre pre[8][NW];
#pragma unroll
    for (int m = 0; m < 8; ++m)
#pragma unroll
        for (int n = 0; n < NW; ++n) pre[m][n] = epi.pre(m0 + wr * 128 + m * 16 + fr, n0 + wc * (BN / 4) + n * 16 + 4 * fq);
#pragma unroll
    for (int m = 0; m < 8; ++m)
#pragma unroll
        for (int n = 0; n < NW; ++n) epi(acc[m][n], pre[m][n], m0 + wr * 128 + m * 16 + fr, n0 + wc * (BN / 4) + n * 16 + 4 * fq);
}

struct EpiStoreT {
    bf16_t* O; int ldc; int col0;
    struct Pre {};
    __device__ __forceinline__ Pre pre(int, int) const { return Pre{}; }
    __device__ __forceinline__ void operator()(const f32x4& v, const Pre&, int row, int col) const {
        u32x2 w; w.x = pk_bf16(v[0], v[1]); w.y = pk_bf16(v[2], v[3]); *(u32x2*)(O + (size_t)row * ldc + col0 + col) = w; }
};
struct EpiGlu {
    const bf16_t* ZS; bf16_t* CAT; const float* bias;
    struct Pre { u32x2 z; f32x4 b; };
    __device__ __forceinline__ Pre pre(int row, int col) const { Pre q; q.z = *(const u32x2*)(ZS + (size_t)row * 512 + col); q.b = *(const f32x4*)(bias + col); return q; }
    __device__ __forceinline__ void operator()(const f32x4& v, const Pre& q, int row, int col) const {
        const float o0 = bflo(q.z.x) * sigmoid_f(v[0] + q.b[0]), o1 = bfhi(q.z.x) * sigmoid_f(v[1] + q.b[1]), o2 = bflo(q.z.y) * sigmoid_f(v[2] + q.b[2]), o3 = bfhi(q.z.y) * sigmoid_f(v[3] + q.b[3]);
        u32x2 w; w.x = pk_bf16(o0, o1); w.y = pk_bf16(o2, o3);
        *(u32x2*)(CAT + (size_t)row * D + col) = w;
    }
};
template <int BN, class Epi>
__device__ __forceinline__ void gemm_phase(const bf16_t* A, int lda, const bf16_t* Bt, int ldb, int K, int M, int N, LAS uchar* lds, Epi& epi) {
    const int nM = M / 256, nN = N / BN, nt = nM * nN;
    for (int t = blockIdx.x; t < nt; t += gridDim.x) { const int pn = t % nN, pm = t / nN; gemm_tile<BN>(A, lda, Bt, ldb, K, pm * 256, pn * BN, lds, epi); }
}

namespace pg8 {
#define PG8_LAS __attribute__((address_space(3)))
typedef unsigned short bf16_t;
typedef short bf16x8 __attribute__((ext_vector_type(8)));
typedef float f32x4 __attribute__((ext_vector_type(4)));
typedef unsigned u32x4 __attribute__((ext_vector_type(4)));
constexpr int BM = 256, BK = 64, HALF = 128, HTB = HALF * BK * 2  , STAGE_BYTES = 8 * HTB, NXCD = 8, WGM = 8;

__host__ __device__ __forceinline__ int lds_byte(int r, int c) { const int st = (r >> 4) * 2 + (c >> 5), rr = r & 15, cc = c & 31, ob = rr * 64 + cc * 2; return st * 1024 + (ob ^ (((ob >> 9) & 1) << 5)); }
__host__ __device__ __forceinline__ void stage_rc(int b, int& R, int& C) { const int st = b / 1024, sb = b % 1024, swz = sb ^ (((sb >> 9) & 1) << 5); R = (st >> 1) * 16 + swz / 64; C = (st & 1) * 32 + (swz % 64) / 2; }
__host__ __device__ __forceinline__ int perm32(int rho) { const int n = rho >> 4, i = rho & 15; return 8 * (i >> 2) + 4 * n + (i & 3); }

struct Unit { int pm, pn; };
struct Gemm { const bf16_t* A; const bf16_t* Bt; int M, N, K; };

struct StaticOrder {
    int nM, nN, nwg, G, c;
    __host__ __device__ void init(int M, int N, int G_, int c_) { nM = M / BM; nN = N / BM; nwg = nM * nN; G = G_; c = c_; }
    __host__ __device__ bool next(int i, Unit& u) const {
        const long L = (long)i * G + c; if (L >= nwg) return false;
        int wgid = (int)L; { const int q = nwg / NXCD, r = nwg % NXCD, xcd = wgid % NXCD, off = wgid / NXCD; wgid = (xcd < r ? xcd * (q + 1) : r * (q + 1) + (xcd - r) * q) + off; }
        const int nig = WGM * nN, gid = wgid / nig, fm = gid * WGM, gsz = (nM - fm) < WGM ? (nM - fm) : WGM;
        u.pm = fm + ((wgid % nig) % gsz); u.pn = (wgid % nig) / gsz; return true;
    }
    __device__ __forceinline__ void a_ready(const Unit&) const {}
    __device__ __forceinline__ void done(const Unit&) const {}
};
template <class Epi, class Sched, bool STAMP = false>
__device__ __forceinline__ void gemm_phase(PG8_LAS unsigned char* lds, const Gemm g, const Sched& S, const Epi& E, unsigned long long* stamps) {
    int tid = threadIdx.x; asm volatile("" : "+v"(tid));
    const int wid = __builtin_amdgcn_readfirstlane(tid >> 6), lane = tid & 63, wr = wid >> 2, wc = wid & 3, fr = lane & 15, fq = lane >> 4;
    const int K = g.K, nt = K / BK;
    int ts_lo = 0, ts_hi = 0, nts = 0; const unsigned long long rt_entry = STAMP ? (unsigned long long)wall_clock64() : 0ull;
#define PG8_STAMP() do { if (STAMP && wid == 0 && nts < 64) { const unsigned long long _c = (unsigned long long)clock64(); \
        ts_lo = (lane == nts) ? (int)(unsigned)_c : ts_lo; ts_hi = (lane == nts) ? (int)(unsigned)(_c >> 32) : ts_hi; ++nts; } } while (0)
    PG8_STAMP();
    unsigned voffA[2], voffB[2];
#pragma unroll
    for (int i = 0; i < 2; ++i) { int R, C; stage_rc(tid * 16 + i * 8192, R, C); const int Rb = Epi::PERM ? ((R & ~31) + perm32(R & 31)) : R;
        voffA[i] = (unsigned)(R * K + C) * 2u; voffB[i] = (unsigned)(Rb * K + C) * 2u; }
    const size_t kstep = (size_t)(BK * 2);
    const size_t hstep = (size_t)HALF * K * 2;
    const size_t tstep = 2 * hstep;
    const unsigned ldsw = (unsigned)wid * 1024u;
    const int aoff = lds_byte(wr * 64 + fr, fq * 8), boff = lds_byte(wc * 32 + fr, fq * 8);
#define PG8_SA(b, h) (((b) * 2 + (h)) * HTB)
#define PG8_SB(b, h) ((4 + (b) * 2 + (h)) * HTB)
#define PG8_STAGE(bufoff, gbase, voff) do { _Pragma("unroll") for (int _i = 0; _i < 2; ++_i) \
        __builtin_amdgcn_global_load_lds((const unsigned*)((const char*)(gbase) + (voff)[_i]), (PG8_LAS unsigned*)(lds + (bufoff) + ldsw + _i * 8192), 16, 0, 0); } while (0)
#define PG8_LDA(dst, b, h) do { _Pragma("unroll") for (int m = 0; m < 4; ++m) _Pragma("unroll") for (int k = 0; k < 2; ++k) dst[m][k] = *(const PG8_LAS bf16x8*)(lds + PG8_SA(b, h) + aoff + m * 2048 + k * 1024); } while (0)
#define PG8_LDB(dst, b, h) do { _Pragma("unroll") for (int n = 0; n < 2; ++n) _Pragma("unroll") for (int k = 0; k < 2; ++k) dst[n][k] = *(const PG8_LAS bf16x8*)(lds + PG8_SB(b, h) + boff + n * 2048 + k * 1024); } while (0)
#define PG8_MMA(ai, bj, At, Bt) do { __builtin_amdgcn_s_setprio(1); _Pragma("unroll") for (int m = 0; m < 4; ++m) _Pragma("unroll") for (int n = 0; n < 2; ++n) _Pragma("unroll") for (int k = 0; k < 2; ++k) \
        acc[ai][bj][m][n] = __builtin_amdgcn_mfma_f32_16x16x32_bf16(Bt[n][k], At[m][k], acc[ai][bj][m][n], 0, 0, 0); __builtin_amdgcn_s_setprio(0); } while (0)
#define PG8_WAIT_V(n) asm volatile("s_waitcnt vmcnt(" #n ")" ::: "memory")
#define PG8_WAIT_L(n) asm volatile("s_waitcnt lgkmcnt(" #n ")" ::: "memory")
#define PG8_BAR __builtin_amdgcn_s_barrier()
#define PG8_SCHED __builtin_amdgcn_sched_barrier(0)
    Unit cur, nxt; int ui = 0;
    if (!S.next(0, cur)) return;
    f32x4 acc[2][2][4][2];
#pragma unroll
    for (int a = 0; a < 2; ++a)
#pragma unroll
        for (int b = 0; b < 2; ++b)
#pragma unroll
            for (int m = 0; m < 4; ++m)
#pragma unroll
                for (int n = 0; n < 2; ++n) acc[a][b][m][n] = (f32x4){0.f, 0.f, 0.f, 0.f};
    bf16x8 At[4][2], B0[2][2], B1[2][2];
    const char* cA = (const char*)g.A + (size_t)cur.pm * tstep; const char* cB = (const char*)g.Bt + (size_t)cur.pn * tstep;
    S.a_ready(cur);
    PG8_STAGE(PG8_SB(0, 0), cB, voffB); PG8_STAGE(PG8_SA(0, 0), cA, voffA); PG8_STAGE(PG8_SB(0, 1), cB + hstep, voffB); PG8_STAGE(PG8_SA(0, 1), cA + hstep, voffA);
    if (wr == 1) PG8_BAR;
    PG8_WAIT_V(4); PG8_BAR;
    PG8_STAGE(PG8_SB(1, 0), cB + kstep, voffB); PG8_STAGE(PG8_SA(1, 0), cA + kstep, voffA); PG8_STAGE(PG8_SB(1, 1), cB + hstep + kstep, voffB);
    PG8_WAIT_V(6); PG8_BAR;
    PG8_STAMP();
    for (;;) {
        const bool has_next = S.next(ui + 1, nxt);
        const char* nA = has_next ? (const char*)g.A + (size_t)nxt.pm * tstep : cA; const char* nB = has_next ? (const char*)g.Bt + (size_t)nxt.pn * tstep : cB;
        for (int t = 0; t < nt; t += 2) {
            const bool last = (t == nt - 2);
            const char* a1 = cA + (size_t)(t + 1) * kstep;
            const char* a2 = last ? nA : cA + (size_t)(t + 2) * kstep; const char* b2 = last ? nB : cB + (size_t)(t + 2) * kstep;
            const char* a3 = a2 + kstep; const char* b3 = b2 + kstep;
            if (last && has_next) S.a_ready(nxt);
            PG8_LDB(B0, 0, 0); PG8_SCHED; PG8_LDA(At, 0, 0); PG8_STAGE(PG8_SA(1, 1), a1 + hstep, voffA);
            PG8_WAIT_L(8); PG8_BAR; PG8_WAIT_L(0); PG8_MMA(0, 0, At, B0); PG8_BAR; PG8_SCHED;
            PG8_LDB(B1, 0, 1); PG8_STAGE(PG8_SB(0, 0), b2, voffB);
            PG8_BAR; PG8_WAIT_L(0); PG8_MMA(0, 1, At, B1); PG8_BAR;
            PG8_LDA(At, 0, 1); PG8_STAGE(PG8_SA(0, 0), a2, voffA);
            PG8_BAR; PG8_WAIT_L(0); PG8_MMA(1, 0, At, B0); PG8_BAR; PG8_SCHED;
            PG8_STAGE(PG8_SB(0, 1), b2 + hstep, voffB);
            PG8_WAIT_V(6); PG8_BAR; PG8_MMA(1, 1, At, B1); PG8_BAR;
            PG8_LDB(B0, 1, 0); PG8_SCHED; PG8_LDA(At, 1, 0); PG8_STAGE(PG8_SA(0, 1), a2 + hstep, voffA);
            PG8_WAIT_L(8); PG8_BAR; PG8_WAIT_L(0); PG8_MMA(0, 0, At, B0); PG8_BAR; PG8_SCHED;
            PG8_LDB(B1, 1, 1); PG8_STAGE(PG8_SB(1, 0), b3, voffB);
            PG8_BAR; PG8_WAIT_L(0); PG8_MMA(0, 1, At, B1); PG8_BAR;
            PG8_LDA(At, 1, 1); PG8_STAGE(PG8_SA(1, 0), a3, voffA);
            PG8_BAR; PG8_WAIT_L(0); PG8_MMA(1, 0, At, B0); PG8_BAR; PG8_SCHED;
            PG8_STAGE(PG8_SB(1, 1), b3 + hstep, voffB);
            PG8_WAIT_V(6); PG8_BAR; PG8_MMA(1, 1, At, B1); PG8_BAR;
        }
        PG8_STAMP();
        if constexpr (!Epi::AFTER_DRAIN) { E(acc, cur, wr, wc, fr, fq); S.done(cur); }
        PG8_STAMP();
        if (!has_next) break;
#pragma unroll
        for (int a = 0; a < 2; ++a)
#pragma unroll
            for (int b = 0; b < 2; ++b)
#pragma unroll
                for (int m = 0; m < 4; ++m)
#pragma unroll
                    for (int n = 0; n < 2; ++n) acc[a][b][m][n] = (f32x4){0.f, 0.f, 0.f, 0.f};
        cur = nxt; cA = nA; cB = nB; ++ui;
    }
    PG8_WAIT_V(0);
    if (wr == 0) PG8_BAR;
    PG8_BAR;
    if constexpr (Epi::AFTER_DRAIN) { E.fused(acc, cur, wr, wc, fr, fq, lds, wid, lane); S.done(cur); }
    PG8_STAMP();
    if (STAMP && wid == 0) { stamps[lane] = lane < nts ? (((unsigned long long)(unsigned)ts_hi << 32) | (unsigned)ts_lo) : 0ull;
        if (lane == 62) stamps[62] = rt_entry; if (lane == 63) stamps[63] = (unsigned long long)wall_clock64(); }
#undef PG8_STAMP
#undef PG8_SA
#undef PG8_SB
#undef PG8_STAGE
#undef PG8_LDA
#undef PG8_LDB
#undef PG8_MMA
#undef PG8_WAIT_V
#undef PG8_WAIT_L
#undef PG8_BAR
#undef PG8_SCHED
}
}

__device__ __forceinline__ void tile_load(const float* src, int N, int k0, int n0, int tid, float (&v)[8]) {
#pragma unroll
    for (int i = 0; i < 8; ++i) { const int e = tid + NTHR * i, kr = e >> 6, nc = e & 63; v[i] = src[(size_t)(k0 + kr) * N + n0 + nc]; }
}
__device__ __forceinline__ void tile_store(const float (&v)[8], int K, bf16_t* dst, int k0, int n0, int tid, LAS uchar* lds) {
    LAS float* tl = (LAS float*)lds;
    __syncthreads();
#pragma unroll
    for (int i = 0; i < 8; ++i) { const int e = tid + NTHR * i, kr = e >> 6, nc = e & 63; tl[nc * 65 + kr] = v[i]; }
    __syncthreads();
#pragma unroll
    for (int i = 0; i < 4; ++i) { const int e = tid + NTHR * i, nr = e >> 5, kp = e & 31;
        *(unsigned*)(dst + (size_t)(n0 + nr) * K + k0 + 2 * kp) = pk_bf16(tl[nr * 65 + 2 * kp], tl[nr * 65 + 2 * kp + 1]); }
}

__device__ __forceinline__ unsigned fp6code(float y) {
    const float a = fabsf(y);
    const float t = a < 2.f ? 8.f * a : (a < 4.f ? 4.f * a + 8.f : 2.f * a + 16.f);
    int c = (int)rintf(t); c = c > 31 ? 31 : c;
    return (unsigned)c | (y < 0.f ? 32u : 0u);
}
__device__ __forceinline__ unsigned fp4code(float y) {
    const float a = fabsf(y);
    const float t = a < 2.f ? 2.f * a : (a < 4.f ? a + 2.f : 0.5f * a + 4.f);
    int c = (int)rintf(t); c = c > 7 ? 7 : c;
    return (unsigned)c | (y < 0.f ? 8u : 0u);
}
__device__ __forceinline__ void phase0(const MKP& p, LAS uchar* lds) {
    int tid = threadIdx.x; asm volatile("" : "+v"(tid));
    const int bid = blockIdx.x, G = gridDim.x, wid = tid >> 6, lane = tid & 63;
    const int gtid = bid * NTHR + tid, gthreads = G * NTHR;
    {
        LAS float* sc = (LAS float*)lds;
        LAS float* red = (LAS float*)(lds + 12288);
        bool have = false;
        for (int it = bid; it < 192; it += G) {
            if (!have) { for (int i = tid; i < 3072; i += NTHR) { const int cv = i >> 10, k = i & 1023; const float x = cv == 0 ? p.c_ctx[k] : p.c[(cv - 1) * D + k]; sc[i] = silu_f(x); } have = true; }
            __syncthreads();
            const int l = it / 96, cgp = it % 96, col = cgp * 64 + lane;
            const float* w = p.w_mod + (size_t)l * D * 6144 + col;
            float a0 = 0.f, a1 = 0.f, a2 = 0.f;
#pragma unroll 8
            for (int k = wid * 128; k < wid * 128 + 128; ++k) { const float wv = w[(size_t)k * 6144]; a0 += sc[k] * wv; a1 += sc[1024 + k] * wv; a2 += sc[2048 + k] * wv; }
            red[(wid * 3 + 0) * 64 + lane] = a0; red[(wid * 3 + 1) * 64 + lane] = a1; red[(wid * 3 + 2) * 64 + lane] = a2;
            __syncthreads();
            if (tid < 192) { const int cv = tid >> 6, ln = tid & 63; float s = p.b_mod[l * 6144 + cgp * 64 + ln];
#pragma unroll
                for (int w8 = 0; w8 < 8; ++w8) s += red[(w8 * 3 + cv) * 64 + ln];
                p.modv[(l * 3 + cv) * 6144 + cgp * 64 + ln] = s; }
        }
        __syncthreads();
    }
    {
        auto tile_desc = [&](int g, const float*& src, int& K, int& N, bf16_t*& dst, int& k0, int& n0) {
            int t = g;
            if (t < 384) { src = p.w_in_ab; K = 1024; N = 1536; dst = p.WinT; }
            else if ((t -= 384) < 64) { src = p.s5_w_glu; K = 512; N = 512; dst = p.WgluT; }
            else if ((t -= 64) < 256) { src = p.w_out_ab; K = 1024; N = 1024; dst = p.WoutT; }
            else if ((t -= 256) < 768) { src = p.w_in_c; K = 1024; N = 3072; dst = p.WincT; }
            else if ((t -= 768) < 256) { src = p.w_out_c; K = 1024; N = 1024; dst = p.WoutcT; }
            else { t -= 256; const int m = t & 15; const bool isx = t >= 16; src = (isx ? p.lru_w_x : p.lru_w_a) + (size_t)m * 4096; K = 64; N = 64; dst = (isx ? p.WxT : p.WaT) + (size_t)m * 4096; t = 0; }
            const int nkt = K / 64; k0 = (t % nkt) * 64; n0 = (t / nkt) * 64;
        };
        float va[8], vb[8];
        int g = bid;
        const float* src; int K, N, k0, n0; bf16_t* dst;
        if (g < 1760) { tile_desc(g, src, K, N, dst, k0, n0); tile_load(src, N, k0, n0, tid, va); }
        for (; g < 1760; g += G) {
            const float* src2 = src; int K2 = K, N2 = N, k02 = k0, n02 = n0; bf16_t* dst2 = dst;
            const bool hn = g + G < 1760;
            if (hn) { tile_desc(g + G, src2, K2, N2, dst2, k02, n02); tile_load(src2, N2, k02, n02, tid, vb); }
            tile_store(va, K, dst, k0, n0, tid, lds);
            if (hn) {
#pragma unroll
                for (int i = 0; i < 8; ++i) va[i] = vb[i];
                src = src2; K = K2; N = N2; k0 = k02; n0 = n02; dst = dst2; }
        }
        __syncthreads();
    }
    for (int task = __builtin_amdgcn_readfirstlane(bid * 8 + wid); task < 4096; task += G * 8) {
        const int kt = task & 31, k4 = (task >> 5) & 3, hp = (task >> 7) & 15, l = task >> 11;
        const int r = lane & 31, hh = lane >> 5;
        const float* kp = p.peer_keys + (((size_t)(l * 16 + hp) * 128) + 32 * k4 + r) * 128 + 8 * hh;
        const float* wp = p.peer_wq + ((size_t)l * 1024 + 32 * kt + r) * 2048 + hp * 128 + 8 * hh;
        f32x16 accw = {0.f, 0.f, 0.f, 0.f, 0.f, 0.f, 0.f, 0.f, 0.f, 0.f, 0.f, 0.f, 0.f, 0.f, 0.f, 0.f};
        f32x4 ka[8][2], wa[8][2];
#pragma unroll
        for (int ks = 0; ks < 8; ++ks) { ka[ks][0] = *(const f32x4*)(kp + 16 * ks); ka[ks][1] = *(const f32x4*)(kp + 16 * ks + 4); wa[ks][0] = *(const f32x4*)(wp + 16 * ks); wa[ks][1] = *(const f32x4*)(wp + 16 * ks + 4); }
#pragma unroll
        for (int ks = 0; ks < 8; ++ks) {
            u32x4 au, bu; au.x = pk_bf16(ka[ks][0][0], ka[ks][0][1]); au.y = pk_bf16(ka[ks][0][2], ka[ks][0][3]); au.z = pk_bf16(ka[ks][1][0], ka[ks][1][1]); au.w = pk_bf16(ka[ks][1][2], ka[ks][1][3]);
            bu.x = pk_bf16(wa[ks][0][0], wa[ks][0][1]); bu.y = pk_bf16(wa[ks][0][2], wa[ks][0][3]); bu.z = pk_bf16(wa[ks][1][0], wa[ks][1][1]); bu.w = pk_bf16(wa[ks][1][2], wa[ks][1][3]);
            accw = __builtin_amdgcn_mfma_f32_32x32x16_bf16(__builtin_bit_cast(bf16x8, au), __builtin_bit_cast(bf16x8, bu), accw, 0, 0, 0); }
        bf16_t* dstw = p.WqT + ((size_t)l * 2048 + hp * 128 + 32 * k4) * 1024 + 32 * kt + r;
#pragma unroll
        for (int e = 0; e < 16; ++e) dstw[(size_t)((e & 3) + 8 * (e >> 2) + 4 * hh) * 1024] = f2bf(accw[e]);
    }
    for (int r0 = __builtin_amdgcn_readfirstlane(bid * 8 + wid) * 4; r0 < 65536; r0 += G * 32) {
        const int q = lane & 31, hl = lane >> 5;
        f32x4 v[2][8];
#pragma unroll
        for (int k = 0; k < 2; ++k) { const int r = r0 + 2 * k + hl; const bool isv = r >= 32768; const int rr = r & 32767;
            const float* src = (isv ? p.peer_v : p.peer_u) + (size_t)rr * D;
#pragma unroll
            for (int i = 0; i < 8; ++i) v[k][i] = __builtin_nontemporal_load((const f32x4*)(src + 4 * q + 128 * i)); }
#pragma unroll
        for (int k = 0; k < 2; ++k) { const int r = r0 + 2 * k + hl; const bool isv = r >= 32768; const int rr = r & 32767;
            float am = 0.f;
#pragma unroll
            for (int i = 0; i < 8; ++i) am = fmaxf(am, fmaxf(fmaxf(fabsf(v[k][i][0]), fabsf(v[k][i][1])), fmaxf(fabsf(v[k][i][2]), fabsf(v[k][i][3]))));
#pragma unroll
            for (int o = 16; o > 0; o >>= 1) am = fmaxf(am, __shfl_xor(am, o));
            if (!isv) {
                const float sc = am > 0.f ? 7.5f / am : 1.f;
                u32x6p w;
#pragma unroll
                for (int h2 = 0; h2 < 2; ++h2) { unsigned cc[16];
#pragma unroll
                    for (int n = 0; n < 16; ++n) cc[n] = fp6code(v[k][4 * h2 + (n >> 2)][n & 3] * sc);
                    w[3 * h2] = cc[0] | (cc[1] << 6) | (cc[2] << 12) | (cc[3] << 18) | (cc[4] << 24) | (cc[5] << 30);
                    w[3 * h2 + 1] = (cc[5] >> 2) | (cc[6] << 4) | (cc[7] << 10) | (cc[8] << 16) | (cc[9] << 22) | (cc[10] << 28);
                    w[3 * h2 + 2] = (cc[10] >> 4) | (cc[11] << 2) | (cc[12] << 8) | (cc[13] << 14) | (cc[14] << 20) | (cc[15] << 26); }
                uchar* dst = p.Ub + (size_t)rr * 768;
                *(u32x4*)(dst + 16 * q) = (u32x4){w[0], w[1], w[2], w[3]}; *(u32x2*)(dst + 512 + 8 * q) = (u32x2){w[4], w[5]};
                if (q == 0) p.SU[rr] = am > 0.f ? am * (1.f / 7.5f) : 1.f;
            } else {
                const float sc = am > 0.f ? 6.f / am : 1.f;
                u32x4 w;
#pragma unroll
                for (int d = 0; d < 4; ++d) { unsigned acc4 = 0u;
#pragma unroll
                    for (int n = 0; n < 8; ++n) acc4 |= fp4code(v[k][2 * d + (n >> 2)][n & 3] * sc) << (4 * n);
                    w[d] = acc4; }
                *(u32x4*)(p.Vb + (size_t)rr * 512 + 16 * q) = w;
                if (q == 0) p.SV[rr] = am > 0.f ? am * (1.f / 6.f) : 1.f;
            } }
    }
    if (gtid < 65536) {
        const int idx = gtid >> 4, c = gtid & 15, dg = idx >> 6, pp = idx & 63;
        const double ar = p.s5_a_re[idx], ai = p.s5_a_im[idx], dt = exp((double)p.s5_log_dt[dg]);
        const double mag = exp(ar * dt), abr = mag * cos(ai * dt), abi = mag * sin(ai * dt);
        const double den = ar * ar + ai * ai, nr = abr - 1.0;
        const double cr = (nr * ar + abi * ai) / den, ci = (abi * ar - nr * ai) / den;
        if (c == 0) { p.abar[idx * 2] = (float)abr; p.abar[idx * 2 + 1] = (float)abi;
            const double m256 = exp(256.0 * ar * dt), a256 = fmod(256.0 * ai * dt, 6.283185307179586476925);
            p.aL[idx * 2] = (float)(m256 * cos(a256)); p.aL[idx * 2 + 1] = (float)(m256 * sin(a256)); }
        const double br = p.s5_b_re[idx * 16 + c], bi = p.s5_b_im[idx * 16 + c];
        p.Bmat[((size_t)dg * 128 + 2 * pp) * 16 + c] = f2bf((float)(cr * br - ci * bi));
        p.Bmat[((size_t)dg * 128 + 2 * pp + 1) * 16 + c] = f2bf((float)(cr * bi + ci * br));
        p.CmT[((size_t)dg * 16 + c) * 128 + 2 * pp] = f2bf(p.s5_c_re[((size_t)dg * 16 + c) * 64 + pp]);
        p.CmT[((size_t)dg * 16 + c) * 128 + 2 * pp + 1] = f2bf(-p.s5_c_im[((size_t)dg * 16 + c) * 64 + pp]);
    }
    {
        LAS float* w1s = (LAS float*)lds; LAS float* w2s = (LAS float*)(lds + 33 * 64 * 4);
        __syncthreads();
        for (int i = tid; i < 33 * 64; i += NTHR) w1s[i] = p.hy_w1[i];
        for (int i = tid; i < 64 * 64; i += NTHR) w2s[i] = p.hy_w2[i];
        __syncthreads();
        const int j = lane; const float b1 = p.hy_b1[j], f1 = p.hy_f1[j], b2 = p.hy_b2[j], f2 = p.hy_f2[j];
        for (int pi = __builtin_amdgcn_readfirstlane(bid * 8 + wid); pi < 4352; pi += G * 8) {
            const int L = pi < 256 ? 256 : 4096, pos = pi < 256 ? pi : pi - 256;
            float emb = 0.f;
            if (j == 0) emb = (float)pos / (float)L;
            else if (j < 33) { const int bi = (j - 1) & 15; const float band = 1e-4f + (15.f - 1e-4f) * (float)bi / 15.f;
                const float ang = (6.283185307179586f / (float)L) * (float)pos * band; emb = j <= 16 ? cosf(ang) : -sinf(ang); }
            float a = b1;
#pragma unroll
            for (int k = 0; k < 33; ++k) a += __shfl(emb, k) * w1s[k * 64 + j];
            const float z1 = sinf(f1 * a);
            float c2 = b2;
#pragma unroll
            for (int k = 0; k < 64; ++k) c2 += __shfl(z1, k) * w2s[k * 64 + j];
            p.Z2[(size_t)pi * 64 + j] = sinf(f2 * c2);
        }
        __syncthreads();
    }
    if (gtid < 2048) p.NORMSQ[gtid] = 0.f;
}

__device__ __forceinline__ void norm_one(const MKP& p, const float* xr, int t, const float* gvec, const float* modv_l, int sh_chunk, int sc_chunk, bf16_t* hout, float* fout, int lane) {
    f32x4 v[4], g[4], sc[4], sh[4]; float s = 0.f;
    const float* mv = modv_l + (size_t)tok_cv(t) * 6144;
#pragma unroll
    for (int i = 0; i < 4; ++i) { const int c = 4 * lane + 256 * i; v[i] = *(const f32x4*)(xr + c); g[i] = *(const f32x4*)(gvec + c);
        if (hout) { sc[i] = *(const f32x4*)(mv + sc_chunk * D + c); sh[i] = *(const f32x4*)(mv + sh_chunk * D + c); } }
#pragma unroll
    for (int i = 0; i < 4; ++i) s += v[i][0] * v[i][0] + v[i][1] * v[i][1] + v[i][2] * v[i][2] + v[i][3] * v[i][3];
    s = wave_sum(s);
    const float rstd = rsqrtf(s * (1.f / D) + EPSV);
#pragma unroll
    for (int i = 0; i < 4; ++i) { const int c = 4 * lane + 256 * i;
        f32x4 y; y[0] = v[i][0] * rstd * g[i][0]; y[1] = v[i][1] * rstd * g[i][1]; y[2] = v[i][2] * rstd * g[i][2]; y[3] = v[i][3] * rstd * g[i][3];
        if (hout) { u32x2 w; w.x = pk_bf16(y[0] * (1.f + sc[i][0]) + sh[i][0], y[1] * (1.f + sc[i][1]) + sh[i][1]); w.y = pk_bf16(y[2] * (1.f + sc[i][2]) + sh[i][2], y[3] * (1.f + sc[i][3]) + sh[i][3]);
            *(u32x2*)(hout + (size_t)t * D + c) = w; }
        else *(f32x4*)(fout + (size_t)t * D + c) = y; }
}
__device__ __forceinline__ void norm_phase(const MKP& p, bool from_input, const float* gvec, const float* modv_l, int sh_chunk, int sc_chunk, bf16_t* hout) {
    int tid = threadIdx.x; asm volatile("" : "+v"(tid));
    const int wid = tid >> 6, lane = tid & 63;
    for (int t = __builtin_amdgcn_readfirstlane(blockIdx.x * 8 + wid); t < NTOK; t += gridDim.x * 8)
        norm_one(p, from_input ? xin_row(p, t) : p.X + (size_t)t * D, t, gvec, modv_l, sh_chunk, sc_chunk, hout, p.out, lane);
}

__device__ __forceinline__ void hyfilt_phase(const MKP& p, LAS uchar* lds, bool dry = false) {
    LAS float* z2 = (LAS float*)lds;
    int tid = threadIdx.x; asm volatile("" : "+v"(tid));
    for (int it = blockIdx.x; it < 272; it += gridDim.x) {
        const bool big = it >= 16; const int L = big ? 4096 : 256; const int p0 = (big ? it - 16 : it) * 16; const int pbase = (big ? 256 : 0) + p0;
        __syncthreads();
#pragma unroll
        for (int i = 0; i < 2; ++i) z2[tid + NTHR * i] = p.Z2[(size_t)pbase * 64 + tid + NTHR * i];
        __syncthreads();
        const int col0 = 4 * tid;
        f32x4 acc[16];
#pragma unroll
        for (int q = 0; q < 16; ++q) acc[q] = (f32x4){0.f, 0.f, 0.f, 0.f};
#pragma unroll 4
        for (int k = 0; k < 64; ++k) { const f32x4 w = *(const f32x4*)(p.hy_w3 + (size_t)k * 2048 + col0);
#pragma unroll
            for (int q = 0; q < 16; ++q) { const float z = z2[q * 64 + k]; acc[q][0] += z * w[0]; acc[q][1] += z * w[1]; acc[q][2] += z * w[2]; acc[q][3] += z * w[3]; } }
        const f32x4 dec = *(const f32x4*)(p.hy_decay + col0);
        const int dir = col0 >> 10, ch0 = col0 & 1023;
        bf16_t* R = p.Rf + (big ? (size_t)1024 * 512 : 0);
        const int RL = 2 * L;
        float ss[4] = {0.f, 0.f, 0.f, 0.f};
#pragma unroll
        for (int e = 0; e < 4; ++e) {
            const float ad = fabsf(dec[e]); bf16_t* Rc = R + (size_t)(ch0 + e) * RL;
#pragma unroll
            for (int g8 = 0; g8 < 2; ++g8) { float val[8];
#pragma unroll
                for (int q = 0; q < 8; ++q) { const int pos = p0 + 8 * g8 + q; const float tt = (float)pos / (float)L; val[q] = acc[8 * g8 + q][e] * (__expf(-tt * ad) + 0.05f);
                    if (dir == 0 || pos >= 1) ss[e] += val[q] * val[q]; }
                const int pg = p0 + 8 * g8;
                if (dir == 0) {
                    u32x4 w; w.x = pk_bf16(val[7], val[6]); w.y = pk_bf16(val[5], val[4]); w.z = pk_bf16(val[3], val[2]); w.w = pk_bf16(val[1], val[0]);
                    *(u32x4*)(Rc + (L - 8 - pg)) = w;
                } else {
                    bf16_t* d1 = Rc + (L - 1 + pg);
                    if (pg >= 1) d1[0] = f2bf(val[0]);
                    *(unsigned*)(d1 + 1) = pk_bf16(val[1], val[2]); *(unsigned*)(d1 + 3) = pk_bf16(val[3], val[4]); *(unsigned*)(d1 + 5) = pk_bf16(val[5], val[6]);
                    d1[7] = f2bf(val[7]);
                } } }
#pragma unroll
        for (int e = 0; e < 4; ++e) p.PSQ[(size_t)it * 2048 + col0 + e] = ss[e];
    }
}

#define S5ROW 528
__device__ __forceinline__ float fsigmoid(float x) { return __builtin_amdgcn_rcpf(1.f + __expf(-x)); }
__device__ __forceinline__ float fgelu(float x) { const float z = 1.5957691216057308f * (x + 0.044715f * x * x * x); return x * __builtin_amdgcn_rcpf(1.f + __expf(-z)); }
__device__ __forceinline__ float one_minus_exp(float y) { const float t = y * (1.f + y * (0.5f + y * (0.16666667f + y * 0.041666668f))); return y > -0.125f ? -t : 1.f - __expf(y); }

__device__ __forceinline__ void s5_task(const MKP& p, int seqid, int g, int seg, int mode, LAS uchar* wl, int lane) {
    asm volatile("" : "+v"(lane));
    const bool ctx = seqid < 32; const int b = ctx ? seqid : seqid - 32;
    const int t0 = ctx ? seqid * 256 : CTX_TOK + b * 4096 + seg * 256;
    const int r = lane & 31, hh = lane >> 5, fr = lane & 15, fq = lane >> 4;
    const bool full = ctx || mode == 1;
    bf16_t* YP = (bf16_t*)p.HS;
    const f32x4 dsk = *(const f32x4*)(p.s5_d + 16 * g + 4 * fq);
#pragma nounroll
    for (int d = 0; d < 2; ++d) {
        const int dg = d * 32 + g;
        bf16x8 bm[4], cm[4];
#pragma unroll
        for (int nt = 0; nt < 4; ++nt) bm[nt] = *(const bf16x8*)(p.Bmat + ((size_t)dg * 128 + 32 * nt + r) * 16 + 8 * hh);
#pragma unroll
        for (int ks = 0; ks < 4; ++ks) cm[ks] = *(const bf16x8*)(p.CmT + ((size_t)dg * 16 + fr) * 128 + 32 * ks + 8 * fq);
        const float ar = p.abar[(dg * 64 + lane) * 2], ai = p.abar[(dg * 64 + lane) * 2 + 1];
        float hr = 0.f, hi = 0.f;
        if (!ctx && mode == 1) {
            hr = p.st_re[((b * 2 + d) * 32 + g) * 64 + lane]; hi = p.st_im[((b * 2 + d) * 32 + g) * 64 + lane];
            const float lr = p.aL[(dg * 64 + lane) * 2], li = p.aL[(dg * 64 + lane) * 2 + 1];
            const float* car = p.S5car + ((size_t)((b * 2 + d) * 32 + g) * 16) * 128;
            f32x2 cs[15];
#pragma unroll
            for (int i = 0; i < 15; ++i) { const int s = d == 0 ? i : 15 - i; const bool use = d == 0 ? (s < seg) : (s > seg);
                cs[i] = *(const f32x2*)(car + (use ? s : seg) * 128 + lane * 2); }
#pragma unroll
            for (int i = 0; i < 15; ++i) { const int s = d == 0 ? i : 15 - i; const bool use = d == 0 ? (s < seg) : (s > seg);
                const float nr = lr * hr - li * hi + cs[i][0], ni = lr * hi + li * hr + cs[i][1]; hr = use ? nr : hr; hi = use ? ni : hi; }
        }
        bf16x8 uf = *(const bf16x8*)(p.Zb + (size_t)(t0 + 32 * (d == 0 ? 0 : 7) + r) * 1536 + 16 * g + 8 * hh);
#pragma nounroll
        for (int step = 0; step < 8; ++step) {
            const int sb = d == 0 ? step : 7 - step; const int tb = t0 + 32 * sb;
            const int sbn = d == 0 ? (step < 7 ? step + 1 : 7) : (step < 7 ? 6 - step : 0);
            const bf16x8 ufn = *(const bf16x8*)(p.Zb + (size_t)(t0 + 32 * sbn + r) * 1536 + 16 * g + 8 * hh);
            u32x2 epre[2];
            if (full) {
#pragma unroll
                for (int mt = 0; mt < 2; ++mt) { const size_t t = tb + 16 * mt + fr;
                    epre[mt] = d == 0 ? *(const u32x2*)(p.Zb + t * 1536 + 16 * g + 4 * fq) : *(const u32x2*)(YP + t * 512 + 16 * g + 4 * fq); }
            }
#pragma unroll
            for (int nt = 0; nt < 4; ++nt) {
                f32x16 dd = {0.f, 0.f, 0.f, 0.f, 0.f, 0.f, 0.f, 0.f, 0.f, 0.f, 0.f, 0.f, 0.f, 0.f, 0.f, 0.f};
                dd = __builtin_amdgcn_mfma_f32_32x32x16_bf16(bm[nt], uf, dd, 0, 0, 0);
#pragma unroll
                for (int q = 0; q < 4; ++q) { f32x4 w = {dd[4 * q], dd[4 * q + 1], dd[4 * q + 2], dd[4 * q + 3]};
                    *(LAS f32x4*)(wl + r * S5ROW + (32 * nt + 8 * q + 4 * hh) * 4) = w; }
            }
            uf = ufn;
            f32x2 bu[32];
#pragma unroll
            for (int jj = 0; jj < 32; ++jj) { const int j = d == 0 ? jj : 31 - jj; bu[jj] = *(const LAS f32x2*)(wl + j * S5ROW + 8 * lane); }
            { f32x2 h = {hr, hi}; const f32x2 a1 = {ar, ar}, a2 = {-ai, ai};
#pragma unroll
              for (int jj = 0; jj < 32; ++jj) { const int j = d == 0 ? jj : 31 - jj;
                const f32x2 hs = __builtin_shufflevector(h, h, 1, 0); const f32x2 t = a1 * h + bu[jj]; h = a2 * hs + t;
                if (full) *(LAS unsigned*)(wl + j * S5ROW + 4 * lane) = pk_bf16(h[0], h[1]); }
              hr = h[0]; hi = h[1]; }
            if (full) {
#pragma unroll
                for (int mt = 0; mt < 2; ++mt) {
                    f32x4 y = {0.f, 0.f, 0.f, 0.f};
#pragma unroll
                    for (int ks = 0; ks < 4; ++ks) { const bf16x8 hf = *(const LAS bf16x8*)(wl + (16 * mt + fr) * S5ROW + 64 * ks + 16 * fq);
                        y = __builtin_amdgcn_mfma_f32_16x16x32_bf16(cm[ks], hf, y, 0, 0, 0); }
                    const size_t t = tb + 16 * mt + fr;
                    if (d == 0) {
                        const u32x2 uu = epre[mt];
                        y[0] += dsk[0] * bflo(uu.x); y[1] += dsk[1] * bfhi(uu.x); y[2] += dsk[2] * bflo(uu.y); y[3] += dsk[3] * bfhi(uu.y);
                        u32x2 w; w.x = pk_bf16(y[0], y[1]); w.y = pk_bf16(y[2], y[3]); *(u32x2*)(YP + t * 512 + 16 * g + 4 * fq) = w;
                    } else {
                        const u32x2 yp = epre[mt];
                        y[0] += bflo(yp.x); y[1] += bfhi(yp.x); y[2] += bflo(yp.y); y[3] += bfhi(yp.y);
                        u32x2 w; w.x = pk_bf16(fgelu(y[0]), fgelu(y[1])); w.y = pk_bf16(fgelu(y[2]), fgelu(y[3])); *(u32x2*)(p.ZS + t * 512 + 16 * g + 4 * fq) = w;
                    }
                }
            }
        }
        if (ctx) { float* nre = p.out + (size_t)NTOK * D; float* nim = nre + 131072;
            nre[((b * 2 + d) * 32 + g) * 64 + lane] = hr; nim[((b * 2 + d) * 32 + g) * 64 + lane] = hi; }
        else if (mode == 0) { float* car = p.S5car + ((size_t)((b * 2 + d) * 32 + g) * 16 + seg) * 128; car[lane * 2] = hr; car[lane * 2 + 1] = hi; }
        asm volatile("s_waitcnt vmcnt(0)" ::: "memory");
    }
}

#define LRU_XA 144
#define LRU_G 528
__device__ __forceinline__ void lru_task(const MKP& p, int ck, int h, int mode, LAS uchar* wl, int lane) {
    asm volatile("" : "+v"(lane));
    const bool ctx = ck < 128; const int b = ctx ? (ck >> 2) : ((ck - 128) >> 6); const int cis = ctx ? (ck & 3) : ((ck - 128) & 63); const int nch = ctx ? 4 : 64;
    const int seqbase = ctx ? b * 256 : CTX_TOK + b * 4096;
    const int t0 = ck * 64;
    const int rowlen = ctx ? 256 : 64;
    const int rs = seqbase + ((t0 - seqbase) / rowlen) * rowlen, re = rs + rowlen;
    const int fr = lane & 15, fq = lane >> 4;
    const int ch = 64 * h + lane;
    LAS uchar* xa = wl; LAS uchar* gl = wl + 64 * LRU_XA;
    bf16_t* HF = (bf16_t*)p.HS + (size_t)NTOK * 512;
    {
        const float cw0 = p.lru_conv_w[ch], cw1 = p.lru_conv_w[512 + ch], cw2 = p.lru_conv_w[1024 + ch], cw3 = p.lru_conv_w[1536 + ch], cb = p.lru_conv_b[ch];
        float xr[67];
#pragma unroll
        for (int i = 0; i < 67; ++i) { const int tt = t0 - 2 + i; const int tc = tt < rs ? rs : (tt >= re ? re - 1 : tt);
            const float v = bf2f(p.Zb[(size_t)tc * 1536 + 512 + ch]); xr[i] = (tt >= rs && tt < re) ? v : 0.f; }
#pragma unroll
        for (int j = 0; j < 64; ++j) *(LAS bf16_t*)(xa + j * LRU_XA + 2 * lane) = f2bf(cb + cw0 * xr[j] + cw1 * xr[j + 1] + cw2 * xr[j + 2] + cw3 * xr[j + 3]);
    }
#pragma nounroll
    for (int d = 0; d < 2; ++d) {
        bf16x8 wa[4][2], wx[4][2];
#pragma unroll
        for (int nt = 0; nt < 4; ++nt)
#pragma unroll
            for (int ks = 0; ks < 2; ++ks) { const size_t o = ((size_t)(d * 8 + h) * 64 + 16 * nt + fr) * 64 + 32 * ks + 8 * fq;
                wa[nt][ks] = *(const bf16x8*)(p.WaT + o); wx[nt][ks] = *(const bf16x8*)(p.WxT + o); }
        const float ba = p.lru_b_a[d * 512 + ch], bx = p.lru_b_x[d * 512 + ch];
        const float lm = -p.lru_lambda[d * 512 + ch]; const float sp8 = -8.f * (lm > 20.f ? lm : log1pf(expf(lm)));
        float hst = 0.f, aprod = 1.f;
        if (mode == 1) {
            hst = ctx ? 0.f : p.st_lru[(b * 2 + d) * 512 + ch];
            const float* car = p.LRUcar + ((size_t)(ck - cis) * 2 + d) * 1024 + ch * 2;
            const int nprev = d == 0 ? cis : nch - 1 - cis;
            for (int b0 = 0; b0 < nprev; b0 += 16) {
                f32x2 cc[16];
#pragma unroll
                for (int i = 0; i < 16; ++i) { const int k = b0 + i; const int s = d == 0 ? k : nch - 1 - k; const int sc = k < nprev ? s : cis;
                    cc[i] = *(const f32x2*)(car + (size_t)sc * 2048); }
#pragma unroll
                for (int i = 0; i < 16; ++i) { const float nh = cc[i][0] * hst + cc[i][1]; hst = (b0 + i < nprev) ? nh : hst; }
            }
        }
#pragma nounroll
        for (int step = 0; step < 4; ++step) {
            const int sb = d == 0 ? step : 3 - step; const int tb = t0 + 16 * sb;
            float xg[16]; unsigned hfp[16];
            if (mode == 1 && d == 1) {
#pragma unroll
                for (int jj = 0; jj < 16; ++jj) { const size_t t = tb + 15 - jj; xg[jj] = bf2f(p.Zb[t * 1536 + 1024 + ch]); hfp[jj] = HF[t * 512 + ch]; }
            }
            bf16x8 xf[2];
#pragma unroll
            for (int ks = 0; ks < 2; ++ks) xf[ks] = *(const LAS bf16x8*)(xa + (16 * sb + fr) * LRU_XA + 64 * ks + 16 * fq);
#pragma unroll
            for (int nt = 0; nt < 4; ++nt) {
                f32x4 da = {0.f, 0.f, 0.f, 0.f}, dx = {0.f, 0.f, 0.f, 0.f};
#pragma unroll
                for (int ks = 0; ks < 2; ++ks) { da = __builtin_amdgcn_mfma_f32_16x16x32_bf16(wa[nt][ks], xf[ks], da, 0, 0, 0); dx = __builtin_amdgcn_mfma_f32_16x16x32_bf16(wx[nt][ks], xf[ks], dx, 0, 0, 0); }
                *(LAS f32x4*)(gl + fr * LRU_G + (16 * nt + 4 * fq) * 4) = da;
                *(LAS f32x4*)(gl + fr * LRU_G + 256 + (16 * nt + 4 * fq) * 4) = dx;
            }
            float av[16], bv[16];
#pragma unroll
            for (int jj = 0; jj < 16; ++jj) { const int j = d == 0 ? jj : 15 - jj;
                const float ra = *(const LAS float*)(gl + j * LRU_G + 4 * lane) + ba, rx = *(const LAS float*)(gl + j * LRU_G + 256 + 4 * lane) + bx;
                const float xbv = bf2f(*(const LAS bf16_t*)(xa + (16 * sb + j) * LRU_XA + 2 * lane));
                const float la = sp8 * fsigmoid(ra); av[jj] = __expf(la);
                bv[jj] = __builtin_amdgcn_sqrtf(one_minus_exp(2.f * la)) * (fsigmoid(rx) * xbv); }
#pragma unroll
            for (int jj = 0; jj < 16; ++jj) { hst = av[jj] * hst + bv[jj]; aprod *= av[jj]; bv[jj] = hst; }
            if (mode == 1) {
                if (d == 0) {
#pragma unroll
                    for (int jj = 0; jj < 16; ++jj) HF[(size_t)(tb + jj) * 512 + ch] = f2bf(bv[jj]);
                } else {
#pragma unroll
                    for (int jj = 0; jj < 16; ++jj) p.CAT[(size_t)(tb + 15 - jj) * D + 512 + ch] = f2bf((bf2f((bf16_t)hfp[jj]) + bv[jj]) * fgelu(xg[jj]));
                }
            }
        }
        if (mode == 0) { float* car = p.LRUcar + ((size_t)ck * 2 + d) * 1024 + ch * 2; *(f32x2*)car = (f32x2){aprod, hst}; }
        else if (ctx && ((d == 0 && cis == 3) || (d == 1 && cis == 0))) { float* nl = p.out + (size_t)NTOK * D + 262144; nl[(b * 2 + d) * 512 + ch] = hst; }
        asm volatile("s_waitcnt vmcnt(0)" ::: "memory");
    }
}

__device__ __forceinline__ void scan_phase(const MKP& p, int pass, LAS uchar* lds, int which = 3) {
    int tid = threadIdx.x; asm volatile("" : "+v"(tid));
    const int wid = tid >> 6, lane = tid & 63;
    LAS uchar* wl = lds + wid * 20480;
    const int gw = __builtin_amdgcn_readfirstlane(blockIdx.x * 8 + wid), GW = gridDim.x * 8;
    if (which & 1)
    for (int task = gw; task < 1536; task += GW) {
        int seqid, g, seg, mode;
        if (task < 1024) { seqid = 32 + (task >> 9); seg = (task >> 5) & 15; g = task & 31; mode = pass; }
        else { const int i = (task - 1024) + pass * 512; seqid = i >> 5; g = i & 31; seg = 0; mode = 1; }
        s5_task(p, seqid, g, seg, mode, wl, lane);
    }
    asm volatile("" ::: "memory");
    if (which & 2)
    for (int i = (gw + GW - (1536 % GW)) % GW; i < 2048; i += GW) lru_task(p, i >> 3, i & 7, pass, wl, lane);
}

__device__ __forceinline__ unsigned f2key(float f) { const unsigned u = __float_as_uint(f); return u ^ ((unsigned)((int)u >> 31) | 0x80000000u); }
template <int CTRL> __device__ __forceinline__ unsigned dppu(unsigned x) { return (unsigned)__builtin_amdgcn_update_dpp(0, (int)x, CTRL, 0xf, 0xf, false); }
template <int CTRL> __device__ __forceinline__ float dppf(float x) { return __int_as_float(__builtin_amdgcn_update_dpp(0, __float_as_int(x), CTRL, 0xf, 0xf, false)); }
__device__ __forceinline__ unsigned rowmax_u(unsigned x) { unsigned t; t = dppu<0x121>(x); x = x > t ? x : t; t = dppu<0x122>(x); x = x > t ? x : t; t = dppu<0x124>(x); x = x > t ? x : t; t = dppu<0x128>(x); x = x > t ? x : t; return x; }
__device__ __forceinline__ float rowmax_f(float x) { x = fmaxf(x, dppf<0x121>(x)); x = fmaxf(x, dppf<0x122>(x)); x = fmaxf(x, dppf<0x124>(x)); x = fmaxf(x, dppf<0x128>(x)); return x; }
__device__ __forceinline__ float rowsum_f(float x) { x += dppf<0x121>(x); x += dppf<0x122>(x); x += dppf<0x124>(x); x += dppf<0x128>(x); return x; }
#define CEX(a, b) { const unsigned _hi = (a) > (b) ? (a) : (b), _lo = (a) > (b) ? (b) : (a); (a) = _hi; (b) = _lo; }

#define PS_ROW 528

#define R2_SV0 135168
#define R2_SI0 151552
struct OneUnit { int pm, pn;
    __device__ bool next(int i, pg8::Unit& u) const { if (i != 0) return false; u.pm = pm; u.pn = pn; return true; }
    __device__ __forceinline__ void a_ready(const pg8::Unit&) const {}
    __device__ __forceinline__ void done(const pg8::Unit&) const {}
};
struct R2Tab { unsigned v[16]; };
constexpr R2Tab r2_make_tab() {
    R2Tab t{}; unsigned b[64] = {}; for (int n = 0; n < 64; ++n) b[n] = 255u;
    int n = 0;
    for (int i = 0; i < 16; ++i) for (int j = 0; j < 16; ++j) if ((i + 1) * (j + 1) <= 16) b[n++] = (unsigned)(i << 4 | j);
    for (int l = 0; l < 16; ++l) t.v[l] = b[l] | (b[16 + l] << 8) | (b[32 + l] << 16) | (b[48 + l] << 24);
    return t;
}
struct EpiTopk {
    static constexpr bool PERM = false, AFTER_DRAIN = true;
    const MKP* p; int layer;
    __device__ __forceinline__ void fused(f32x4 (&acc)[2][2][4][2], const pg8::Unit& u, int wr, int wc, int fr, int fq, LAS uchar* lds, int wid, int lane) const {
        const int pm = u.pm, h = u.pn; const int rbase = 32 * wid;
        unsigned r2tab = 0u;
        { constexpr R2Tab T = r2_make_tab();
#pragma unroll
          for (int l = 0; l < 16; ++l) r2tab = (fr == l) ? T.v[l] : r2tab; }
#pragma unroll
        for (int half = 0; half < 2; ++half) {
#pragma unroll
            for (int ai = 0; ai < 2; ++ai)
#pragma unroll
                for (int m = 0; m < 4; ++m)
#pragma unroll
                    for (int n = 0; n < 2; ++n) *(LAS f32x4*)(lds + (ai * 128 + wr * 64 + m * 16 + fr) * PS_ROW + (wc * 32 + n * 16 + 4 * fq) * 4) = acc[ai][half][m][n];
            __syncthreads();
#if defined(MK_PROBE) && ((MK_PROBE >> 15) & 1)
            for (int rep_ = 0; rep_ < 2; ++rep_)
#endif
            for (int rg = 0; rg < 8; rg += 2) {
                const int q = fr;
                int rowc[2]; unsigned kk[2][8]; unsigned res[2];
#pragma unroll
                for (int c = 0; c < 2; ++c) { rowc[c] = rbase + 4 * (rg + c) + fq; const LAS uchar* srow = lds + rowc[c] * PS_ROW;
                    const f32x4 s0 = *(const LAS f32x4*)(srow + 32 * q), s1 = *(const LAS f32x4*)(srow + 32 * q + 16);
#pragma unroll
                    for (int e = 0; e < 4; ++e) { kk[c][e] = (f2key(s0[e]) & ~127u) | (127u - (unsigned)(8 * q + e)); kk[c][4 + e] = (f2key(s1[e]) & ~127u) | (127u - (unsigned)(8 * q + 4 + e)); }
                    CEX(kk[c][0], kk[c][1]) CEX(kk[c][2], kk[c][3]) CEX(kk[c][4], kk[c][5]) CEX(kk[c][6], kk[c][7])
                    CEX(kk[c][0], kk[c][2]) CEX(kk[c][1], kk[c][3]) CEX(kk[c][4], kk[c][6]) CEX(kk[c][5], kk[c][7])
                    CEX(kk[c][1], kk[c][2]) CEX(kk[c][5], kk[c][6])
                    CEX(kk[c][0], kk[c][4]) CEX(kk[c][1], kk[c][5]) CEX(kk[c][2], kk[c][6]) CEX(kk[c][3], kk[c][7])
                    CEX(kk[c][2], kk[c][4]) CEX(kk[c][3], kk[c][5])
                    CEX(kk[c][1], kk[c][2]) CEX(kk[c][3], kk[c][4]) CEX(kk[c][5], kk[c][6])
                    res[c] = 0u; }
#pragma unroll
                for (int it = 0; it < 16; ++it) {
#pragma unroll
                    for (int c = 0; c < 2; ++c) { const unsigned mx = rowmax_u(kk[c][0]); res[c] = (q == it) ? mx : res[c]; const bool own = kk[c][0] == mx;
#pragma unroll
                        for (int e = 0; e < 7; ++e) kk[c][e] = own ? kk[c][e + 1] : kk[c][e];
                        kk[c][7] = own ? 0u : kk[c][7]; }
                }
                int idxc[2]; float valc[2];
#pragma unroll
                for (int c = 0; c < 2; ++c) { idxc[c] = 127 - (int)(res[c] & 127u); valc[c] = *(const LAS float*)(lds + rowc[c] * PS_ROW + 4 * idxc[c]); }
                if (half == 0) {
#pragma unroll
                    for (int c = 0; c < 2; ++c) { *(LAS float*)(lds + R2_SV0 + (rowc[c] * 16 + q) * 4) = valc[c]; *(LAS uchar*)(lds + R2_SI0 + rowc[c] * 16 + q) = (uchar)idxc[c]; }
                } else {
                    const int rowlane = lane & 48;
                    float sv0[2]; int si0[2]; unsigned cd[2][4]; unsigned res2[2];
#pragma unroll
                    for (int c = 0; c < 2; ++c) { sv0[c] = *(const LAS float*)(lds + R2_SV0 + (rowc[c] * 16 + q) * 4); si0[c] = *(const LAS uchar*)(lds + R2_SI0 + rowc[c] * 16 + q);
#pragma unroll
                        for (int s4 = 0; s4 < 4; ++s4) { const unsigned b = (r2tab >> (8 * s4)) & 255u;
                            const float sm = __shfl(sv0[c], rowlane + (int)(b >> 4)) + __shfl(valc[c], rowlane + (int)(b & 15u));
                            cd[c][s4] = b == 255u ? 0u : ((f2key(sm) & ~255u) | (255u - b)); }
                        CEX(cd[c][0], cd[c][1]) CEX(cd[c][2], cd[c][3]) CEX(cd[c][0], cd[c][2]) CEX(cd[c][1], cd[c][3]) CEX(cd[c][1], cd[c][2])
                        res2[c] = 0u; }
#pragma unroll
                    for (int it = 0; it < 16; ++it) {
#pragma unroll
                        for (int c = 0; c < 2; ++c) { const unsigned mx = rowmax_u(cd[c][0]); res2[c] = (q == it) ? mx : res2[c]; const bool own = cd[c][0] == mx;
                            cd[c][0] = own ? cd[c][1] : cd[c][0]; cd[c][1] = own ? cd[c][2] : cd[c][1]; cd[c][2] = own ? cd[c][3] : cd[c][2]; cd[c][3] = own ? 0u : cd[c][3]; }
                    }
#pragma unroll
                    for (int c = 0; c < 2; ++c) {
                        const int flat = 255 - (int)(res2[c] & 255u); const int ii = flat >> 4, jj = flat & 15;
                        const float fv = __shfl(sv0[c], rowlane + ii) + __shfl(valc[c], rowlane + jj);
                        const int e0 = __shfl(si0[c], rowlane + ii), e1 = __shfl(idxc[c], rowlane + jj);
                        const float mx = rowmax_f(fv); const float ex = __expf(fv - mx); const float sm = rowsum_f(ex);
                        const int t = pm * 256 + rowc[c];
                        p->EI[(size_t)t * 128 + h * 16 + q] = e0 * 128 + e1;
                        p->EG[(size_t)t * 128 + h * 16 + q] = ex / sm; }
                }
            }
            __syncthreads();
        }
    }
};
__device__ __forceinline__ void peer_route2_phase(const MKP& p, int layer, LAS uchar* lds, const bf16_t* Hsrc) {
    const bf16_t* WkT = p.WqT + (size_t)layer * 2048 * 1024;
    for (int item = blockIdx.x; item < 512; item += gridDim.x) {
        OneUnit S{item >> 3, item & 7}; EpiTopk E{&p, layer};
        pg8::gemm_phase<EpiTopk, OneUnit, false>(lds, pg8::Gemm{Hsrc, WkT, NTOK, 2048, D}, S, E, nullptr);
        __syncthreads();
    }
}

typedef unsigned int u32x6 __attribute__((ext_vector_type(6)));
typedef float f32x32 __attribute__((ext_vector_type(32)));
typedef __bf16 bf16x32 __attribute__((ext_vector_type(32)));
template <int M> __device__ __forceinline__ bf16x2v bfpair(const bf16x32& v) { return __builtin_shufflevector(v, v, 2 * M, 2 * M + 1); }
__device__ __forceinline__ float readlane_f(float x, int l) { return __int_as_float(__builtin_amdgcn_readlane(__float_as_int(x), l)); }
__device__ __forceinline__ float dot2bf(unsigned a, bf16x2v b, float c) { return __builtin_amdgcn_fdot2_f32_bf16(__builtin_bit_cast(bf16x2v, a), b, c, false); }

__device__ __forceinline__ void pe_sort_header(int lane, int& ei0, int& ei1, float& eg0, float& eg1) {
    unsigned k0 = ((unsigned)ei0 << 7) | (unsigned)lane, k1 = ((unsigned)ei1 << 7) | (unsigned)(64 + lane);
#pragma unroll
    for (int k = 2; k <= 128; k <<= 1) {
        const bool asc = (lane & (k >> 1)) == 0;
#pragma unroll
        for (int j = k >> 1; j >= 2; j >>= 1) {
            const bool keepmin = ((lane & (j >> 1)) == 0) == asc;
            const unsigned p0 = (unsigned)__shfl_xor((int)k0, j >> 1), p1 = (unsigned)__shfl_xor((int)k1, j >> 1);
            const unsigned mn0 = k0 < p0 ? k0 : p0, mx0 = k0 < p0 ? p0 : k0, mn1 = k1 < p1 ? k1 : p1, mx1 = k1 < p1 ? p1 : k1;
            k0 = keepmin ? mn0 : mx0; k1 = keepmin ? mn1 : mx1; }
        { const unsigned mn = k0 < k1 ? k0 : k1, mx = k0 < k1 ? k1 : k0; k0 = asc ? mn : mx; k1 = asc ? mx : mn; } }
    const int s0 = (int)(k0 & 127u), s1 = (int)(k1 & 127u);
    const float a0 = __shfl(eg0, s0 & 63), b0 = __shfl(eg1, s0 & 63), a1 = __shfl(eg0, s1 & 63), b1 = __shfl(eg1, s1 & 63);
    eg0 = s0 < 64 ? a0 : b0; eg1 = s1 < 64 ? a1 : b1; ei0 = (int)(k0 >> 7); ei1 = (int)(k1 >> 7);
}

__device__ __forceinline__ unsigned pe_idx(bool hl, int ei0, int ei1, int j) { const int ia = __builtin_amdgcn_readlane(ei0, j), ib = __builtin_amdgcn_readlane(ei1, j); return (unsigned)(hl ? ib : ia); }
__device__ __forceinline__ void peer_eval_phase(const MKP& p, int layer, const float* gate  , bool last, bool dry) {
    int tid = threadIdx.x; asm volatile("" : "+v"(tid));
    const int wid = tid >> 6, lane = tid & 63, q = lane & 31; const bool hl = lane >= 32;
    const uchar* U0 = p.Ub + (size_t)layer * 16384 * 768 + 16 * q; const uchar* U1 = p.Ub + (size_t)layer * 16384 * 768 + 512 + 8 * q;
    const uchar* V0 = p.Vb + (size_t)layer * 16384 * 512 + 16 * q;
    const float* SU = p.SU + layer * 16384; const float* SV = p.SV + layer * 16384;
    const int eoff = 4 * q + (hl ? 512 : 0);
    const int tstride = gridDim.x * 8;
    int t = __builtin_amdgcn_readfirstlane(blockIdx.x * 8 + wid);
    u32x2 nh[8]; int nei0 = 0, nei1 = 0; float neg0 = 0.f, neg1 = 0.f, ndu0 = 0.f, ndu1 = 0.f, nsv0 = 0.f, nsv1 = 0.f;
#pragma unroll
    for (int i = 0; i < 8; ++i) nh[i] = (u32x2){0u, 0u};
    if (t < NTOK) {
#pragma unroll
        for (int i = 0; i < 8; ++i) nh[i] = *(const u32x2*)(p.Hb + (size_t)t * D + 4 * q + 128 * i);
        nei0 = p.EI[(size_t)t * 128 + lane]; nei1 = p.EI[(size_t)t * 128 + 64 + lane]; neg0 = p.EG[(size_t)t * 128 + lane]; neg1 = p.EG[(size_t)t * 128 + 64 + lane];
        pe_sort_header(lane, nei0, nei1, neg0, neg1);
        ndu0 = SU[nei0]; ndu1 = SU[nei1]; nsv0 = SV[nei0]; nsv1 = SV[nei1]; }
    for (; t < NTOK; t += tstride) {
        __syncthreads();
        unsigned xp[16];
#pragma unroll
        for (int i = 0; i < 8; ++i) { xp[2 * i] = nh[i].x; xp[2 * i + 1] = nh[i].y; }
        const int ei0 = nei0, ei1 = nei1;
        const float du0 = ndu0, du1 = ndu1;
        const float gv0 = neg0 * nsv0, gv1 = neg1 * nsv1;
        const int tn = (t + tstride < NTOK) ? t + tstride : t;
        nei0 = p.EI[(size_t)tn * 128 + lane]; nei1 = p.EI[(size_t)tn * 128 + 64 + lane]; neg0 = p.EG[(size_t)tn * 128 + lane]; neg1 = p.EG[(size_t)tn * 128 + 64 + lane];
        f32x2 acc[16];
#pragma unroll
        for (int i = 0; i < 16; ++i) acc[i] = (f32x2){0.f, 0.f};
        u32x4 u0[4], v0[4]; u32x2 u1[4];
#define FP4P(w, b) __builtin_amdgcn_cvt_scalef32_pk_f32_fp4((w), 1.0f, (b))
#define PE_IDX(j) pe_idx(hl, ei0, ei1, j)
#define PE_LOADU(i, ix) { const size_t ro = (size_t)(ix) * 768u; u0[i] = *(const u32x4*)(U0 + ro); u1[i] = *(const u32x2*)(U1 + ro); }
#define PE_LOADV(i, ix) { const size_t ro = (size_t)(ix) * 512u; v0[i] = *(const u32x4*)(V0 + ro); }
#define PE_DOT(i, dd) { const u32x6 w = {u0[i].x, u0[i].y, u0[i].z, u0[i].w, u1[i].x, u1[i].y}; const bf16x32 ud = __builtin_amdgcn_cvt_scalef32_pk32_bf16_fp6(w, 1.0f); \
            float a0 = 0.f, a1 = 0.f; \
            a0 = dot2bf(xp[0], bfpair<0>(ud), a0); a1 = dot2bf(xp[1], bfpair<1>(ud), a1); a0 = dot2bf(xp[2], bfpair<2>(ud), a0); a1 = dot2bf(xp[3], bfpair<3>(ud), a1); \
            a0 = dot2bf(xp[4], bfpair<4>(ud), a0); a1 = dot2bf(xp[5], bfpair<5>(ud), a1); a0 = dot2bf(xp[6], bfpair<6>(ud), a0); a1 = dot2bf(xp[7], bfpair<7>(ud), a1); \
            a0 = dot2bf(xp[8], bfpair<8>(ud), a0); a1 = dot2bf(xp[9], bfpair<9>(ud), a1); a0 = dot2bf(xp[10], bfpair<10>(ud), a0); a1 = dot2bf(xp[11], bfpair<11>(ud), a1); \
            a0 = dot2bf(xp[12], bfpair<12>(ud), a0); a1 = dot2bf(xp[13], bfpair<13>(ud), a1); a0 = dot2bf(xp[14], bfpair<14>(ud), a0); a1 = dot2bf(xp[15], bfpair<15>(ud), a1); dd = a0 + a1; }
#define PE_FMA(i, QP) { const float cf = dppf<QP>(cfl); const f32x2 c2 = {cf, cf}; \
            acc[0] = c2 * FP4P(v0[i].x, 0) + acc[0]; acc[1] = c2 * FP4P(v0[i].x, 1) + acc[1]; acc[2] = c2 * FP4P(v0[i].x, 2) + acc[2]; acc[3] = c2 * FP4P(v0[i].x, 3) + acc[3]; \
            acc[4] = c2 * FP4P(v0[i].y, 0) + acc[4]; acc[5] = c2 * FP4P(v0[i].y, 1) + acc[5]; acc[6] = c2 * FP4P(v0[i].y, 2) + acc[6]; acc[7] = c2 * FP4P(v0[i].y, 3) + acc[7]; \
            acc[8] = c2 * FP4P(v0[i].z, 0) + acc[8]; acc[9] = c2 * FP4P(v0[i].z, 1) + acc[9]; acc[10] = c2 * FP4P(v0[i].z, 2) + acc[10]; acc[11] = c2 * FP4P(v0[i].z, 3) + acc[11]; \
            acc[12] = c2 * FP4P(v0[i].w, 0) + acc[12]; acc[13] = c2 * FP4P(v0[i].w, 1) + acc[13]; acc[14] = c2 * FP4P(v0[i].w, 2) + acc[14]; acc[15] = c2 * FP4P(v0[i].w, 3) + acc[15]; }
        { const unsigned i0 = PE_IDX(0), i1 = PE_IDX(1), i2 = PE_IDX(2), i3 = PE_IDX(3);
          PE_LOADU(0, i0) PE_LOADU(1, i1) PE_LOADU(2, i2) PE_LOADU(3, i3) PE_LOADV(0, i0) PE_LOADV(1, i1) PE_LOADV(2, i2) PE_LOADV(3, i3) }
        const int lq4 = 4 * (lane & 3);
        for (int g = 0; g < 16; ++g) {
            float d0, d1, d2, d3;
            const int gn = g < 15 ? g + 1 : g;
            const unsigned n0 = PE_IDX(4 * gn), n1 = PE_IDX(4 * gn + 1), n2 = PE_IDX(4 * gn + 2), n3 = PE_IDX(4 * gn + 3);
            PE_DOT(0, d0) if (g < 15) PE_LOADU(0, n0)
            PE_DOT(1, d1) if (g < 15) PE_LOADU(1, n1)
            PE_DOT(2, d2) if (g < 15) PE_LOADU(2, n2)
            PE_DOT(3, d3) if (g < 15) PE_LOADU(3, n3)
            float k0 = (lane & 1) ? d1 : d0, s0 = (lane & 1) ? d0 : d1, k1 = (lane & 1) ? d3 : d2, s1 = (lane & 1) ? d2 : d3;
            k0 += dppf<0xB1>(s0); k1 += dppf<0xB1>(s1);
            float kk = (lane & 2) ? k1 : k0, ss = (lane & 2) ? k0 : k1;
            kk += dppf<0x4E>(ss); kk += dppf<0x124>(kk); kk += dppf<0x128>(kk); kk += __shfl_xor(kk, 16);
            const int sa = 16 * g + lq4;
            const float dsa = __int_as_float(__builtin_amdgcn_ds_bpermute(sa, __float_as_int(du0))), dsb = __int_as_float(__builtin_amdgcn_ds_bpermute(sa, __float_as_int(du1)));
            const float gsa = __int_as_float(__builtin_amdgcn_ds_bpermute(sa, __float_as_int(gv0))), gsb = __int_as_float(__builtin_amdgcn_ds_bpermute(sa, __float_as_int(gv1)));
            const float cfl = (hl ? gsb : gsa) * gelu_f(kk * (hl ? dsb : dsa));
            PE_FMA(0, 0x00) if (g < 15) PE_LOADV(0, n0)
            PE_FMA(1, 0x55) if (g < 15) PE_LOADV(1, n1)
            PE_FMA(2, 0xAA) if (g < 15) PE_LOADV(2, n2)
            PE_FMA(3, 0xFF) if (g < 15) PE_LOADV(3, n3)
        }
#undef PE_IDX
#undef PE_LOADU
#undef PE_LOADV
#undef PE_FMA
#undef FP4P
#undef PE_DOT
        pe_sort_header(lane, nei0, nei1, neg0, neg1);
        ndu0 = SU[nei0]; ndu1 = SU[nei1]; nsv0 = SV[nei0]; nsv1 = SV[nei1];
#pragma unroll
        for (int i = 0; i < 8; ++i) nh[i] = *(const u32x2*)(p.Hb + (size_t)tn * D + 4 * q + 128 * i);
        float tot[16];
#pragma unroll
        for (int m = 0; m < 8; ++m) {
            const float k0 = hl ? acc[8 + m][0] : acc[m][0], k1 = hl ? acc[8 + m][1] : acc[m][1], s0 = hl ? acc[m][0] : acc[8 + m][0], s1 = hl ? acc[m][1] : acc[8 + m][1];
            tot[2 * m] = k0 + __shfl_xor(s0, 32); tot[2 * m + 1] = k1 + __shfl_xor(s1, 32); }
        float* xr = p.X + (size_t)t * D + eoff; const float* gt = gate + (size_t)tok_cv(t) * 6144 + eoff;
        const float* gvp = (last ? p.final_g : p.norm1_g + D) + eoff; const float* mvp = p.modv + 3 * 6144 + (size_t)tok_cv(t) * 6144 + eoff;
        f32x4 xx[4], gg[4], gn[4], scv[4], shv[4];
#pragma unroll
        for (int v4 = 0; v4 < 4; ++v4) { xx[v4] = *(const f32x4*)(xr + 128 * v4); gg[v4] = *(const f32x4*)(gt + 128 * v4); gn[v4] = *(const f32x4*)(gvp + 128 * v4);
            if (!last) { scv[v4] = *(const f32x4*)(mvp + D + 128 * v4); shv[v4] = *(const f32x4*)(mvp + 128 * v4); } }
        float xn[16]; float ssq = 0.f;
#pragma unroll
        for (int v4 = 0; v4 < 4; ++v4) { f32x4 o;
#pragma unroll
            for (int e = 0; e < 4; ++e) { o[e] = xx[v4][e] + gg[v4][e] * tot[4 * v4 + e]; xn[4 * v4 + e] = o[e]; ssq += o[e] * o[e]; }
            if (!dry) *(f32x4*)(xr + 128 * v4) = o; }
        ssq = wave_sum(ssq);
        if (dry) { if (ssq == 12345.678f) p.NORMSQ[lane] = ssq; continue; }
        const float rstd = rsqrtf(ssq * (1.f / D) + EPSV);
        if (!last) {
#pragma unroll
            for (int v4 = 0; v4 < 4; ++v4) { float y[4];
#pragma unroll
                for (int e = 0; e < 4; ++e) y[e] = xn[4 * v4 + e] * rstd * gn[v4][e] * (1.f + scv[v4][e]) + shv[v4][e];
                u32x2 w; w.x = pk_bf16(y[0], y[1]); w.y = pk_bf16(y[2], y[3]);
                *(u32x2*)(p.Hb + (size_t)t * D + eoff + 128 * v4) = w; }
        } else {
#pragma unroll
            for (int v4 = 0; v4 < 4; ++v4) { f32x4 o;
#pragma unroll
                for (int e = 0; e < 4; ++e) o[e] = xn[4 * v4 + e] * rstd * gn[v4][e];
                *(f32x4*)(p.out + (size_t)t * D + eoff + 128 * v4) = o; }
        }
    }
}

__device__ __forceinline__ void hy_conv_phase(const MKP& p, LAS uchar* lds) {
    int tid = threadIdx.x; asm volatile("" : "+v"(tid));
    LAS bf16_t* tl = (LAS bf16_t*)lds;
    const int tok = tid >> 3, cseg = tid & 7;
    u32x4 zn[3][3];
    auto loadz = [&](int item, u32x4 (&z)[3][3]) {
        const int t = (item >> 4) * 64 + tok, c = (item & 15) * 64 + 8 * cseg;
        const int rowlen = t < CTX_TOK ? 256 : 64; const int pos = (t < CTX_TOK ? t : t - CTX_TOK) % rowlen;
        const bool vm = pos > 0, vp = pos < rowlen - 1;
#pragma unroll
        for (int part = 0; part < 3; ++part) { const int cc = part * 1024 + c;
            z[part][0] = *(const u32x4*)(p.Zb + (size_t)(vm ? t - 1 : t) * 3072 + cc); z[part][1] = *(const u32x4*)(p.Zb + (size_t)t * 3072 + cc); z[part][2] = *(const u32x4*)(p.Zb + (size_t)(vp ? t + 1 : t) * 3072 + cc);
            if (!vm) z[part][0] = (u32x4){0u, 0u, 0u, 0u};
            if (!vp) z[part][2] = (u32x4){0u, 0u, 0u, 0u}; }
    };
    int item = blockIdx.x; int wcg = -1;
    float wb[3][8], w0c[3][8], w1c[3][8], w2c[3][8];
    if (item < 4096) loadz(item, zn);
    for (; item < 4096; item += gridDim.x) {
        const int tt = item >> 4, cgp = item & 15; const int t0 = tt * 64, c0 = cgp * 64;
        const int t = t0 + tok; const int c = c0 + 8 * cseg;
        if (cgp != wcg) {
#pragma unroll
            for (int part = 0; part < 3; ++part)
#pragma unroll
                for (int e = 0; e < 8; ++e) { const int cc = part * 1024 + c + e; wb[part][e] = p.hy_conv_b[cc]; w0c[part][e] = p.hy_conv_w[cc]; w1c[part][e] = p.hy_conv_w[3072 + cc]; w2c[part][e] = p.hy_conv_w[6144 + cc]; }
            wcg = cgp; }
        u32x4 z[3][3];
#pragma unroll
        for (int a = 0; a < 3; ++a)
#pragma unroll
            for (int b = 0; b < 3; ++b) z[a][b] = zn[a][b];
        const int nitem = item + (int)gridDim.x;
        if (nitem < 4096) loadz(nitem, zn);
        float r[3][8];
#pragma unroll
        for (int part = 0; part < 3; ++part) {
            const unsigned zmu[4] = {z[part][0].x, z[part][0].y, z[part][0].z, z[part][0].w}, z0u[4] = {z[part][1].x, z[part][1].y, z[part][1].z, z[part][1].w}, zpu[4] = {z[part][2].x, z[part][2].y, z[part][2].z, z[part][2].w};
#pragma unroll
            for (int e = 0; e < 8; ++e) { const float a = (e & 1) ? bfhi(zmu[e >> 1]) : bflo(zmu[e >> 1]), b = (e & 1) ? bfhi(z0u[e >> 1]) : bflo(z0u[e >> 1]), cpl = (e & 1) ? bfhi(zpu[e >> 1]) : bflo(zpu[e >> 1]);
                r[part][e] = wb[part][e] + w0c[part][e] * a + w1c[part][e] * b + w2c[part][e] * cpl; } }
        float vg[8];
#pragma unroll
        for (int e = 0; e < 8; ++e) vg[e] = r[2][e] * r[1][e];
        u32x4 w0, w1;
        w0.x = pk_bf16(r[0][0], r[0][1]); w0.y = pk_bf16(r[0][2], r[0][3]); w0.z = pk_bf16(r[0][4], r[0][5]); w0.w = pk_bf16(r[0][6], r[0][7]);
        w1.x = pk_bf16(vg[0], vg[1]); w1.y = pk_bf16(vg[2], vg[3]); w1.z = pk_bf16(vg[4], vg[5]); w1.w = pk_bf16(vg[6], vg[7]);
        *(u32x4*)(p.X0C + (size_t)t * D + c) = w0;
        *(u32x4*)(p.VG + (size_t)t * D + c) = w1;
        __syncthreads();
#pragma unroll
        for (int e = 0; e < 8; ++e) tl[(8 * cseg + e) * 72 + tok] = f2bf(vg[e]);
        __syncthreads();
        { const int cc = tid >> 3, ts = tid & 7; const u32x4 w = *(const LAS u32x4*)(tl + cc * 72 + 8 * ts);
          *(u32x4*)(p.VT + (size_t)(c0 + cc) * NTOK + t0 + 8 * ts) = w; }
    }
}

#define HL_C1 16448
#define HL_V 32896
#define HL_ACC 51456
#define HL_VS 144
__device__ __forceinline__ void hy_long_phase(const MKP& p, LAS uchar* lds, int variant = 0) {
    int tid = threadIdx.x; asm volatile("" : "+v"(tid));
    const int wid = tid >> 6, lane = tid & 63, r = lane & 31, hh = lane >> 5;
    for (int item = blockIdx.x; item < 1024; item += gridDim.x) {
        const int pass = 1; const int c = item & 1023;
        const int L = pass ? 4096 : 256, NA = pass ? 64 : 4, RL = 2 * L;
        const bf16_t* R = p.Rf + (pass ? (size_t)1024 * 512 : 0) + (size_t)c * RL;
        const bf16_t* Vc = p.VT + (size_t)c * NTOK + (pass ? CTX_TOK : 0);
        __syncthreads();
        for (int ch = tid; ch < RL / 16; ch += NTHR) {
            const unsigned* src = (const unsigned*)(R + ch * 16);
            unsigned w[9];
#pragma unroll
            for (int i = 0; i < 8; ++i) w[i] = src[i];
            w[8] = (ch * 16 + 16 < RL) ? src[8] : 0u;
            LAS unsigned* d0 = (LAS unsigned*)(lds + ch * 32); LAS unsigned* d1 = (LAS unsigned*)(lds + HL_C1 + ch * 32);
#pragma unroll
            for (int i = 0; i < 8; ++i) { d0[i] = w[i]; d1[i] = (w[i] >> 16) | (w[i + 1] << 16); }
        }
        for (int ch = tid; ch < 1024; ch += NTHR) *(LAS u32x4*)(lds + HL_V + (ch >> 3) * HL_VS + (ch & 7) * 16) = *(const u32x4*)(Vc + ch * 8);
        __syncthreads();
        f32x16 acc[2][4];
#pragma unroll
        for (int mt = 0; mt < 2; ++mt)
#pragma unroll
            for (int nt = 0; nt < 4; ++nt)
#pragma unroll
                for (int e = 0; e < 16; ++e) acc[mt][nt][e] = 0.f;
        const int dlo = -(NA - 1), dhi = NA - 1;
        const int cpo = (r & 1) ? 0 : HL_C1;
        auto dbody = [&](auto maskc, int dl) {
            constexpr int MASK = decltype(maskc)::value;
            int voff[4]; bool vok[4];
#pragma unroll
            for (int nt = 0; nt < 4; ++nt) { const int col = 32 * nt + r; const int a = col % NA; vok[nt] = (a - dl >= 0) && (a - dl < NA); voff[nt] = HL_V + (vok[nt] ? col - dl : 0) * HL_VS + 16 * hh; }
            const int xbase = (L - 1) - 64 * dl - r + 8 * hh;
#pragma unroll
            for (int ks = 0; ks < 4; ++ks) {
                bf16x8 af[2], bfv[4];
#pragma unroll
                for (int mt = 0; mt < 2; ++mt) { const int x = xbase - 32 * mt + 16 * ks; const int xe = x & ~1;
                    const LAS unsigned* src = (const LAS unsigned*)(lds + cpo + xe * 2);
                    u32x4 w; w.x = src[0]; w.y = src[1]; w.z = src[2]; w.w = src[3]; af[mt] = __builtin_bit_cast(bf16x8, w); }
#pragma unroll
                for (int nt = 0; nt < 4; ++nt) if (MASK & (1 << nt)) { u32x4 w = *(const LAS u32x4*)(lds + voff[nt] + 32 * ks);
                    if (!vok[nt]) w = (u32x4){0u, 0u, 0u, 0u}; bfv[nt] = __builtin_bit_cast(bf16x8, w); }
#pragma unroll
                for (int nt = 0; nt < 4; ++nt) if (MASK & (1 << nt)) {
#pragma unroll
                    for (int mt = 0; mt < 2; ++mt) acc[mt][nt] = __builtin_amdgcn_mfma_f32_32x32x16_bf16(af[mt], bfv[nt], acc[mt][nt], 0, 0, 0); }
            }
        };
        if (variant & 2) {}
        else if (pass) {
            for (int dl = -63 + wid; dl <= -32; dl += 8) dbody(std::integral_constant<int, 5>{}, dl);
            for (int dl = -31 + wid; dl <= 31; dl += 8) dbody(std::integral_constant<int, 15>{}, dl);
            for (int dl = 32 + wid; dl <= 63; dl += 8) dbody(std::integral_constant<int, 10>{}, dl);
        } else {
            for (int dl = dlo + wid; dl <= dhi; dl += 8) dbody(std::integral_constant<int, 15>{}, dl);
        }
#pragma unroll
        for (int w = 0; w < 8; ++w) {
            if (wid == w && !(variant & 1)) {
#pragma unroll
                for (int mt = 0; mt < 2; ++mt)
#pragma unroll
                    for (int nt = 0; nt < 4; ++nt)
#pragma unroll
                        for (int q = 0; q < 4; ++q) { LAS f32x4* ap = (LAS f32x4*)(lds + HL_ACC + ((32 * nt + r) * 68 + 32 * mt + 8 * q + 4 * hh) * 4);
                            f32x4 v = {acc[mt][nt][4 * q], acc[mt][nt][4 * q + 1], acc[mt][nt][4 * q + 2], acc[mt][nt][4 * q + 3]};
                            if (w > 0) v += *ap;
                            *ap = v; }
            }
            __syncthreads();
        }
        { float sq = 0.f;
#pragma unroll
          for (int i = 0; i < 4; ++i) { const float* pq = p.PSQ + (size_t)(16 + 4 * lane + i) * 2048 + c; sq += pq[0] + pq[1024]; }
          const float nrm = rsqrtf(wave_sum(sq) + EPSV);
          const int col = tid >> 2, i0 = 16 * (tid & 3); const LAS float* a = (const LAS float*)(lds + HL_ACC) + col * 68 + i0;
          u32x4 w0, w1;
          w0.x = pk_bf16(a[0] * nrm, a[1] * nrm); w0.y = pk_bf16(a[2] * nrm, a[3] * nrm); w0.z = pk_bf16(a[4] * nrm, a[5] * nrm); w0.w = pk_bf16(a[6] * nrm, a[7] * nrm);
          w1.x = pk_bf16(a[8] * nrm, a[9] * nrm); w1.y = pk_bf16(a[10] * nrm, a[11] * nrm); w1.z = pk_bf16(a[12] * nrm, a[13] * nrm); w1.w = pk_bf16(a[14] * nrm, a[15] * nrm);
          bf16_t* dst = p.YT + (size_t)c * NTOK + (pass ? CTX_TOK : 0) + col * 64 + i0;
          if (variant == 0) { *(u32x4*)dst = w0; *(u32x4*)(dst + 8) = w1; } else if (nrm == 123.456f) { *(u32x4*)dst = w0; } }
    }
    {
        constexpr int L = 256, NA = 4, RL = 512;
        LAS uchar* wl = lds + wid * 18688; constexpr int W_C1 = 1088, W_V = 2176;
        const int cpo = (r & 1) ? 0 : W_C1;
        __syncthreads();
        for (int item = blockIdx.x; item < 128; item += gridDim.x) {
            const int c = item * 8 + wid;
            const bf16_t* R = p.Rf + (size_t)c * RL; const bf16_t* Vc = p.VT + (size_t)c * NTOK;
            if (lane < 32) { const unsigned* src = (const unsigned*)(R + lane * 16); unsigned w[9];
#pragma unroll
                for (int i = 0; i < 8; ++i) w[i] = src[i];
                w[8] = src[lane < 31 ? 8 : 7]; if (lane == 31) w[8] = 0u;
                LAS unsigned* d0 = (LAS unsigned*)(wl + lane * 32); LAS unsigned* d1 = (LAS unsigned*)(wl + W_C1 + lane * 32);
#pragma unroll
                for (int i = 0; i < 8; ++i) { d0[i] = w[i]; d1[i] = (w[i] >> 16) | (w[i + 1] << 16); } }
            { u32x4 vv[16];
#pragma unroll
              for (int i = 0; i < 16; ++i) vv[i] = *(const u32x4*)(Vc + (lane + 64 * i) * 8);
#pragma unroll
              for (int i = 0; i < 16; ++i) *(LAS u32x4*)(wl + W_V + (lane + 64 * i) * 16) = vv[i]; }
            f32x16 acc[2][4];
#pragma unroll
            for (int mt = 0; mt < 2; ++mt)
#pragma unroll
                for (int nt = 0; nt < 4; ++nt)
#pragma unroll
                    for (int e = 0; e < 16; ++e) acc[mt][nt][e] = 0.f;
            if (!(variant & 2))
            for (int dl = -3; dl <= 3; ++dl) {
                int voff[4]; bool vok[4];
#pragma unroll
                for (int nt = 0; nt < 4; ++nt) { const int col = 32 * nt + r; const int a = col & 3; vok[nt] = (a - dl >= 0) && (a - dl < NA); voff[nt] = W_V + (vok[nt] ? col - dl : 0) * 128 + 16 * hh; }
                const int xbase = (L - 1) - 64 * dl - r + 8 * hh;
#pragma unroll
                for (int ks = 0; ks < 4; ++ks) {
                    bf16x8 af[2], bfv[4];
#pragma unroll
                    for (int mt = 0; mt < 2; ++mt) { const int x = xbase - 32 * mt + 16 * ks; const int xe = x & ~1;
                        const LAS unsigned* src = (const LAS unsigned*)(wl + cpo + xe * 2);
                        u32x4 w; w.x = src[0]; w.y = src[1]; w.z = src[2]; w.w = src[3]; af[mt] = __builtin_bit_cast(bf16x8, w); }
#pragma unroll
                    for (int nt = 0; nt < 4; ++nt) { u32x4 w = *(const LAS u32x4*)(wl + voff[nt] + 32 * ks);
                        if (!vok[nt]) w = (u32x4){0u, 0u, 0u, 0u}; bfv[nt] = __builtin_bit_cast(bf16x8, w); }
#pragma unroll
                    for (int nt = 0; nt < 4; ++nt)
#pragma unroll
                        for (int mt = 0; mt < 2; ++mt) acc[mt][nt] = __builtin_amdgcn_mfma_f32_32x32x16_bf16(af[mt], bfv[nt], acc[mt][nt], 0, 0, 0);
                }
            }
            float sq = 0.f;
            if (lane < 16) { const float* pq = p.PSQ + (size_t)lane * 2048 + c; sq = pq[0] + pq[1024]; }
            const float nrm = rsqrtf(wave_sum(sq) + EPSV);
            bf16_t* dstc = p.YT + (size_t)c * NTOK;
#pragma unroll
            for (int mt = 0; mt < 2; ++mt)
#pragma unroll
                for (int nt = 0; nt < 4; ++nt)
#pragma unroll
                    for (int q = 0; q < 4; ++q) { u32x2 w; w.x = pk_bf16(acc[mt][nt][4 * q] * nrm, acc[mt][nt][4 * q + 1] * nrm); w.y = pk_bf16(acc[mt][nt][4 * q + 2] * nrm, acc[mt][nt][4 * q + 3] * nrm);
                        if (variant == 0) *(u32x2*)(dstc + (32 * nt + r) * 64 + 32 * mt + 8 * q + 4 * hh) = w; }
        }
    }
}

__device__ __forceinline__ void hy_gate_phase(const MKP& p, LAS uchar* lds) {
    int tid = threadIdx.x; asm volatile("" : "+v"(tid));
    LAS bf16_t* tl = (LAS bf16_t*)lds;
    const int tok = tid >> 3, cseg = tid & 7, cc = tid >> 3, ts = tid & 7;
    int item = blockIdx.x;
    u32x4 ytn = {0u, 0u, 0u, 0u}, x0n = ytn, vgn = ytn;
    auto loadg = [&](int it) { const int t0 = (it >> 4) * 64, c0 = (it & 15) * 64;
        ytn = *(const u32x4*)(p.YT + (size_t)(c0 + cc) * NTOK + t0 + 8 * ts);
        x0n = *(const u32x4*)(p.X0C + (size_t)(t0 + tok) * D + c0 + 8 * cseg); vgn = *(const u32x4*)(p.VG + (size_t)(t0 + tok) * D + c0 + 8 * cseg); };
    if (item < 4096) loadg(item);
    for (; item < 4096; item += gridDim.x) {
        const int tt = item >> 4, cgp = item & 15; const int t0 = tt * 64, c0 = cgp * 64;
        const u32x4 yt = ytn, x0 = x0n, vgp = vgn;
        float hb[8];
#pragma unroll
        for (int e = 0; e < 8; ++e) hb[e] = p.hy_bias[c0 + 8 * cseg + e];
        if (item + (int)gridDim.x < 4096) loadg(item + (int)gridDim.x);
        __syncthreads();
        *(LAS u32x4*)(tl + cc * 72 + 8 * ts) = yt;
        __syncthreads();
        const int t = t0 + tok, c = c0 + 8 * cseg;
        const unsigned x0u[4] = {x0.x, x0.y, x0.z, x0.w}, vgu[4] = {vgp.x, vgp.y, vgp.z, vgp.w};
        float y[8];
#pragma unroll
        for (int e = 0; e < 8; ++e) { const float cv = bf2f(tl[(8 * cseg + e) * 72 + tok]); const float vv = (e & 1) ? bfhi(vgu[e >> 1]) : bflo(vgu[e >> 1]), xx = (e & 1) ? bfhi(x0u[e >> 1]) : bflo(x0u[e >> 1]);
            y[e] = (cv + hb[e] * vv) * xx; }
        u32x4 w; w.x = pk_bf16(y[0], y[1]); w.y = pk_bf16(y[2], y[3]); w.z = pk_bf16(y[4], y[5]); w.w = pk_bf16(y[6], y[7]);
        *(u32x4*)(p.CAT + (size_t)t * D + c) = w;
    }
}

extern __shared__ __attribute__((aligned(16))) unsigned char smem_raw[];
#define MK_LDS_BYTES 163840

#define XB_TMO      128
#define XB_XCNT(j)  (256  + 64 * (j))
#define XB_XSUB(j)  (1280 + 64 * (j))
#define XB_XGEN(j)  (2304 + 64 * (j))
#define XB_TOP      3328
#define XB_TOPGEN   3392
#define XCD_BAR_WORDS 3456
#define XB_SPIN_CAP (1u << 20)
__device__ __forceinline__ unsigned xb_ld(unsigned* q) { return __hip_atomic_load(q, __ATOMIC_RELAXED, __HIP_MEMORY_SCOPE_AGENT); }
__device__ __forceinline__ unsigned xb_add(unsigned* q, unsigned v) { return __hip_atomic_fetch_add(q, v, __ATOMIC_RELAXED, __HIP_MEMORY_SCOPE_AGENT); }
__device__ __forceinline__ unsigned xb_xcc_id() { return (unsigned)__builtin_amdgcn_s_getreg((3 << 11) | 20) & 0xFu; }
#define XB_SPIN(cond, bar) do { unsigned _sp = 0; while (cond) { __builtin_amdgcn_s_sleep(1); \
    if ((++_sp & 255u) == 0u) { if (xb_ld(&(bar)[XB_TMO])) break; if (_sp > XB_SPIN_CAP) { atomicAdd(&(bar)[XB_TMO], 1u); break; } } } } while (0)
struct XcdBarrier { unsigned* bar; unsigned x; volatile LAS unsigned* st; };
__device__ __forceinline__ XcdBarrier xcd_barrier_post(unsigned* bar, volatile LAS unsigned* st) {
    XcdBarrier b; b.bar = bar; b.x = xb_xcc_id(); b.st = st;
    if (threadIdx.x == 0) (void)xb_add(&bar[XB_XCNT(b.x)], 1u);
    return b;
}
__device__ __forceinline__ void xcd_barrier_complete(unsigned* bar, unsigned x, unsigned& nloc, unsigned& nx) {
    const unsigned G = gridDim.x * gridDim.y * gridDim.z;
    unsigned sum, cnt, mine, sp = 0u;
    for (;;) {
        sum = 0u; cnt = 0u; mine = 0u;
#pragma unroll
        for (unsigned j = 0; j < 16; ++j) { const unsigned c = xb_ld(&bar[XB_XCNT(j)]); sum += c; cnt += (c > 0u) ? 1u : 0u; mine = (j == x) ? c : mine; }
        if (sum == G) break;
        __builtin_amdgcn_s_sleep(1);
        if ((++sp & 255u) == 0u) { if (xb_ld(&bar[XB_TMO])) break; if (sp > XB_SPIN_CAP) { atomicAdd(&bar[XB_TMO], 1u); break; } }
    }
    nloc = mine > 0u ? mine : 1u; nx = cnt > 0u ? cnt : 1u;
}
__device__ __forceinline__ void xcd_barrier(const XcdBarrier& b) {
    asm volatile("s_waitcnt vmcnt(0)" ::: "memory");
    __syncthreads();
    if (threadIdx.x == 0) {
        unsigned* bar = b.bar;
        __builtin_amdgcn_s_waitcnt(0);
        unsigned nloc = b.st[0], nx = b.st[1];
        if (nloc == 0u) { xcd_barrier_complete(bar, b.x, nloc, nx); b.st[0] = nloc; b.st[1] = nx; }
        const unsigned old = xb_add(&bar[XB_XSUB(b.x)], 1u);
        const unsigned gen = old / nloc;
        if (old + 1u == (gen + 1u) * nloc) {
            __builtin_amdgcn_fence(__ATOMIC_RELEASE, "agent");
            asm volatile("s_waitcnt vmcnt(0)" ::: "memory");
            const unsigned og = xb_add(&bar[XB_TOP], 1u);
            const unsigned tg = og / nx;
            if (og + 1u == (tg + 1u) * nx) xb_add(&bar[XB_TOPGEN], 1u);
            else XB_SPIN(xb_ld(&bar[XB_TOPGEN]) == tg, bar);
            __builtin_amdgcn_fence(__ATOMIC_ACQUIRE, "agent");
            xb_add(&bar[XB_XGEN(b.x)], 1u);
            asm volatile("s_waitcnt vmcnt(0)" ::: "memory");
        } else {
            XB_SPIN(xb_ld(&bar[XB_XGEN(b.x)]) == gen, bar);
            __builtin_amdgcn_fence(__ATOMIC_ACQUIRE, "agent");
            asm volatile("s_waitcnt vmcnt(0)" ::: "memory");
        }
    }
    __syncthreads();
}
#define MK_BAR_LDS_OFF (MK_LDS_BYTES - 16)

#define GSYNC_CG() do { asm volatile("s_waitcnt vmcnt(0)" ::: "memory"); grid.sync(); \
    if (threadIdx.x == 0) { __builtin_amdgcn_fence(__ATOMIC_ACQUIRE, "agent"); asm volatile("s_waitcnt vmcnt(0)" ::: "memory"); } __syncthreads(); } while (0)
#define GSYNC() xcd_barrier(xb)

struct Pg8Store {
    static constexpr bool PERM = false, AFTER_DRAIN = false;
    bf16_t* O; int ldc; const float* bias;
    __device__ __forceinline__ void operator()(const f32x4 (&acc)[2][2][4][2], const pg8::Unit& u, int wr, int wc, int fr, int fq) const {
        f32x4 bv[2][2];
#pragma unroll
        for (int bj = 0; bj < 2; ++bj)
#pragma unroll
            for (int n = 0; n < 2; ++n) bv[bj][n] = bias ? *(const f32x4*)(bias + u.pn * 256 + bj * 128 + wc * 32 + n * 16 + 4 * fq) : (f32x4){0.f, 0.f, 0.f, 0.f};
#pragma unroll
        for (int ai = 0; ai < 2; ++ai)
#pragma unroll
            for (int m = 0; m < 4; ++m)
#pragma unroll
                for (int bj = 0; bj < 2; ++bj)
#pragma unroll
                    for (int n = 0; n < 2; ++n) { const f32x4 v = acc[ai][bj][m][n] + bv[bj][n]; u32x2 w; w.x = pk_bf16(v[0], v[1]); w.y = pk_bf16(v[2], v[3]);
                        *(u32x2*)(O + (size_t)(u.pm * 256 + ai * 128 + wr * 64 + m * 16 + fr) * ldc + u.pn * 256 + bj * 128 + wc * 32 + n * 16 + 4 * fq) = w; }
    }
};
struct Pg8Resid {
    static constexpr bool PERM = false, AFTER_DRAIN = false;
    const MKP* p; bool from_input; const float* gate; const float* bias;
    __device__ __forceinline__ void operator()(const f32x4 (&acc)[2][2][4][2], const pg8::Unit& u, int wr, int wc, int fr, int fq) const {
        const float* gt = gate + (size_t)tok_cv(u.pm * 256) * 6144;
        f32x4 gv[2][2], bv[2][2];
#pragma unroll
        for (int bj = 0; bj < 2; ++bj)
#pragma unroll
            for (int n = 0; n < 2; ++n) { const int col = u.pn * 256 + bj * 128 + wc * 32 + n * 16 + 4 * fq; gv[bj][n] = *(const f32x4*)(gt + col); bv[bj][n] = bias ? *(const f32x4*)(bias + col) : (f32x4){0.f, 0.f, 0.f, 0.f}; }
#pragma unroll
        for (int ai = 0; ai < 2; ++ai)
#pragma unroll
            for (int mh = 0; mh < 2; ++mh) {
                f32x4 xv[2][2][2];
#pragma unroll
                for (int mm = 0; mm < 2; ++mm) { const int row = u.pm * 256 + ai * 128 + wr * 64 + (2 * mh + mm) * 16 + fr; const float* xr = from_input ? xin_row(*p, row) : p->X + (size_t)row * D;
#pragma unroll
                    for (int bj = 0; bj < 2; ++bj)
#pragma unroll
                        for (int n = 0; n < 2; ++n) xv[mm][bj][n] = *(const f32x4*)(xr + u.pn * 256 + bj * 128 + wc * 32 + n * 16 + 4 * fq); }
#pragma unroll
                for (int mm = 0; mm < 2; ++mm) { const int row = u.pm * 256 + ai * 128 + wr * 64 + (2 * mh + mm) * 16 + fr;
#pragma unroll
                    for (int bj = 0; bj < 2; ++bj)
#pragma unroll
                        for (int n = 0; n < 2; ++n) { const f32x4 o = xv[mm][bj][n] + gv[bj][n] * (acc[ai][bj][2 * mh + mm][n] + bv[bj][n]);
                            *(f32x4*)(p->X + (size_t)row * D + u.pn * 256 + bj * 128 + wc * 32 + n * 16 + 4 * fq) = o; } }
            }
    }
};
template <class E> __device__ __forceinline__ void gemm8(const bf16_t* A, const bf16_t* Bt, int M, int N, int K, LAS uchar* lds, const E& e) {
    pg8::StaticOrder S; S.init(M, N, (int)gridDim.x, (int)blockIdx.x);
    pg8::gemm_phase<E, pg8::StaticOrder, false>(lds, pg8::Gemm{A, Bt, M, N, K}, S, e, nullptr);
    __syncthreads();
}

#ifndef MK_PROBE
#define MK_PROBE 0
#endif
#define REP(bit) for (int _r = 0; _r < (((MK_PROBE) >> (bit)) & 1) + 1; ++_r)
__global__ void __launch_bounds__(NTHR) mega_fwd(MKP p) {
    cg::grid_group grid = cg::this_grid();
    LAS uchar* lds = (LAS uchar*)smem_raw;
    volatile LAS unsigned* xst = (volatile LAS unsigned*)(lds + MK_BAR_LDS_OFF);
    if (threadIdx.x == 0) { xst[0] = 0u; xst[1] = 0u; }
    __syncthreads();
    const XcdBarrier xb = xcd_barrier_post(p.bar, xst);
    REP(0) { phase0(p, lds); GSYNC_CG(); }
#pragma nounroll
    for (int layer = 0; layer < 2; ++layer) {
        const float* mv = p.modv + layer * 3 * 6144;
        if (layer == 0) {
            REP(1) { norm_phase(p, true, p.norm1_g, mv, 0, 1, p.Hb); if (_r == 0) hyfilt_phase(p, lds); GSYNC(); }
            REP(13) { if (_r == 1) { hyfilt_phase(p, lds, true); GSYNC(); } }
            REP(2) {
                      { Pg8Store e{p.Zb, 1536, nullptr}; gemm8(p.Hb, p.WinT, NTOK, 1024, D, lds, e); }
                      { EpiStoreT e{p.Zb, 1536, 1024}; gemm_phase<128>(p.Hb, D, p.WinT + (size_t)1024 * 1024, D, D, NTOK, 512, lds, e); }
                      GSYNC(); }
            REP(3) {
#pragma nounroll
                for (int pass = 0; pass < 2; ++pass) {
                    if (_r == 1 && (((MK_PROBE) >> 17) & 3) && !((((MK_PROBE) >> 17) & 3) & (1 << pass))) continue;
                    scan_phase(p, pass, lds, _r == 0 ? 3 : (((MK_PROBE) >> 9) & 3) ? (((MK_PROBE) >> 9) & 3) : 3); GSYNC(); } }
            REP(2) { EpiGlu e{p.ZS, p.CAT, p.s5_b_glu}; gemm_phase<128>(p.ZS, 512, p.WgluT, 512, 512, NTOK, 512, lds, e); GSYNC(); }
        } else {
            REP(2) { Pg8Store e{p.Zb, 3072, p.b_in_c}; gemm8(p.Hb, p.WincT, NTOK, 3072, D, lds, e); GSYNC(); }
            REP(4) { hy_conv_phase(p, lds); GSYNC(); }
            REP(5) { hy_long_phase(p, lds, _r == 0 ? 0 : (((MK_PROBE) >> 11) & 3)); GSYNC(); }
            REP(4) { hy_gate_phase(p, lds); GSYNC(); }
        }
        { Pg8Resid e{&p, layer == 0, mv + 2 * D, layer ? p.b_out_c : nullptr}; gemm8(p.CAT, layer ? p.WoutcT : p.WoutT, NTOK, D, D, lds, e); }
        GSYNC();
        REP(14) { if (_r == 1 && layer == 0) { Pg8Resid e{&p, true, mv + 2 * D, nullptr}; gemm8(p.CAT, p.WoutT, NTOK, D, D, lds, e); GSYNC(); } }
        REP(1) { norm_phase(p, false, p.norm2_g + layer * D, mv, 3, 4, p.Hb); GSYNC(); }
        REP(6) { peer_route2_phase(p, layer, lds, p.Hb); GSYNC(); }
#if (MK_PROBE >> 7) & 1
        peer_eval_phase(p, layer, mv + 5 * D, layer == 1, true); GSYNC();
#endif
        peer_eval_phase(p, layer, mv + 5 * D, layer == 1, false);
        if (layer == 0) GSYNC();
#if (MK_PROBE >> 8) & 1
        for (int _r = 0; _r < 10; ++_r) GSYNC();
#endif
    }
}

static void mk_fill_params(MKP& p, void* const* d_in, void* d_out, void* d_ws) {
    const float** f = (const float**)&p;
    for (int i = 0; i < 50; ++i) f[i] = (const float*)d_in[i];
    p.out = (float*)d_out;
    unsigned char* ws = (unsigned char*)d_ws; size_t off = 0;
    auto take = [&](size_t bytes) { unsigned char* q = ws + off; off += (bytes + 255) & ~(size_t)255; return q; };
    p.X = (float*)take((size_t)NTOK * D * 4);
    p.Hb = (bf16_t*)take((size_t)NTOK * D * 2);
    p.Zb = (bf16_t*)take((size_t)NTOK * 3072 * 2);
    p.CAT = (bf16_t*)take((size_t)NTOK * D * 2);
    unsigned char* regA = take((size_t)96 << 20);
    p.ZS = (bf16_t*)regA; p.HS = (float*)(regA + ((size_t)16 << 20)); p.Qs = (bf16_t*)(regA + ((size_t)48 << 20));
    p.EI = (int*)(regA + ((size_t)80 << 20)); p.EG = (float*)(regA + ((size_t)88 << 20));
    p.X0C = (bf16_t*)regA; p.VG = (bf16_t*)(regA + ((size_t)32 << 20)); p.VT = (bf16_t*)(regA + ((size_t)64 << 20));
    p.YT = p.Zb;
    p.Ub = (uchar*)take((size_t)2 * 16384 * 768); p.Vb = (uchar*)take((size_t)2 * 16384 * 512);
    p.SU = (float*)take(2 * 16384 * 4); p.SV = (float*)take(2 * 16384 * 4); p.bar = (unsigned*)take(16384);
    p.WinT = (bf16_t*)take((size_t)1536 * 1024 * 2); p.WgluT = (bf16_t*)take((size_t)512 * 512 * 2); p.WoutT = (bf16_t*)take((size_t)1024 * 1024 * 2);
    p.WincT = (bf16_t*)take((size_t)3072 * 1024 * 2); p.WoutcT = (bf16_t*)take((size_t)1024 * 1024 * 2); p.WqT = (bf16_t*)take((size_t)2 * 2048 * 1024 * 2);
    p.Keysb = (bf16_t*)take((size_t)2 * 16 * 128 * 128 * 2); p.WaT = (bf16_t*)take((size_t)16 * 4096 * 2); p.WxT = (bf16_t*)take((size_t)16 * 4096 * 2);
    p.Bmat = (bf16_t*)take((size_t)64 * 128 * 16 * 2); p.CmT = (bf16_t*)take((size_t)64 * 16 * 128 * 2);
    p.abar = (float*)take(4096 * 2 * 4); p.aL = (float*)take(4096 * 2 * 4);
    p.S5car = (float*)take((size_t)2 * 2 * 32 * 16 * 128 * 4); p.LRUcar = (float*)take((size_t)256 * 2 * 1024 * 4);
    p.modv = (float*)take(2 * 3 * 6144 * 4); p.Z2 = (float*)take((size_t)4352 * 64 * 4); p.NORMSQ = (float*)take(2048 * 4); p.PSQ = (float*)take((size_t)272 * 2048 * 4);
    p.Rf = (bf16_t*)take(((size_t)1024 * 512 + (size_t)1024 * 8192) * 2);
    p.stop_after = 0; p.pad0 = 0;
}

#include <string.h>
#ifndef MK_STOP_AFTER
#define MK_STOP_AFTER 0
#endif
extern "C" void kernel_launch(void* const* d_in, const int* in_sizes, int n_in, void* d_out, int out_size, void* d_ws, size_t ws_size, hipStream_t stream) {
    static int grid_blocks = 0;
    if (!grid_blocks) {
        int dev = 0, cus = 0, per_cu = 0;
        (void)hipGetDevice(&dev);
        (void)hipDeviceGetAttribute(&cus, hipDeviceAttributeMultiprocessorCount, dev);
        (void)hipFuncSetAttribute((const void*)mega_fwd, hipFuncAttributeMaxDynamicSharedMemorySize, MK_LDS_BYTES);
        (void)hipOccupancyMaxActiveBlocksPerMultiprocessor(&per_cu, (const void*)mega_fwd, NTHR, MK_LDS_BYTES);
        if (per_cu > 1) per_cu = 1;
        grid_blocks = cus * per_cu; if (grid_blocks > 256) grid_blocks = 256;
        grid_blocks &= ~7;
        if (grid_blocks < 1) { fprintf(stderr, "mega_fwd: occupancy query returned 0 blocks per CU\n"); grid_blocks = 0; return; }
    }
    MKP p; memset(&p, 0, sizeof(p));
    mk_fill_params(p, d_in, d_out, d_ws);
    p.stop_after = MK_STOP_AFTER;
    (void)hipMemsetAsync(p.bar, 0, XCD_BAR_WORDS * 4, stream);
    void* args[] = {&p};
    hipError_t e = hipLaunchCooperativeKernel((const void*)mega_fwd, dim3(grid_blocks), dim3(NTHR), args, MK_LDS_BYTES, stream);
    if (e != hipSuccess) fprintf(stderr, "cooperative launch failed: %s (grid %d)\n", hipGetErrorString(e), grid_blocks);
#if MK_STOP_AFTER != 0
    nv::naive_tail(MK_STOP_AFTER, d_in, d_out, d_ws, stream);
#endif
}
```

```cpp
#include <hip/hip_runtime.h>
#include <hip/hip_cooperative_groups.h>
#include <stdint.h>
#include <math.h>
#include <stdio.h>
#include <type_traits>
namespace cg = cooperative_groups;

#define D 1024
#define NTOK 16384
#define CTX_TOK 8192
#define EPSV 1e-6f
#define NTHR 512
#define LAS __attribute__((address_space(3)))
#define GAS __attribute__((address_space(1)))

typedef unsigned short bf16_t;
typedef unsigned char uchar;
typedef short bf16x8 __attribute__((ext_vector_type(8)));
typedef float f32x4 __attribute__((ext_vector_type(4)));
typedef float f32x2 __attribute__((ext_vector_type(2)));
typedef float f32x16 __attribute__((ext_vector_type(16)));
typedef unsigned u32x4 __attribute__((ext_vector_type(4)));
typedef unsigned u32x2 __attribute__((ext_vector_type(2)));
typedef unsigned u32x6p __attribute__((ext_vector_type(6)));
typedef __bf16 bf16x2v __attribute__((ext_vector_type(2)));

struct MKP {
    const float *x_prompt, *x_sample, *st_re, *st_im, *st_lru, *c, *c_ctx, *norm1_g, *norm2_g, *w_mod, *b_mod, *w_in_ab,
        *s5_a_re, *s5_a_im, *s5_log_dt, *s5_b_re, *s5_b_im, *s5_c_re, *s5_c_im, *s5_d, *s5_w_glu, *s5_b_glu,
        *lru_conv_w, *lru_conv_b, *lru_w_a, *lru_b_a, *lru_w_x, *lru_b_x, *lru_lambda, *w_out_ab,
        *w_in_c, *b_in_c, *hy_conv_w, *hy_conv_b, *hy_w1, *hy_b1, *hy_f1, *hy_w2, *hy_b2, *hy_f2, *hy_w3, *hy_decay, *hy_bias, *w_out_c, *b_out_c,
        *peer_wq, *peer_keys, *peer_u, *peer_v, *final_g;
    float* out;
    float* X;
    bf16_t* Hb;
    bf16_t* Zb;
    bf16_t* CAT;
    bf16_t* ZS;
    float* HS;
    bf16_t* Qs;
    int* EI; float* EG;
    bf16_t *X0C, *VG, *VT, *YT;
    uchar *Ub, *Vb;
    float *SU, *SV;
    unsigned *bar;
    bf16_t *WinT, *WgluT, *WoutT, *WincT, *WoutcT, *WqT, *Keysb, *WaT, *WxT;
    bf16_t *Bmat, *CmT; float *abar, *aL;
    float *S5car;
    float *LRUcar;
    float *modv;
    float *Z2;
    float *NORMSQ;
    float *PSQ;
    bf16_t *Rf;
    int stop_after; int pad0;
};

__device__ __forceinline__ float bf2f(bf16_t v) { return __uint_as_float((unsigned)v << 16); }
__device__ __forceinline__ float bflo(unsigned p) { return __uint_as_float(p << 16); }
__device__ __forceinline__ float bfhi(unsigned p) { return __uint_as_float(p & 0xffff0000u); }
__device__ __forceinline__ unsigned pk_bf16(float lo, float hi) { const f32x2 v = {lo, hi}; const bf16x2v r = __builtin_convertvector(v, bf16x2v); return __builtin_bit_cast(unsigned, r); }
__device__ __forceinline__ bf16_t f2bf(float x) { return (bf16_t)(pk_bf16(x, 0.f) & 0xffffu); }
__device__ __forceinline__ float sigmoid_f(float x) { return 1.f / (1.f + __expf(-x)); }
__device__ __forceinline__ float gelu_f(float x) { float z = 1.5957691216057308f * (x + 0.044715f * x * x * x); return x / (1.f + __expf(-z)); }
__device__ __forceinline__ float silu_f(float x) { return x / (1.f + __expf(-x)); }
__device__ __forceinline__ int tok_cv(int t) { return t < CTX_TOK ? 0 : 1 + ((t - CTX_TOK) >> 12); }
__device__ __forceinline__ const float* xin_row(const MKP& p, int t) { return t < CTX_TOK ? p.x_prompt + (size_t)t * D : p.x_sample + (size_t)(t - CTX_TOK) * D; }
__device__ __forceinline__ float wave_sum(float v) {
#pragma unroll
    for (int o = 32; o > 0; o >>= 1) v += __shfl_xor(v, o);
    return v;
}
__device__ __forceinline__ void glds16(const void* g, LAS uchar* l) { __builtin_amdgcn_global_load_lds((const GAS void*)g, (LAS void*)l, 16, 0, 0); }

template <int BN, class Epi>
__device__ __forceinline__ void gemm_tile(const bf16_t* A, int lda, const bf16_t* Bt, int ldb, int K, int m0, int n0, LAS uchar* lds, Epi& epi) {
    constexpr int NW = BN / 64;
    constexpr int STAGE = 256 * 128 + BN * 128;
    int tid = threadIdx.x; asm volatile("" : "+v"(tid));
    const int wid = tid >> 6, lane = tid & 63, wr = wid >> 2, wc = wid & 3, fr = lane & 15, fq = lane >> 4;
    f32x4 acc[8][NW];
#pragma unroll
    for (int m = 0; m < 8; ++m)
#pragma unroll
        for (int n = 0; n < NW; ++n) acc[m][n] = (f32x4){0.f, 0.f, 0.f, 0.f};
    const int nk = K >> 6;
    const int srow = lane >> 3, sc = lane & 7;
    auto stage = [&](int kt, int buf) {
        LAS uchar* sb = lds + buf * STAGE;
#pragma unroll
        for (int j = 0; j < 4; ++j) { const int rowl = 8 * (wid + 8 * j) + srow; const int c = sc ^ ((rowl >> 1) & 7);
            glds16(A + (size_t)(m0 + rowl) * lda + kt * 64 + c * 8, sb + rowl * 128 + sc * 16); }
#pragma unroll
        for (int j = 0; j < BN / 64; ++j) { const int rowl = 8 * (wid + 8 * j) + srow; const int c = sc ^ ((rowl >> 1) & 7);
            glds16(Bt + (size_t)(n0 + rowl) * ldb + kt * 64 + c * 8, sb + 32768 + rowl * 128 + sc * 16); }
    };
    __syncthreads();
    stage(0, 0);
    for (int kt = 0; kt < nk; ++kt) {
        asm volatile("s_waitcnt vmcnt(0)" ::: "memory");
        __syncthreads();
        if (kt + 1 < nk) stage(kt + 1, (kt + 1) & 1);
        const LAS uchar* sa = lds + (kt & 1) * STAGE;
        const LAS uchar* sbp = sa + 32768;
#pragma unroll
        for (int kk = 0; kk < 2; ++kk) {
            const int cs = ((kk * 4 + fq) ^ (fr >> 1)) * 16;
            bf16x8 bfr[NW];
#pragma unroll
            for (int n = 0; n < NW; ++n) bfr[n] = *(const LAS bf16x8*)(sbp + (wc * (BN / 4) + n * 16 + fr) * 128 + cs);
#pragma unroll
            for (int mh = 0; mh < 2; ++mh) {
                bf16x8 af[4];
#pragma unroll
                for (int m = 0; m < 4; ++m) af[m] = *(const LAS bf16x8*)(sa + (wr * 128 + (4 * mh + m) * 16 + fr) * 128 + cs);
#pragma unroll
                for (int m = 0; m < 4; ++m)
#pragma unroll
                    for (int n = 0; n < NW; ++n) acc[4 * mh + m][n] = __builtin_amdgcn_mfma_f32_16x16x32_bf16(bfr[n], af[m], acc[4 * mh + m][n], 0, 0, 0);
            }
        }
    }
    typename Epi::Pre pre[8][NW];
#pragma unroll
    for (int m = 0; m < 8; ++m)
#pragma unroll
        for (int n = 0; n < NW; ++n) pre[m][n] = epi.pre(m0 + wr * 128 + m * 16 + fr, n0 + wc * (BN / 4) + n * 16 + 4 * fq);
#pragma unroll
    for (int m = 0; m < 8; ++m)
#pragma unroll
        for (int n = 0; n < NW; ++n) epi(acc[m][n], pre[m][n], m0 + wr * 128 + m * 16 + fr, n0 + wc * (BN / 4) + n * 16 + 4 * fq);
}

struct EpiStoreT {
    bf16_t* O; int ldc; int col0;
    struct Pre {};
    __device__ __forceinline__ Pre pre(int, int) const { return Pre{}; }
    __device__ __forceinline__ void operator()(const f32x4& v, const Pre&, int row, int col) const {
        u32x2 w; w.x = pk_bf16(v[0], v[1]); w.y = pk_bf16(v[2], v[3]); *(u32x2*)(O + (size_t)row * ldc + col0 + col) = w; }
};
struct EpiGlu {
    const bf16_t* ZS; bf16_t* CAT; const float* bias;
    struct Pre { u32x2 z; f32x4 b; };
    __device__ __forceinline__ Pre pre(int row, int col) const { Pre q; q.z = *(const u32x2*)(ZS + (size_t)row * 512 + col); q.b = *(const f32x4*)(bias + col); return q; }
    __device__ __forceinline__ void operator()(const f32x4& v, const Pre& q, int row, int col) const {
        const float o0 = bflo(q.z.x) * sigmoid_f(v[0] + q.b[0]), o1 = bfhi(q.z.x) * sigmoid_f(v[1] + q.b[1]), o2 = bflo(q.z.y) * sigmoid_f(v[2] + q.b[2]), o3 = bfhi(q.z.y) * sigmoid_f(v[3] + q.b[3]);
        u32x2 w; w.x = pk_bf16(o0, o1); w.y = pk_bf16(o2, o3);
        *(u32x2*)(CAT + (size_t)row * D + col) = w;
    }
};
template <int BN, class Epi>
__device__ __forceinline__ void gemm_phase(const bf16_t* A, int lda, const bf16_t* Bt, int ldb, int K, int M, int N, LAS uchar* lds, Epi& epi) {
    const int nM = M / 256, nN = N / BN, nt = nM * nN;
    for (int t = blockIdx.x; t < nt; t += gridDim.x) { const int pn = t % nN, pm = t / nN; gemm_tile<BN>(A, lda, Bt, ldb, K, pm * 256, pn * BN, lds, epi); }
}

namespace pg8 {
#define PG8_LAS __attribute__((address_space(3)))
typedef unsigned short bf16_t;
typedef short bf16x8 __attribute__((ext_vector_type(8)));
typedef float f32x4 __attribute__((ext_vector_type(4)));
typedef unsigned u32x4 __attribute__((ext_vector_type(4)));
constexpr int BM = 256, BK = 64, HALF = 128, HTB = HALF * BK * 2  , STAGE_BYTES = 8 * HTB, NXCD = 8, WGM = 8;

__host__ __device__ __forceinline__ int lds_byte(int r, int c) { const int st = (r >> 4) * 2 + (c >> 5), rr = r & 15, cc = c & 31, ob = rr * 64 + cc * 2; return st * 1024 + (ob ^ (((ob >> 9) & 1) << 5)); }
__host__ __device__ __forceinline__ void stage_rc(int b, int& R, int& C) { const int st = b / 1024, sb = b % 1024, swz = sb ^ (((sb >> 9) & 1) << 5); R = (st >> 1) * 16 + swz / 64; C = (st & 1) * 32 + (swz % 64) / 2; }
__host__ __device__ __forceinline__ int perm32(int rho) { const int n = rho >> 4, i = rho & 15; return 8 * (i >> 2) + 4 * n + (i & 3); }

struct Unit { int pm, pn; };
struct Gemm { const bf16_t* A; const bf16_t* Bt; int M, N, K; };

struct StaticOrder {
    int nM, nN, nwg, G, c;
    __host__ __device__ void init(int M, int N, int G_, int c_) { nM = M / BM; nN = N / BM; nwg = nM * nN; G = G_; c = c_; }
    __host__ __device__ bool next(int i, Unit& u) const {
        const long L = (long)i * G + c; if (L >= nwg) return false;
        int wgid = (int)L; { const int q = nwg / NXCD, r = nwg % NXCD, xcd = wgid % NXCD, off = wgid / NXCD; wgid = (xcd < r ? xcd * (q + 1) : r * (q + 1) + (xcd - r) * q) + off; }
        const int nig = WGM * nN, gid = wgid / nig, fm = gid * WGM, gsz = (nM - fm) < WGM ? (nM - fm) : WGM;
        u.pm = fm + ((wgid % nig) % gsz); u.pn = (wgid % nig) / gsz; return true;
    }
    __device__ __forceinline__ void a_ready(const Unit&) const {}
    __device__ __forceinline__ void done(const Unit&) const {}
};
template <class Epi, class Sched, bool STAMP = false>
__device__ __forceinline__ void gemm_phase(PG8_LAS unsigned char* lds, const Gemm g, const Sched& S, const Epi& E, unsigned long long* stamps) {
    int tid = threadIdx.x; asm volatile("" : "+v"(tid));
    const int wid = __builtin_amdgcn_readfirstlane(tid >> 6), lane = tid & 63, wr = wid >> 2, wc = wid & 3, fr = lane & 15, fq = lane >> 4;
    const int K = g.K, nt = K / BK;
    int ts_lo = 0, ts_hi = 0, nts = 0; const unsigned long long rt_entry = STAMP ? (unsigned long long)wall_clock64() : 0ull;
#define PG8_STAMP() do { if (STAMP && wid == 0 && nts < 64) { const unsigned long long _c = (unsigned long long)clock64(); \
        ts_lo = (lane == nts) ? (int)(unsigned)_c : ts_lo; ts_hi = (lane == nts) ? (int)(unsigned)(_c >> 32) : ts_hi; ++nts; } } while (0)
    PG8_STAMP();
    unsigned voffA[2], voffB[2];
#pragma unroll
    for (int i = 0; i < 2; ++i) { int R, C; stage_rc(tid * 16 + i * 8192, R, C); const int Rb = Epi::PERM ? ((R & ~31) + perm32(R & 31)) : R;
        voffA[i] = (unsigned)(R * K + C) * 2u; voffB[i] = (unsigned)(Rb * K + C) * 2u; }
    const size_t kstep = (size_t)(BK * 2);
    const size_t hstep = (size_t)HALF * K * 2;
    const size_t tstep = 2 * hstep;
    const unsigned ldsw = (unsigned)wid * 1024u;
    const int aoff = lds_byte(wr * 64 + fr, fq * 8), boff = lds_byte(wc * 32 + fr, fq * 8);
#define PG8_SA(b, h) (((b) * 2 + (h)) * HTB)
#define PG8_SB(b, h) ((4 + (b) * 2 + (h)) * HTB)
#define PG8_STAGE(bufoff, gbase, voff) do { _Pragma("unroll") for (int _i = 0; _i < 2; ++_i) \
        __builtin_amdgcn_global_load_lds((const unsigned*)((const char*)(gbase) + (voff)[_i]), (PG8_LAS unsigned*)(lds + (bufoff) + ldsw + _i * 8192), 16, 0, 0); } while (0)
#define PG8_LDA(dst, b, h) do { _Pragma("unroll") for (int m = 0; m < 4; ++m) _Pragma("unroll") for (int k = 0; k < 2; ++k) dst[m][k] = *(const PG8_LAS bf16x8*)(lds + PG8_SA(b, h) + aoff + m * 2048 + k * 1024); } while (0)
#define PG8_LDB(dst, b, h) do { _Pragma("unroll") for (int n = 0; n < 2; ++n) _Pragma("unroll") for (int k = 0; k < 2; ++k) dst[n][k] = *(const PG8_LAS bf16x8*)(lds + PG8_SB(b, h) + boff + n * 2048 + k * 1024); } while (0)
#define PG8_MMA(ai, bj, At, Bt) do { __builtin_amdgcn_s_setprio(1); _Pragma("unroll") for (int m = 0; m < 4; ++m) _Pragma("unroll") for (int n = 0; n < 2; ++n) _Pragma("unroll") for (int k = 0; k < 2; ++k) \
        acc[ai][bj][m][n] = __builtin_amdgcn_mfma_f32_16x16x32_bf16(Bt[n][k], At[m][k], acc[ai][bj][m][n], 0, 0, 0); __builtin_amdgcn_s_setprio(0); } while (0)
#define PG8_WAIT_V(n) asm volatile("s_waitcnt vmcnt(" #n ")" ::: "memory")
#define PG8_WAIT_L(n) asm volatile("s_waitcnt lgkmcnt(" #n ")" ::: "memory")
#define PG8_BAR __builtin_amdgcn_s_barrier()
#define PG8_SCHED __builtin_amdgcn_sched_barrier(0)
    Unit cur, nxt; int ui = 0;
    if (!S.next(0, cur)) return;
    f32x4 acc[2][2][4][2];
#pragma unroll
    for (int a = 0; a < 2; ++a)
#pragma unroll
        for (int b = 0; b < 2; ++b)
#pragma unroll
            for (int m = 0; m < 4; ++m)
#pragma unroll
                for (int n = 0; n < 2; ++n) acc[a][b][m][n] = (f32x4){0.f, 0.f, 0.f, 0.f};
    bf16x8 At[4][2], B0[2][2], B1[2][2];
    const char* cA = (const char*)g.A + (size_t)cur.pm * tstep; const char* cB = (const char*)g.Bt + (size_t)cur.pn * tstep;
    S.a_ready(cur);
    PG8_STAGE(PG8_SB(0, 0), cB, voffB); PG8_STAGE(PG8_SA(0, 0), cA, voffA); PG8_STAGE(PG8_SB(0, 1), cB + hstep, voffB); PG8_STAGE(PG8_SA(0, 1), cA + hstep, voffA);
    if (wr == 1) PG8_BAR;
    PG8_WAIT_V(4); PG8_BAR;
    PG8_STAGE(PG8_SB(1, 0), cB + kstep, voffB); PG8_STAGE(PG8_SA(1, 0), cA + kstep, voffA); PG8_STAGE(PG8_SB(1, 1), cB + hstep + kstep, voffB);
    PG8_WAIT_V(6); PG8_BAR;
    PG8_STAMP();
    for (;;) {
        const bool has_next = S.next(ui + 1, nxt);
        const char* nA = has_next ? (const char*)g.A + (size_t)nxt.pm * tstep : cA; const char* nB = has_next ? (const char*)g.Bt + (size_t)nxt.pn * tstep : cB;
        for (int t = 0; t < nt; t += 2) {
            const bool last = (t == nt - 2);
            const char* a1 = cA + (size_t)(t + 1) * kstep;
            const char* a2 = last ? nA : cA + (size_t)(t + 2) * kstep; const char* b2 = last ? nB : cB + (size_t)(t + 2) * kstep;
            const char* a3 = a2 + kstep; const char* b3 = b2 + kstep;
            if (last && has_next) S.a_ready(nxt);
            PG8_LDB(B0, 0, 0); PG8_SCHED; PG8_LDA(At, 0, 0); PG8_STAGE(PG8_SA(1, 1), a1 + hstep, voffA);
            PG8_WAIT_L(8); PG8_BAR; PG8_WAIT_L(0); PG8_MMA(0, 0, At, B0); PG8_BAR; PG8_SCHED;
            PG8_LDB(B1, 0, 1); PG8_STAGE(PG8_SB(0, 0), b2, voffB);
            PG8_BAR; PG8_WAIT_L(0); PG8_MMA(0, 1, At, B1); PG8_BAR;
            PG8_LDA(At, 0, 1); PG8_STAGE(PG8_SA(0, 0), a2, voffA);
            PG8_BAR; PG8_WAIT_L(0); PG8_MMA(1, 0, At, B0); PG8_BAR; PG8_SCHED;
            PG8_STAGE(PG8_SB(0, 1), b2 + hstep, voffB);
            PG8_WAIT_V(6); PG8_BAR; PG8_MMA(1, 1, At, B1); PG8_BAR;
            PG8_LDB(B0, 1, 0); PG8_SCHED; PG8_LDA(At, 1, 0); PG8_STAGE(PG8_SA(0, 1), a2 + hstep, voffA);
            PG8_WAIT_L(8); PG8_BAR; PG8_WAIT_L(0); PG8_MMA(0, 0, At, B0); PG8_BAR; PG8_SCHED;
            PG8_LDB(B1, 1, 1); PG8_STAGE(PG8_SB(1, 0), b3, voffB);
            PG8_BAR; PG8_WAIT_L(0); PG8_MMA(0, 1, At, B1); PG8_BAR;
            PG8_LDA(At, 1, 1); PG8_STAGE(PG8_SA(1, 0), a3, voffA);
            PG8_BAR; PG8_WAIT_L(0); PG8_MMA(1, 0, At, B0); PG8_BAR; PG8_SCHED;
            PG8_STAGE(PG8_SB(1, 1), b3 + hstep, voffB);
            PG8_WAIT_V(6); PG8_BAR; PG8_MMA(1, 1, At, B1); PG8_BAR;
        }
        PG8_STAMP();
        if constexpr (!Epi::AFTER_DRAIN) { E(acc, cur, wr, wc, fr, fq); S.done(cur); }
        PG8_STAMP();
        if (!has_next) break;
#pragma unroll
        for (int a = 0; a < 2; ++a)
#pragma unroll
            for (int b = 0; b < 2; ++b)
#pragma unroll
                for (int m = 0; m < 4; ++m)
#pragma unroll
                    for (int n = 0; n < 2; ++n) acc[a][b][m][n] = (f32x4){0.f, 0.f, 0.f, 0.f};
        cur = nxt; cA = nA; cB = nB; ++ui;
    }
    PG8_WAIT_V(0);
    if (wr == 0) PG8_BAR;
    PG8_BAR;
    if constexpr (Epi::AFTER_DRAIN) { E.fused(acc, cur, wr, wc, fr, fq, lds, wid, lane); S.done(cur); }
    PG8_STAMP();
    if (STAMP && wid == 0) { stamps[lane] = lane < nts ? (((unsigned long long)(unsigned)ts_hi << 32) | (unsigned)ts_lo) : 0ull;
        if (lane == 62) stamps[62] = rt_entry; if (lane == 63) stamps[63] = (unsigned long long)wall_clock64(); }
#undef PG8_STAMP
#undef PG8_SA
#undef PG8_SB
#undef PG8_STAGE
#undef PG8_LDA
#undef PG8_LDB
#undef PG8_MMA
#undef PG8_WAIT_V
#undef PG8_WAIT_L
#undef PG8_BAR
#undef PG8_SCHED
}
}

__device__ __forceinline__ void tile_load(const float* src, int N, int k0, int n0, int tid, float (&v)[8]) {
#pragma unroll
    for (int i = 0; i < 8; ++i) { const int e = tid + NTHR * i, kr = e >> 6, nc = e & 63; v[i] = src[(size_t)(k0 + kr) * N + n0 + nc]; }
}
__device__ __forceinline__ void tile_store(const float (&v)[8], int K, bf16_t* dst, int k0, int n0, int tid, LAS uchar* lds) {
    LAS float* tl = (LAS float*)lds;
    __syncthreads();
#pragma unroll
    for (int i = 0; i < 8; ++i) { const int e = tid + NTHR * i, kr = e >> 6, nc = e & 63; tl[nc * 65 + kr] = v[i]; }
    __syncthreads();
#pragma unroll
    for (int i = 0; i < 4; ++i) { const int e = tid + NTHR * i, nr = e >> 5, kp = e & 31;
        *(unsigned*)(dst + (size_t)(n0 + nr) * K + k0 + 2 * kp) = pk_bf16(tl[nr * 65 + 2 * kp], tl[nr * 65 + 2 * kp + 1]); }
}

__device__ __forceinline__ unsigned fp6code(float y) {
    const float a = fabsf(y);
    const float t = a < 2.f ? 8.f * a : (a < 4.f ? 4.f * a + 8.f : 2.f * a + 16.f);
    int c = (int)rintf(t); c = c > 31 ? 31 : c;
    return (unsigned)c | (y < 0.f ? 32u : 0u);
}
__device__ __forceinline__ unsigned fp4code(float y) {
    const float a = fabsf(y);
    const float t = a < 2.f ? 2.f * a : (a < 4.f ? a + 2.f : 0.5f * a + 4.f);
    int c = (int)rintf(t); c = c > 7 ? 7 : c;
    return (unsigned)c | (y < 0.f ? 8u : 0u);
}
__device__ __forceinline__ void phase0(const MKP& p, LAS uchar* lds) {
    int tid = threadIdx.x; asm volatile("" : "+v"(tid));
    const int bid = blockIdx.x, G = gridDim.x, wid = tid >> 6, lane = tid & 63;
    const int gtid = bid * NTHR + tid, gthreads = G * NTHR;
    {
        LAS float* sc = (LAS float*)lds;
        LAS float* red = (LAS float*)(lds + 12288);
        bool have = false;
        for (int it = bid; it < 192; it += G) {
            if (!have) { for (int i = tid; i < 3072; i += NTHR) { const int cv = i >> 10, k = i & 1023; const float x = cv == 0 ? p.c_ctx[k] : p.c[(cv - 1) * D + k]; sc[i] = silu_f(x); } have = true; }
            __syncthreads();
            const int l = it / 96, cgp = it % 96, col = cgp * 64 + lane;
            const float* w = p.w_mod + (size_t)l * D * 6144 + col;
            float a0 = 0.f, a1 = 0.f, a2 = 0.f;
#pragma unroll 8
            for (int k = wid * 128; k < wid * 128 + 128; ++k) { const float wv = w[(size_t)k * 6144]; a0 += sc[k] * wv; a1 += sc[1024 + k] * wv; a2 += sc[2048 + k] * wv; }
            red[(wid * 3 + 0) * 64 + lane] = a0; red[(wid * 3 + 1) * 64 + lane] = a1; red[(wid * 3 + 2) * 64 + lane] = a2;
            __syncthreads();
            if (tid < 192) { const int cv = tid >> 6, ln = tid & 63; float s = p.b_mod[l * 6144 + cgp * 64 + ln];
#pragma unroll
                for (int w8 = 0; w8 < 8; ++w8) s += red[(w8 * 3 + cv) * 64 + ln];
                p.modv[(l * 3 + cv) * 6144 + cgp * 64 + ln] = s; }
        }
        __syncthreads();
    }
    {
        auto tile_desc = [&](int g, const float*& src, int& K, int& N, bf16_t*& dst, int& k0, int& n0) {
            int t = g;
            if (t < 384) { src = p.w_in_ab; K = 1024; N = 1536; dst = p.WinT; }
            else if ((t -= 384) < 64) { src = p.s5_w_glu; K = 512; N = 512; dst = p.WgluT; }
            else if ((t -= 64) < 256) { src = p.w_out_ab; K = 1024; N = 1024; dst = p.WoutT; }
            else if ((t -= 256) < 768) { src = p.w_in_c; K = 1024; N = 3072; dst = p.WincT; }
            else if ((t -= 768) < 256) { src = p.w_out_c; K = 1024; N = 1024; dst = p.WoutcT; }
            else { t -= 256; const int m = t & 15; const bool isx = t >= 16; src = (isx ? p.lru_w_x : p.lru_w_a) + (size_t)m * 4096; K = 64; N = 64; dst = (isx ? p.WxT : p.WaT) + (size_t)m * 4096; t = 0; }
            const int nkt = K / 64; k0 = (t % nkt) * 64; n0 = (t / nkt) * 64;
        };
        float va[8], vb[8];
        int g = bid;
        const float* src; int K, N, k0, n0; bf16_t* dst;
        if (g < 1760) { tile_desc(g, src, K, N, dst, k0, n0); tile_load(src, N, k0, n0, tid, va); }
        for (; g < 1760; g += G) {
            const float* src2 = src; int K2 = K, N2 = N, k02 = k0, n02 = n0; bf16_t* dst2 = dst;
            const bool hn = g + G < 1760;
            if (hn) { tile_desc(g + G, src2, K2, N2, dst2, k02, n02); tile_load(src2, N2, k02, n02, tid, vb); }
            tile_store(va, K, dst, k0, n0, tid, lds);
            if (hn) {
#pragma unroll
                for (int i = 0; i < 8; ++i) va[i] = vb[i];
                src = src2; K = K2; N = N2; k0 = k02; n0 = n02; dst = dst2; }
        }
        __syncthreads();
    }
    for (int task = __builtin_amdgcn_readfirstlane(bid * 8 + wid); task < 4096; task += G * 8) {
        const int kt = task & 31, k4 = (task >> 5) & 3, hp = (task >> 7) & 15, l = task >> 11;
        const int r = lane & 31, hh = lane >> 5;
        const float* kp = p.peer_keys + (((size_t)(l * 16 + hp) * 128) + 32 * k4 + r) * 128 + 8 * hh;
        const float* wp = p.peer_wq + ((size_t)l * 1024 + 32 * kt + r) * 2048 + hp * 128 + 8 * hh;
        f32x16 accw = {0.f, 0.f, 0.f, 0.f, 0.f, 0.f, 0.f, 0.f, 0.f, 0.f, 0.f, 0.f, 0.f, 0.f, 0.f, 0.f};
        f32x4 ka[8][2], wa[8][2];
#pragma unroll
        for (int ks = 0; ks < 8; ++ks) { ka[ks][0] = *(const f32x4*)(kp + 16 * ks); ka[ks][1] = *(const f32x4*)(kp + 16 * ks + 4); wa[ks][0] = *(const f32x4*)(wp + 16 * ks); wa[ks][1] = *(const f32x4*)(wp + 16 * ks + 4); }
#pragma unroll
        for (int ks = 0; ks < 8; ++ks) {
            u32x4 au, bu; au.x = pk_bf16(ka[ks][0][0], ka[ks][0][1]); au.y = pk_bf16(ka[ks][0][2], ka[ks][0][3]); au.z = pk_bf16(ka[ks][1][0], ka[ks][1][1]); au.w = pk_bf16(ka[ks][1][2], ka[ks][1][3]);
            bu.x = pk_bf16(wa[ks][0][0], wa[ks][0][1]); bu.y = pk_bf16(wa[ks][0][2], wa[ks][0][3]); bu.z = pk_bf16(wa[ks][1][0], wa[ks][1][1]); bu.w = pk_bf16(wa[ks][1][2], wa[ks][1][3]);
            accw = __builtin_amdgcn_mfma_f32_32x32x16_bf16(__builtin_bit_cast(bf16x8, au), __builtin_bit_cast(bf16x8, bu), accw, 0, 0, 0); }
        bf16_t* dstw = p.WqT + ((size_t)l * 2048 + hp * 128 + 32 * k4) * 1024 + 32 * kt + r;
#pragma unroll
        for (int e = 0; e < 16; ++e) dstw[(size_t)((e & 3) + 8 * (e >> 2) + 4 * hh) * 1024] = f2bf(accw[e]);
    }
    for (int r0 = __builtin_amdgcn_readfirstlane(bid * 8 + wid) * 4; r0 < 65536; r0 += G * 32) {
        const int q = lane & 31, hl = lane >> 5;
        f32x4 v[2][8];
#pragma unroll
        for (int k = 0; k < 2; ++k) { const int r = r0 + 2 * k + hl; const bool isv = r >= 32768; const int rr = r & 32767;
            const float* src = (isv ? p.peer_v : p.peer_u) + (size_t)rr * D;
#pragma unroll
            for (int i = 0; i < 8; ++i) v[k][i] = __builtin_nontemporal_load((const f32x4*)(src + 4 * q + 128 * i)); }
#pragma unroll
        for (int k = 0; k < 2; ++k) { const int r = r0 + 2 * k + hl; const bool isv = r >= 32768; const int rr = r & 32767;
            float am = 0.f;
#pragma unroll
            for (int i = 0; i < 8; ++i) am = fmaxf(am, fmaxf(fmaxf(fabsf(v[k][i][0]), fabsf(v[k][i][1])), fmaxf(fabsf(v[k][i][2]), fabsf(v[k][i][3]))));
#pragma unroll
            for (int o = 16; o > 0; o >>= 1) am = fmaxf(am, __shfl_xor(am, o));
            if (!isv) {
                const float sc = am > 0.f ? 7.5f / am : 1.f;
                u32x6p w;
#pragma unroll
                for (int h2 = 0; h2 < 2; ++h2) { unsigned cc[16];
#pragma unroll
                    for (int n = 0; n < 16; ++n) cc[n] = fp6code(v[k][4 * h2 + (n >> 2)][n & 3] * sc);
                    w[3 * h2] = cc[0] | (cc[1] << 6) | (cc[2] << 12) | (cc[3] << 18) | (cc[4] << 24) | (cc[5] << 30);
                    w[3 * h2 + 1] = (cc[5] >> 2) | (cc[6] << 4) | (cc[7] << 10) | (cc[8] << 16) | (cc[9] << 22) | (cc[10] << 28);
                    w[3 * h2 + 2] = (cc[10] >> 4) | (cc[11] << 2) | (cc[12] << 8) | (cc[13] << 14) | (cc[14] << 20) | (cc[15] << 26); }
                uchar* dst = p.Ub + (size_t)rr * 768;
                *(u32x4*)(dst + 16 * q) = (u32x4){w[0], w[1], w[2], w[3]}; *(u32x2*)(dst + 512 + 8 * q) = (u32x2){w[4], w[5]};
                if (q == 0) p.SU[rr] = am > 0.f ? am * (1.f / 7.5f) : 1.f;
            } else {
                const float sc = am > 0.f ? 6.f / am : 1.f;
                u32x4 w;
#pragma unroll
                for (int d = 0; d < 4; ++d) { unsigned acc4 = 0u;
#pragma unroll
                    for (int n = 0; n < 8; ++n) acc4 |= fp4code(v[k][2 * d + (n >> 2)][n & 3] * sc) << (4 * n);
                    w[d] = acc4; }
                *(u32x4*)(p.Vb + (size_t)rr * 512 + 16 * q) = w;
                if (q == 0) p.SV[rr] = am > 0.f ? am * (1.f / 6.f) : 1.f;
            } }
    }
    if (gtid < 65536) {
        const int idx = gtid >> 4, c = gtid & 15, dg = idx >> 6, pp = idx & 63;
        const double ar = p.s5_a_re[idx], ai = p.s5_a_im[idx], dt = exp((double)p.s5_log_dt[dg]);
        const double mag = exp(ar * dt), abr = mag * cos(ai * dt), abi = mag * sin(ai * dt);
        const double den = ar * ar + ai * ai, nr = abr - 1.0;
        const double cr = (nr * ar + abi * ai) / den, ci = (abi * ar - nr * ai) / den;
        if (c == 0) { p.abar[idx * 2] = (float)abr; p.abar[idx * 2 + 1] = (float)abi;
            const double m256 = exp(256.0 * ar * dt), a256 = fmod(256.0 * ai * dt, 6.283185307179586476925);
            p.aL[idx * 2] = (float)(m256 * cos(a256)); p.aL[idx * 2 + 1] = (float)(m256 * sin(a256)); }
        const double br = p.s5_b_re[idx * 16 + c], bi = p.s5_b_im[idx * 16 + c];
        p.Bmat[((size_t)dg * 128 + 2 * pp) * 16 + c] = f2bf((float)(cr * br - ci * bi));
        p.Bmat[((size_t)dg * 128 + 2 * pp + 1) * 16 + c] = f2bf((float)(cr * bi + ci * br));
        p.CmT[((size_t)dg * 16 + c) * 128 + 2 * pp] = f2bf(p.s5_c_re[((size_t)dg * 16 + c) * 64 + pp]);
        p.CmT[((size_t)dg * 16 + c) * 128 + 2 * pp + 1] = f2bf(-p.s5_c_im[((size_t)dg * 16 + c) * 64 + pp]);
    }
    {
        LAS float* w1s = (LAS float*)lds; LAS float* w2s = (LAS float*)(lds + 33 * 64 * 4);
        __syncthreads();
        for (int i = tid; i < 33 * 64; i += NTHR) w1s[i] = p.hy_w1[i];
        for (int i = tid; i < 64 * 64; i += NTHR) w2s[i] = p.hy_w2[i];
        __syncthreads();
        const int j = lane; const float b1 = p.hy_b1[j], f1 = p.hy_f1[j], b2 = p.hy_b2[j], f2 = p.hy_f2[j];
        for (int pi = __builtin_amdgcn_readfirstlane(bid * 8 + wid); pi < 4352; pi += G * 8) {
            const int L = pi < 256 ? 256 : 4096, pos = pi < 256 ? pi : pi - 256;
            float emb = 0.f;
            if (j == 0) emb = (float)pos / (float)L;
            else if (j < 33) { const int bi = (j - 1) & 15; const float band = 1e-4f + (15.f - 1e-4f) * (float)bi / 15.f;
                const float ang = (6.283185307179586f / (float)L) * (float)pos * band; emb = j <= 16 ? cosf(ang) : -sinf(ang); }
            float a = b1;
#pragma unroll
            for (int k = 0; k < 33; ++k) a += __shfl(emb, k) * w1s[k * 64 + j];
            const float z1 = sinf(f1 * a);
            float c2 = b2;
#pragma unroll
            for (int k = 0; k < 64; ++k) c2 += __shfl(z1, k) * w2s[k * 64 + j];
            p.Z2[(size_t)pi * 64 + j] = sinf(f2 * c2);
        }
        __syncthreads();
    }
    if (gtid < 2048) p.NORMSQ[gtid] = 0.f;
}

__device__ __forceinline__ void norm_one(const MKP& p, const float* xr, int t, const float* gvec, const float* modv_l, int sh_chunk, int sc_chunk, bf16_t* hout, float* fout, int lane) {
    f32x4 v[4], g[4], sc[4], sh[4]; float s = 0.f;
    const float* mv = modv_l + (size_t)tok_cv(t) * 6144;
#pragma unroll
    for (int i = 0; i < 4; ++i) { const int c = 4 * lane + 256 * i; v[i] = *(const f32x4*)(xr + c); g[i] = *(const f32x4*)(gvec + c);
        if (hout) { sc[i] = *(const f32x4*)(mv + sc_chunk * D + c); sh[i] = *(const f32x4*)(mv + sh_chunk * D + c); } }
#pragma unroll
    for (int i = 0; i < 4; ++i) s += v[i][0] * v[i][0] + v[i][1] * v[i][1] + v[i][2] * v[i][2] + v[i][3] * v[i][3];
    s = wave_sum(s);
    const float rstd = rsqrtf(s * (1.f / D) + EPSV);
#pragma unroll
    for (int i = 0; i < 4; ++i) { const int c = 4 * lane + 256 * i;
        f32x4 y; y[0] = v[i][0] * rstd * g[i][0]; y[1] = v[i][1] * rstd * g[i][1]; y[2] = v[i][2] * rstd * g[i][2]; y[3] = v[i][3] * rstd * g[i][3];
        if (hout) { u32x2 w; w.x = pk_bf16(y[0] * (1.f + sc[i][0]) + sh[i][0], y[1] * (1.f + sc[i][1]) + sh[i][1]); w.y = pk_bf16(y[2] * (1.f + sc[i][2]) + sh[i][2], y[3] * (1.f + sc[i][3]) + sh[i][3]);
            *(u32x2*)(hout + (size_t)t * D + c) = w; }
        else *(f32x4*)(fout + (size_t)t * D + c) = y; }
}
__device__ __forceinline__ void norm_phase(const MKP& p, bool from_input, const float* gvec, const float* modv_l, int sh_chunk, int sc_chunk, bf16_t* hout) {
    int tid = threadIdx.x; asm volatile("" : "+v"(tid));
    const int wid = tid >> 6, lane = tid & 63;
    for (int t = __builtin_amdgcn_readfirstlane(blockIdx.x * 8 + wid); t < NTOK; t += gridDim.x * 8)
        norm_one(p, from_input ? xin_row(p, t) : p.X + (size_t)t * D, t, gvec, modv_l, sh_chunk, sc_chunk, hout, p.out, lane);
}

template <int NP>
__device__ __forceinline__ void hyfilt_phase(const MKP& p, LAS uchar* lds, int first, int count, int bid0) {
    LAS float* z2 = (LAS float*)lds;
    int tid = threadIdx.x; asm volatile("" : "+v"(tid));
    const int nb = (int)gridDim.x - bid0;
    if ((int)blockIdx.x >= bid0)
    for (int un = first + ((int)blockIdx.x - bid0); un < first + count; un += nb) {
        const int it = NP == 16 ? un : (un >> 1);
        const int prow = NP == 16 ? un : ((un & 1) ? 272 + (un >> 1) : (un >> 1));
        const bool big = it >= 16; const int L = big ? 4096 : 256; const int p0 = (big ? it - 16 : it) * 16 + (NP == 16 ? 0 : 8 * (un & 1)); const int pbase = (big ? 256 : 0) + p0;
        __syncthreads();
#pragma unroll
        for (int i = 0; i < NP / 8; ++i) z2[tid + NTHR * i] = p.Z2[(size_t)pbase * 64 + tid + NTHR * i];
        if (tid < 64) z2[NP * 64 + tid] = (p0 + NP < L) ? p.Z2[(size_t)(pbase + NP) * 64 + tid] : 0.f;
        __syncthreads();
        const int col0 = 4 * tid;
        const int dir = col0 >> 10, ch0 = col0 & 1023;
        f32x4 acc[NP];
#pragma unroll
        for (int q = 0; q < NP; ++q) acc[q] = (f32x4){0.f, 0.f, 0.f, 0.f};
#pragma nounroll
        for (int k0 = 0; k0 < 64; k0 += 16) {
            f32x4 w[16];
#pragma unroll
            for (int kk = 0; kk < 16; ++kk) w[kk] = *(const f32x4*)(p.hy_w3 + (size_t)(k0 + kk) * 2048 + col0);
#pragma unroll
            for (int k4 = 0; k4 < 16; k4 += 4)
#pragma unroll
                for (int q = 0; q < NP; ++q) { const f32x4 z = *(const LAS f32x4*)(z2 + (q + dir) * 64 + k0 + k4);
#pragma unroll
                    for (int kk = 0; kk < 4; ++kk) acc[q] = (f32x4){z[kk], z[kk], z[kk], z[kk]} * w[k4 + kk] + acc[q]; } }
        const f32x4 dec = *(const f32x4*)(p.hy_decay + col0);
        bf16_t* R = p.Rf + (big ? (size_t)1024 * 512 : 0);
        const int RL = 2 * L;
        float ss[4] = {0.f, 0.f, 0.f, 0.f};
#pragma unroll
        for (int e = 0; e < 4; ++e) {
            const float ad = fabsf(dec[e]); bf16_t* Rc = R + (size_t)(ch0 + e) * RL;
#pragma unroll
            for (int g8 = 0; g8 < NP / 8; ++g8) { float val[8];
#pragma unroll
                for (int q = 0; q < 8; ++q) { const int pos = p0 + dir + 8 * g8 + q; const float tt = (float)pos / (float)L; val[q] = pos < L ? acc[8 * g8 + q][e] * (__expf(-tt * ad) + 0.05f) : 0.f;
                    ss[e] += val[q] * val[q]; }
                const int pg = p0 + 8 * g8;
                u32x4 w;
                if (dir == 0) {
                    w.x = pk_bf16(val[7], val[6]); w.y = pk_bf16(val[5], val[4]); w.z = pk_bf16(val[3], val[2]); w.w = pk_bf16(val[1], val[0]);
                    *(u32x4*)(Rc + (L - 8 - pg)) = w;
                } else {
                    w.x = pk_bf16(val[0], val[1]); w.y = pk_bf16(val[2], val[3]); w.z = pk_bf16(val[4], val[5]); w.w = pk_bf16(val[6], val[7]);
                    *(u32x4*)(Rc + (L + pg)) = w;
                } } }
#pragma unroll
        for (int e = 0; e < 4; ++e) p.PSQ[(size_t)prow * 2048 + col0 + e] = ss[e];
    }
}

#define S5ROW 528
__device__ __forceinline__ float fsigmoid(float x) { return __builtin_amdgcn_rcpf(1.f + __expf(-x)); }
__device__ __forceinline__ float fgelu(float x) { const float z = 1.5957691216057308f * (x + 0.044715f * x * x * x); return x * __builtin_amdgcn_rcpf(1.f + __expf(-z)); }
__device__ __forceinline__ float one_minus_exp(float y) { const float t = y * (1.f + y * (0.5f + y * (0.16666667f + y * 0.041666668f))); return y > -0.125f ? -t : 1.f - __expf(y); }

__device__ __forceinline__ void s5_task(const MKP& p, int seqid, int g, int seg, int mode, LAS uchar* wl, int lane) {
    asm volatile("" : "+v"(lane));
    const bool ctx = seqid < 32; const int b = ctx ? seqid : seqid - 32;
    const int t0 = ctx ? seqid * 256 : CTX_TOK + b * 4096 + seg * 256;
    const int r = lane & 31, hh = lane >> 5, fr = lane & 15, fq = lane >> 4;
    const bool full = ctx || mode == 1;
    bf16_t* YP = (bf16_t*)p.HS;
    const f32x4 dsk = *(const f32x4*)(p.s5_d + 16 * g + 4 * fq);
#pragma nounroll
    for (int d = 0; d < 2; ++d) {
        const int dg = d * 32 + g;
        bf16x8 bm[4], cm[4];
#pragma unroll
        for (int nt = 0; nt < 4; ++nt) bm[nt] = *(const bf16x8*)(p.Bmat + ((size_t)dg * 128 + 32 * nt + r) * 16 + 8 * hh);
#pragma unroll
        for (int ks = 0; ks < 4; ++ks) cm[ks] = *(const bf16x8*)(p.CmT + ((size_t)dg * 16 + fr) * 128 + 32 * ks + 8 * fq);
        const float ar = p.abar[(dg * 64 + lane) * 2], ai = p.abar[(dg * 64 + lane) * 2 + 1];
        float hr = 0.f, hi = 0.f;
        if (!ctx && mode == 1) {
            hr = p.st_re[((b * 2 + d) * 32 + g) * 64 + lane]; hi = p.st_im[((b * 2 + d) * 32 + g) * 64 + lane];
            const float lr = p.aL[(dg * 64 + lane) * 2], li = p.aL[(dg * 64 + lane) * 2 + 1];
            const float* car = p.S5car + ((size_t)((b * 2 + d) * 32 + g) * 16) * 128;
            f32x2 cs[15];
#pragma unroll
            for (int i = 0; i < 15; ++i) { const int s = d == 0 ? i : 15 - i; const bool use = d == 0 ? (s < seg) : (s > seg);
                cs[i] = *(const f32x2*)(car + (use ? s : seg) * 128 + lane * 2); }
#pragma unroll
            for (int i = 0; i < 15; ++i) { const int s = d == 0 ? i : 15 - i; const bool use = d == 0 ? (s < seg) : (s > seg);
                const float nr = lr * hr - li * hi + cs[i][0], ni = lr * hi + li * hr + cs[i][1]; hr = use ? nr : hr; hi = use ? ni : hi; }
        }
        bf16x8 uf = *(const bf16x8*)(p.Zb + (size_t)(t0 + 32 * (d == 0 ? 0 : 7) + r) * 1536 + 16 * g + 8 * hh);
#pragma nounroll
        for (int step = 0; step < 8; ++step) {
            const int sb = d == 0 ? step : 7 - step; const int tb = t0 + 32 * sb;
            const int sbn = d == 0 ? (step < 7 ? step + 1 : 7) : (step < 7 ? 6 - step : 0);
            const bf16x8 ufn = *(const bf16x8*)(p.Zb + (size_t)(t0 + 32 * sbn + r) * 1536 + 16 * g + 8 * hh);
            u32x2 epre[2];
            if (full) {
#pragma unroll
                for (int mt = 0; mt < 2; ++mt) { const size_t t = tb + 16 * mt + fr;
                    epre[mt] = d == 0 ? *(const u32x2*)(p.Zb + t * 1536 + 16 * g + 4 * fq) : *(const u32x2*)(YP + t * 512 + 16 * g + 4 * fq); }
            }
#pragma unroll
            for (int nt = 0; nt < 4; ++nt) {
                f32x16 dd = {0.f, 0.f, 0.f, 0.f, 0.f, 0.f, 0.f, 0.f, 0.f, 0.f, 0.f, 0.f, 0.f, 0.f, 0.f, 0.f};
                dd = __builtin_amdgcn_mfma_f32_32x32x16_bf16(bm[nt], uf, dd, 0, 0, 0);
#pragma unroll
                for (int q = 0; q < 4; ++q) { f32x4 w = {dd[4 * q], dd[4 * q + 1], dd[4 * q + 2], dd[4 * q + 3]};
                    *(LAS f32x4*)(wl + r * S5ROW + (32 * nt + 8 * q + 4 * hh) * 4) = w; }
            }
            uf = ufn;
            f32x2 bu[32];
#pragma unroll
            for (int jj = 0; jj < 32; ++jj) { const int j = d == 0 ? jj : 31 - jj; bu[jj] = *(const LAS f32x2*)(wl + j * S5ROW + 8 * lane); }
            { f32x2 h = {hr, hi}; const f32x2 a1 = {ar, ar}, a2 = {-ai, ai};
#pragma unroll
              for (int jj = 0; jj < 32; ++jj) { const int j = d == 0 ? jj : 31 - jj;
                const f32x2 hs = __builtin_shufflevector(h, h, 1, 0); const f32x2 t = a1 * h + bu[jj]; h = a2 * hs + t;
                if (full) *(LAS unsigned*)(wl + j * S5ROW + 4 * lane) = pk_bf16(h[0], h[1]); }
              hr = h[0]; hi = h[1]; }
            if (full) {
#pragma unroll
                for (int mt = 0; mt < 2; ++mt) {
                    f32x4 y = {0.f, 0.f, 0.f, 0.f};
#pragma unroll
                    for (int ks = 0; ks < 4; ++ks) { const bf16x8 hf = *(const LAS bf16x8*)(wl + (16 * mt + fr) * S5ROW + 64 * ks + 16 * fq);
                        y = __builtin_amdgcn_mfma_f32_16x16x32_bf16(cm[ks], hf, y, 0, 0, 0); }
                    const size_t t = tb + 16 * mt + fr;
                    if (d == 0) {
                        const u32x2 uu = epre[mt];
                        y[0] += dsk[0] * bflo(uu.x); y[1] += dsk[1] * bfhi(uu.x); y[2] += dsk[2] * bflo(uu.y); y[3] += dsk[3] * bfhi(uu.y);
                        u32x2 w; w.x = pk_bf16(y[0], y[1]); w.y = pk_bf16(y[2], y[3]); *(u32x2*)(YP + t * 512 + 16 * g + 4 * fq) = w;
                    } else {
                        const u32x2 yp = epre[mt];
                        y[0] += bflo(yp.x); y[1] += bfhi(yp.x); y[2] += bflo(yp.y); y[3] += bfhi(yp.y);
                        u32x2 w; w.x = pk_bf16(fgelu(y[0]), fgelu(y[1])); w.y = pk_bf16(fgelu(y[2]), fgelu(y[3])); *(u32x2*)(p.ZS + t * 512 + 16 * g + 4 * fq) = w;
                    }
                }
            }
        }
        if (ctx) { float* nre = p.out + (size_t)NTOK * D; float* nim = nre + 131072;
            nre[((b * 2 + d) * 32 + g) * 64 + lane] = hr; nim[((b * 2 + d) * 32 + g) * 64 + lane] = hi; }
        else if (mode == 0) { float* car = p.S5car + ((size_t)((b * 2 + d) * 32 + g) * 16 + seg) * 128; car[lane * 2] = hr; car[lane * 2 + 1] = hi; }
        asm volatile("s_waitcnt vmcnt(0)" ::: "memory");
    }
}

#define LRU_XA 144
#define LRU_G 528
__device__ __forceinline__ void lru_task(const MKP& p, int ck, int h, int mode, LAS uchar* wl, int lane) {
    asm volatile("" : "+v"(lane));
    const bool ctx = ck < 128; const int b = ctx ? (ck >> 2) : ((ck - 128) >> 6); const int cis = ctx ? (ck & 3) : ((ck - 128) & 63); const int nch = ctx ? 4 : 64;
    const int seqbase = ctx ? b * 256 : CTX_TOK + b * 4096;
    const int t0 = ck * 64;
    const int rowlen = ctx ? 256 : 64;
    const int rs = seqbase + ((t0 - seqbase) / rowlen) * rowlen, re = rs + rowlen;
    const int fr = lane & 15, fq = lane >> 4;
    const int ch = 64 * h + lane;
    LAS uchar* xa = wl; LAS uchar* gl = wl + 64 * LRU_XA;
    bf16_t* HF = (bf16_t*)p.HS + (size_t)NTOK * 512;
    {
        const float cw0 = p.lru_conv_w[ch], cw1 = p.lru_conv_w[512 + ch], cw2 = p.lru_conv_w[1024 + ch], cw3 = p.lru_conv_w[1536 + ch], cb = p.lru_conv_b[ch];
        float xr[67];
#pragma unroll
        for (int i = 0; i < 67; ++i) { const int tt = t0 - 2 + i; const int tc = tt < rs ? rs : (tt >= re ? re - 1 : tt);
            const float v = bf2f(p.Zb[(size_t)tc * 1536 + 512 + ch]); xr[i] = (tt >= rs && tt < re) ? v : 0.f; }
#pragma unroll
        for (int j = 0; j < 64; ++j) *(LAS bf16_t*)(xa + j * LRU_XA + 2 * lane) = f2bf(cb + cw0 * xr[j] + cw1 * xr[j + 1] + cw2 * xr[j + 2] + cw3 * xr[j + 3]);
    }
#pragma nounroll
    for (int d = 0; d < 2; ++d) {
        bf16x8 wa[4][2], wx[4][2];
#pragma unroll
        for (int nt = 0; nt < 4; ++nt)
#pragma unroll
            for (int ks = 0; ks < 2; ++ks) { const size_t o = ((size_t)(d * 8 + h) * 64 + 16 * nt + fr) * 64 + 32 * ks + 8 * fq;
                wa[nt][ks] = *(const bf16x8*)(p.WaT + o); wx[nt][ks] = *(const bf16x8*)(p.WxT + o); }
        const float ba = p.lru_b_a[d * 512 + ch], bx = p.lru_b_x[d * 512 + ch];
        const float lm = -p.lru_lambda[d * 512 + ch]; const float sp8 = -8.f * (lm > 20.f ? lm : log1pf(expf(lm)));
        float hst = 0.f, aprod = 1.f;
        if (mode == 1) {
            hst = ctx ? 0.f : p.st_lru[(b * 2 + d) * 512 + ch];
            const float* car = p.LRUcar + ((size_t)(ck - cis) * 2 + d) * 1024 + ch * 2;
            const int nprev = d == 0 ? cis : nch - 1 - cis;
            for (int b0 = 0; b0 < nprev; b0 += 16) {
                f32x2 cc[16];
#pragma unroll
                for (int i = 0; i < 16; ++i) { const int k = b0 + i; const int s = d == 0 ? k : nch - 1 - k; const int sc = k < nprev ? s : cis;
                    cc[i] = *(const f32x2*)(car + (size_t)sc * 2048); }
#pragma unroll
                for (int i = 0; i < 16; ++i) { const float nh = cc[i][0] * hst + cc[i][1]; hst = (b0 + i < nprev) ? nh : hst; }
            }
        }
#pragma nounroll
        for (int step = 0; step < 4; ++step) {
            const int sb = d == 0 ? step : 3 - step; const int tb = t0 + 16 * sb;
            float xg[16]; unsigned hfp[16];
            if (mode == 1 && d == 1) {
#pragma unroll
                for (int jj = 0; jj < 16; ++jj) { const size_t t = tb + 15 - jj; xg[jj] = bf2f(p.Zb[t * 1536 + 1024 + ch]); hfp[jj] = HF[t * 512 + ch]; }
            }
            bf16x8 xf[2];
#pragma unroll
            for (int ks = 0; ks < 2; ++ks) xf[ks] = *(const LAS bf16x8*)(xa + (16 * sb + fr) * LRU_XA + 64 * ks + 16 * fq);
#pragma unroll
            for (int nt = 0; nt < 4; ++nt) {
                f32x4 da = {0.f, 0.f, 0.f, 0.f}, dx = {0.f, 0.f, 0.f, 0.f};
#pragma unroll
                for (int ks = 0; ks < 2; ++ks) { da = __builtin_amdgcn_mfma_f32_16x16x32_bf16(wa[nt][ks], xf[ks], da, 0, 0, 0); dx = __builtin_amdgcn_mfma_f32_16x16x32_bf16(wx[nt][ks], xf[ks], dx, 0, 0, 0); }
                *(LAS f32x4*)(gl + fr * LRU_G + (16 * nt + 4 * fq) * 4) = da;
                *(LAS f32x4*)(gl + fr * LRU_G + 256 + (16 * nt + 4 * fq) * 4) = dx;
            }
            float av[16], bv[16];
#pragma unroll
            for (int jj = 0; jj < 16; ++jj) { const int j = d == 0 ? jj : 15 - jj;
                const float ra = *(const LAS float*)(gl + j * LRU_G + 4 * lane) + ba, rx = *(const LAS float*)(gl + j * LRU_G + 256 + 4 * lane) + bx;
                const float xbv = bf2f(*(const LAS bf16_t*)(xa + (16 * sb + j) * LRU_XA + 2 * lane));
                const float la = sp8 * fsigmoid(ra); av[jj] = __expf(la);
                bv[jj] = __builtin_amdgcn_sqrtf(one_minus_exp(2.f * la)) * (fsigmoid(rx) * xbv); }
#pragma unroll
            for (int jj = 0; jj < 16; ++jj) { hst = av[jj] * hst + bv[jj]; aprod *= av[jj]; bv[jj] = hst; }
            if (mode == 1) {
                if (d == 0) {
#pragma unroll
                    for (int jj = 0; jj < 16; ++jj) HF[(size_t)(tb + jj) * 512 + ch] = f2bf(bv[jj]);
                } else {
#pragma unroll
                    for (int jj = 0; jj < 16; ++jj) p.CAT[(size_t)(tb + 15 - jj) * D + 512 + ch] = f2bf((bf2f((bf16_t)hfp[jj]) + bv[jj]) * fgelu(xg[jj]));
                }
            }
        }
        if (mode == 0) { float* car = p.LRUcar + ((size_t)ck * 2 + d) * 1024 + ch * 2; *(f32x2*)car = (f32x2){aprod, hst}; }
        else if (ctx && ((d == 0 && cis == 3) || (d == 1 && cis == 0))) { float* nl = p.out + (size_t)NTOK * D + 262144; nl[(b * 2 + d) * 512 + ch] = hst; }
        asm volatile("s_waitcnt vmcnt(0)" ::: "memory");
    }
}

__device__ __forceinline__ void scan_phase(const MKP& p, int pass, LAS uchar* lds, int which = 3) {
    int tid = threadIdx.x; asm volatile("" : "+v"(tid));
    const int wid = tid >> 6, lane = tid & 63;
    LAS uchar* wl = lds + wid * 20480;
    const int gw = __builtin_amdgcn_readfirstlane(blockIdx.x * 8 + wid), GW = gridDim.x * 8;
    if (which & 1)
    for (int task = gw; task < 1536; task += GW) {
        int seqid, g, seg, mode;
        if (task < 1024) { seqid = 32 + (task >> 9); seg = (task >> 5) & 15; g = task & 31; mode = pass; }
        else { const int i = (task - 1024) + pass * 512; seqid = i >> 5; g = i & 31; seg = 0; mode = 1; }
        s5_task(p, seqid, g, seg, mode, wl, lane);
    }
    asm volatile("" ::: "memory");
    if (which & 2)
    for (int i = (gw + GW - (1536 % GW)) % GW; i < 2048; i += GW) lru_task(p, i >> 3, i & 7, pass, wl, lane);
    if (which == 3) { const int G = (int)gridDim.x; const int b0 = G >= 64 ? G - 64 : 0, b1 = G >= 16 ? G - 16 : 0;
        hyfilt_phase<16>(p, lds, 16 + 128 * pass, 128, b0); hyfilt_phase<8>(p, lds, 16 * pass, 16, b1); }
}

__device__ __forceinline__ unsigned f2key(float f) { const unsigned u = __float_as_uint(f); return u ^ ((unsigned)((int)u >> 31) | 0x80000000u); }
template <int CTRL> __device__ __forceinline__ unsigned dppu(unsigned x) { return (unsigned)__builtin_amdgcn_update_dpp(0, (int)x, CTRL, 0xf, 0xf, false); }
template <int CTRL> __device__ __forceinline__ float dppf(float x) { return __int_as_float(__builtin_amdgcn_update_dpp(0, __float_as_int(x), CTRL, 0xf, 0xf, false)); }
__device__ __forceinline__ unsigned rowmax_u(unsigned x) { unsigned t; t = dppu<0x121>(x); x = x > t ? x : t; t = dppu<0x122>(x); x = x > t ? x : t; t = dppu<0x124>(x); x = x > t ? x : t; t = dppu<0x128>(x); x = x > t ? x : t; return x; }
__device__ __forceinline__ float rowmax_f(float x) { x = fmaxf(x, dppf<0x121>(x)); x = fmaxf(x, dppf<0x122>(x)); x = fmaxf(x, dppf<0x124>(x)); x = fmaxf(x, dppf<0x128>(x)); return x; }
__device__ __forceinline__ float rowsum_f(float x) { x += dppf<0x121>(x); x += dppf<0x122>(x); x += dppf<0x124>(x); x += dppf<0x128>(x); return x; }
#define CEX(a, b) { const unsigned _hi = (a) > (b) ? (a) : (b), _lo = (a) > (b) ? (b) : (a); (a) = _hi; (b) = _lo; }

#define PS_ROW 528

#define R2_SV0 135168
#define R2_SI0 151552
struct OneUnit { int pm, pn;
    __device__ bool next(int i, pg8::Unit& u) const { if (i != 0) return false; u.pm = pm; u.pn = pn; return true; }
    __device__ __forceinline__ void a_ready(const pg8::Unit&) const {}
    __device__ __forceinline__ void done(const pg8::Unit&) const {}
};
struct R2Tab { unsigned v[16]; };
constexpr R2Tab r2_make_tab() {
    R2Tab t{}; unsigned b[64] = {}; for (int n = 0; n < 64; ++n) b[n] = 255u;
    int n = 0;
    for (int i = 0; i < 16; ++i) for (int j = 0; j < 16; ++j) if ((i + 1) * (j + 1) <= 16) b[n++] = (unsigned)(i << 4 | j);
    for (int l = 0; l < 16; ++l) t.v[l] = b[l] | (b[16 + l] << 8) | (b[32 + l] << 16) | (b[48 + l] << 24);
    return t;
}
struct EpiTopk {
    static constexpr bool PERM = false, AFTER_DRAIN = true;
    const MKP* p; int layer;
    __device__ __forceinline__ void fused(f32x4 (&acc)[2][2][4][2], const pg8::Unit& u, int wr, int wc, int fr, int fq, LAS uchar* lds, int wid, int lane) const {
        const int pm = u.pm, h = u.pn; const int rbase = 32 * wid;
        unsigned r2tab = 0u;
        { constexpr R2Tab T = r2_make_tab();
#pragma unroll
          for (int l = 0; l < 16; ++l) r2tab = (fr == l) ? T.v[l] : r2tab; }
#pragma unroll
        for (int half = 0; half < 2; ++half) {
#pragma unroll
            for (int ai = 0; ai < 2; ++ai)
#pragma unroll
                for (int m = 0; m < 4; ++m)
#pragma unroll
                    for (int n = 0; n < 2; ++n) *(LAS f32x4*)(lds + (ai * 128 + wr * 64 + m * 16 + fr) * PS_ROW + (wc * 32 + n * 16 + 4 * fq) * 4) = acc[ai][half][m][n];
            __syncthreads();
#if defined(MK_PROBE) && ((MK_PROBE >> 15) & 1)
            for (int rep_ = 0; rep_ < 2; ++rep_)
#endif
            for (int rg = 0; rg < 8; rg += 2) {
                const int q = fr;
                int rowc[2]; unsigned kk[2][8]; unsigned res[2];
#pragma unroll
                for (int c = 0; c < 2; ++c) { rowc[c] = rbase + 4 * (rg + c) + fq; const LAS uchar* srow = lds + rowc[c] * PS_ROW;
                    const f32x4 s0 = *(const LAS f32x4*)(srow + 32 * q), s1 = *(const LAS f32x4*)(srow + 32 * q + 16);
#pragma unroll
                    for (int e = 0; e < 4; ++e) { kk[c][e] = (f2key(s0[e]) & ~127u) | (127u - (unsigned)(8 * q + e)); kk[c][4 + e] = (f2key(s1[e]) & ~127u) | (127u - (unsigned)(8 * q + 4 + e)); }
                    CEX(kk[c][0], kk[c][1]) CEX(kk[c][2], kk[c][3]) CEX(kk[c][4], kk[c][5]) CEX(kk[c][6], kk[c][7])
                    CEX(kk[c][0], kk[c][2]) CEX(kk[c][1], kk[c][3]) CEX(kk[c][4], kk[c][6]) CEX(kk[c][5], kk[c][7])
                    CEX(kk[c][1], kk[c][2]) CEX(kk[c][5], kk[c][6])
                    CEX(kk[c][0], kk[c][4]) CEX(kk[c][1], kk[c][5]) CEX(kk[c][2], kk[c][6]) CEX(kk[c][3], kk[c][7])
                    CEX(kk[c][2], kk[c][4]) CEX(kk[c][3], kk[c][5])
                    CEX(kk[c][1], kk[c][2]) CEX(kk[c][3], kk[c][4]) CEX(kk[c][5], kk[c][6])
                    res[c] = 0u; }
#pragma unroll
                for (int it = 0; it < 16; ++it) {
#pragma unroll
                    for (int c = 0; c < 2; ++c) { const unsigned mx = rowmax_u(kk[c][0]); res[c] = (q == it) ? mx : res[c]; const bool own = kk[c][0] == mx;
#pragma unroll
                        for (int e = 0; e < 7; ++e) kk[c][e] = own ? kk[c][e + 1] : kk[c][e];
                        kk[c][7] = own ? 0u : kk[c][7]; }
                }
                int idxc[2]; float valc[2];
#pragma unroll
                for (int c = 0; c < 2; ++c) { idxc[c] = 127 - (int)(res[c] & 127u); valc[c] = *(const LAS float*)(lds + rowc[c] * PS_ROW + 4 * idxc[c]); }
                if (half == 0) {
#pragma unroll
                    for (int c = 0; c < 2; ++c) { *(LAS float*)(lds + R2_SV0 + (rowc[c] * 16 + q) * 4) = valc[c]; *(LAS uchar*)(lds + R2_SI0 + rowc[c] * 16 + q) = (uchar)idxc[c]; }
                } else {
                    const int rowlane = lane & 48;
                    float sv0[2]; int si0[2]; unsigned cd[2][4]; unsigned res2[2];
#pragma unroll
                    for (int c = 0; c < 2; ++c) { sv0[c] = *(const LAS float*)(lds + R2_SV0 + (rowc[c] * 16 + q) * 4); si0[c] = *(const LAS uchar*)(lds + R2_SI0 + rowc[c] * 16 + q);
#pragma unroll
                        for (int s4 = 0; s4 < 4; ++s4) { const unsigned b = (r2tab >> (8 * s4)) & 255u;
                            const float sm = __shfl(sv0[c], rowlane + (int)(b >> 4)) + __shfl(valc[c], rowlane + (int)(b & 15u));
                            cd[c][s4] = b == 255u ? 0u : ((f2key(sm) & ~255u) | (255u - b)); }
                        CEX(cd[c][0], cd[c][1]) CEX(cd[c][2], cd[c][3]) CEX(cd[c][0], cd[c][2]) CEX(cd[c][1], cd[c][3]) CEX(cd[c][1], cd[c][2])
                        res2[c] = 0u; }
#pragma unroll
                    for (int it = 0; it < 16; ++it) {
#pragma unroll
                        for (int c = 0; c < 2; ++c) { const unsigned mx = rowmax_u(cd[c][0]); res2[c] = (q == it) ? mx : res2[c]; const bool own = cd[c][0] == mx;
                            cd[c][0] = own ? cd[c][1] : cd[c][0]; cd[c][1] = own ? cd[c][2] : cd[c][1]; cd[c][2] = own ? cd[c][3] : cd[c][2]; cd[c][3] = own ? 0u : cd[c][3]; }
                    }
#pragma unroll
                    for (int c = 0; c < 2; ++c) {
                        const int flat = 255 - (int)(res2[c] & 255u); const int ii = flat >> 4, jj = flat & 15;
                        const float fv = __shfl(sv0[c], rowlane + ii) + __shfl(valc[c], rowlane + jj);
                        const int e0 = __shfl(si0[c], rowlane + ii), e1 = __shfl(idxc[c], rowlane + jj);
                        const float mx = rowmax_f(fv); const float ex = __expf(fv - mx); const float sm = rowsum_f(ex);
                        const int t = pm * 256 + rowc[c];
                        p->EI[(size_t)t * 128 + h * 16 + q] = e0 * 128 + e1;
                        p->EG[(size_t)t * 128 + h * 16 + q] = ex / sm; }
                }
            }
            __syncthreads();
        }
    }
};
__device__ __forceinline__ void peer_route2_phase(const MKP& p, int layer, LAS uchar* lds, const bf16_t* Hsrc) {
    const bf16_t* WkT = p.WqT + (size_t)layer * 2048 * 1024;
    for (int item = blockIdx.x; item < 512; item += gridDim.x) {
        OneUnit S{item >> 3, item & 7}; EpiTopk E{&p, layer};
        pg8::gemm_phase<EpiTopk, OneUnit, false>(lds, pg8::Gemm{Hsrc, WkT, NTOK, 2048, D}, S, E, nullptr);
        __syncthreads();
    }
}

typedef unsigned int u32x6 __attribute__((ext_vector_type(6)));
typedef float f32x32 __attribute__((ext_vector_type(32)));
typedef __bf16 bf16x32 __attribute__((ext_vector_type(32)));
template <int M> __device__ __forceinline__ bf16x2v bfpair(const bf16x32& v) { return __builtin_shufflevector(v, v, 2 * M, 2 * M + 1); }
__device__ __forceinline__ float readlane_f(float x, int l) { return __int_as_float(__builtin_amdgcn_readlane(__float_as_int(x), l)); }
__device__ __forceinline__ float dot2bf(unsigned a, bf16x2v b, float c) { return __builtin_amdgcn_fdot2_f32_bf16(__builtin_bit_cast(bf16x2v, a), b, c, false); }

__device__ __forceinline__ void pe_sort_header(int lane, int& ei0, int& ei1, float& eg0, float& eg1) {
    unsigned k0 = ((unsigned)ei0 << 7) | (unsigned)lane, k1 = ((unsigned)ei1 << 7) | (unsigned)(64 + lane);
#pragma unroll
    for (int k = 2; k <= 128; k <<= 1) {
        const bool asc = (lane & (k >> 1)) == 0;
#pragma unroll
        for (int j = k >> 1; j >= 2; j >>= 1) {
            const bool keepmin = ((lane & (j >> 1)) == 0) == asc;
            const unsigned p0 = (unsigned)__shfl_xor((int)k0, j >> 1), p1 = (unsigned)__shfl_xor((int)k1, j >> 1);
            const unsigned mn0 = k0 < p0 ? k0 : p0, mx0 = k0 < p0 ? p0 : k0, mn1 = k1 < p1 ? k1 : p1, mx1 = k1 < p1 ? p1 : k1;
            k0 = keepmin ? mn0 : mx0; k1 = keepmin ? mn1 : mx1; }
        { const unsigned mn = k0 < k1 ? k0 : k1, mx = k0 < k1 ? k1 : k0; k0 = asc ? mn : mx; k1 = asc ? mx : mn; } }
    const int s0 = (int)(k0 & 127u), s1 = (int)(k1 & 127u);
    const float a0 = __shfl(eg0, s0 & 63), b0 = __shfl(eg1, s0 & 63), a1 = __shfl(eg0, s1 & 63), b1 = __shfl(eg1, s1 & 63);
    eg0 = s0 < 64 ? a0 : b0; eg1 = s1 < 64 ? a1 : b1; ei0 = (int)(k0 >> 7); ei1 = (int)(k1 >> 7);
}

__device__ __forceinline__ unsigned pe_idx(bool hl, int ei0, int ei1, int j) { const int ia = __builtin_amdgcn_readlane(ei0, j), ib = __builtin_amdgcn_readlane(ei1, j); return (unsigned)(hl ? ib : ia); }
__device__ __forceinline__ void peer_eval_phase(const MKP& p, int layer, const float* gate  , bool last, bool dry) {
    int tid = threadIdx.x; asm volatile("" : "+v"(tid));
    const int wid = tid >> 6, lane = tid & 63, q = lane & 31; const bool hl = lane >= 32;
    const uchar* U0 = p.Ub + (size_t)layer * 16384 * 768 + 16 * q; const uchar* U1 = p.Ub + (size_t)layer * 16384 * 768 + 512 + 8 * q;
    const uchar* V0 = p.Vb + (size_t)layer * 16384 * 512 + 16 * q;
    const float* SU = p.SU + layer * 16384; const float* SV = p.SV + layer * 16384;
    const int eoff = 4 * q + (hl ? 512 : 0);
    const int tstride = gridDim.x * 8;
    int t = __builtin_amdgcn_readfirstlane(blockIdx.x * 8 + wid);
    u32x2 nh[8]; int nei0 = 0, nei1 = 0; float neg0 = 0.f, neg1 = 0.f, ndu0 = 0.f, ndu1 = 0.f, nsv0 = 0.f, nsv1 = 0.f;
#pragma unroll
    for (int i = 0; i < 8; ++i) nh[i] = (u32x2){0u, 0u};
    if (t < NTOK) {
#pragma unroll
        for (int i = 0; i < 8; ++i) nh[i] = *(const u32x2*)(p.Hb + (size_t)t * D + 4 * q + 128 * i);
        nei0 = p.EI[(size_t)t * 128 + lane]; nei1 = p.EI[(size_t)t * 128 + 64 + lane]; neg0 = p.EG[(size_t)t * 128 + lane]; neg1 = p.EG[(size_t)t * 128 + 64 + lane];
        pe_sort_header(lane, nei0, nei1, neg0, neg1);
        ndu0 = SU[nei0]; ndu1 = SU[nei1]; nsv0 = SV[nei0]; nsv1 = SV[nei1]; }
    for (; t < NTOK; t += tstride) {
        __syncthreads();
        unsigned xp[16];
#pragma unroll
        for (int i = 0; i < 8; ++i) { xp[2 * i] = nh[i].x; xp[2 * i + 1] = nh[i].y; }
        const int ei0 = nei0, ei1 = nei1;
        const float du0 = ndu0, du1 = ndu1;
        const float gv0 = neg0 * nsv0, gv1 = neg1 * nsv1;
        const int tn = (t + tstride < NTOK) ? t + tstride : t;
        nei0 = p.EI[(size_t)tn * 128 + lane]; nei1 = p.EI[(size_t)tn * 128 + 64 + lane]; neg0 = p.EG[(size_t)tn * 128 + lane]; neg1 = p.EG[(size_t)tn * 128 + 64 + lane];
        f32x2 acc[16];
#pragma unroll
        for (int i = 0; i < 16; ++i) acc[i] = (f32x2){0.f, 0.f};
        u32x4 u0[4], v0[4]; u32x2 u1[4];
#define FP4P(w, b) __builtin_amdgcn_cvt_scalef32_pk_f32_fp4((w), 1.0f, (b))
#define PE_IDX(j) pe_idx(hl, ei0, ei1, j)
#define PE_LOADU(i, ix) { const size_t ro = (size_t)(ix) * 768u; u0[i] = *(const u32x4*)(U0 + ro); u1[i] = *(const u32x2*)(U1 + ro); }
#define PE_LOADV(i, ix) { const size_t ro = (size_t)(ix) * 512u; v0[i] = *(const u32x4*)(V0 + ro); }
#define PE_DOT(i, dd) { const u32x6 w = {u0[i].x, u0[i].y, u0[i].z, u0[i].w, u1[i].x, u1[i].y}; const bf16x32 ud = __builtin_amdgcn_cvt_scalef32_pk32_bf16_fp6(w, 1.0f); \
            float a0 = 0.f, a1 = 0.f; \
            a0 = dot2bf(xp[0], bfpair<0>(ud), a0); a1 = dot2bf(xp[1], bfpair<1>(ud), a1); a0 = dot2bf(xp[2], bfpair<2>(ud), a0); a1 = dot2bf(xp[3], bfpair<3>(ud), a1); \
            a0 = dot2bf(xp[4], bfpair<4>(ud), a0); a1 = dot2bf(xp[5], bfpair<5>(ud), a1); a0 = dot2bf(xp[6], bfpair<6>(ud), a0); a1 = dot2bf(xp[7], bfpair<7>(ud), a1); \
            a0 = dot2bf(xp[8], bfpair<8>(ud), a0); a1 = dot2bf(xp[9], bfpair<9>(ud), a1); a0 = dot2bf(xp[10], bfpair<10>(ud), a0); a1 = dot2bf(xp[11], bfpair<11>(ud), a1); \
            a0 = dot2bf(xp[12], bfpair<12>(ud), a0); a1 = dot2bf(xp[13], bfpair<13>(ud), a1); a0 = dot2bf(xp[14], bfpair<14>(ud), a0); a1 = dot2bf(xp[15], bfpair<15>(ud), a1); dd = a0 + a1; }
#define PE_FMA(i, QP) { const float cf = dppf<QP>(cfl); const f32x2 c2 = {cf, cf}; \
            acc[0] = c2 * FP4P(v0[i].x, 0) + acc[0]; acc[1] = c2 * FP4P(v0[i].x, 1) + acc[1]; acc[2] = c2 * FP4P(v0[i].x, 2) + acc[2]; acc[3] = c2 * FP4P(v0[i].x, 3) + acc[3]; \
            acc[4] = c2 * FP4P(v0[i].y, 0) + acc[4]; acc[5] = c2 * FP4P(v0[i].y, 1) + acc[5]; acc[6] = c2 * FP4P(v0[i].y, 2) + acc[6]; acc[7] = c2 * FP4P(v0[i].y, 3) + acc[7]; \
            acc[8] = c2 * FP4P(v0[i].z, 0) + acc[8]; acc[9] = c2 * FP4P(v0[i].z, 1) + acc[9]; acc[10] = c2 * FP4P(v0[i].z, 2) + acc[10]; acc[11] = c2 * FP4P(v0[i].z, 3) + acc[11]; \
            acc[12] = c2 * FP4P(v0[i].w, 0) + acc[12]; acc[13] = c2 * FP4P(v0[i].w, 1) + acc[13]; acc[14] = c2 * FP4P(v0[i].w, 2) + acc[14]; acc[15] = c2 * FP4P(v0[i].w, 3) + acc[15]; }
        { const unsigned i0 = PE_IDX(0), i1 = PE_IDX(1), i2 = PE_IDX(2), i3 = PE_IDX(3);
          PE_LOADU(0, i0) PE_LOADU(1, i1) PE_LOADU(2, i2) PE_LOADU(3, i3) PE_LOADV(0, i0) PE_LOADV(1, i1) PE_LOADV(2, i2) PE_LOADV(3, i3) }
        const int lq4 = 4 * (lane & 3);
        for (int g = 0; g < 16; ++g) {
            float d0, d1, d2, d3;
            const int gn = g < 15 ? g + 1 : g;
            const unsigned n0 = PE_IDX(4 * gn), n1 = PE_IDX(4 * gn + 1), n2 = PE_IDX(4 * gn + 2), n3 = PE_IDX(4 * gn + 3);
            PE_DOT(0, d0) if (g < 15) PE_LOADU(0, n0)
            PE_DOT(1, d1) if (g < 15) PE_LOADU(1, n1)
            PE_DOT(2, d2) if (g < 15) PE_LOADU(2, n2)
            PE_DOT(3, d3) if (g < 15) PE_LOADU(3, n3)
            float k0 = (lane & 1) ? d1 : d0, s0 = (lane & 1) ? d0 : d1, k1 = (lane & 1) ? d3 : d2, s1 = (lane & 1) ? d2 : d3;
            k0 += dppf<0xB1>(s0); k1 += dppf<0xB1>(s1);
            float kk = (lane & 2) ? k1 : k0, ss = (lane & 2) ? k0 : k1;
            kk += dppf<0x4E>(ss); kk += dppf<0x124>(kk); kk += dppf<0x128>(kk); kk += __shfl_xor(kk, 16);
            const int sa = 16 * g + lq4;
            const float dsa = __int_as_float(__builtin_amdgcn_ds_bpermute(sa, __float_as_int(du0))), dsb = __int_as_float(__builtin_amdgcn_ds_bpermute(sa, __float_as_int(du1)));
            const float gsa = __int_as_float(__builtin_amdgcn_ds_bpermute(sa, __float_as_int(gv0))), gsb = __int_as_float(__builtin_amdgcn_ds_bpermute(sa, __float_as_int(gv1)));
            const float cfl = (hl ? gsb : gsa) * gelu_f(kk * (hl ? dsb : dsa));
            PE_FMA(0, 0x00) if (g < 15) PE_LOADV(0, n0)
            PE_FMA(1, 0x55) if (g < 15) PE_LOADV(1, n1)
            PE_FMA(2, 0xAA) if (g < 15) PE_LOADV(2, n2)
            PE_FMA(3, 0xFF) if (g < 15) PE_LOADV(3, n3)
        }
#undef PE_IDX
#undef PE_LOADU
#undef PE_LOADV
#undef PE_FMA
#undef FP4P
#undef PE_DOT
        pe_sort_header(lane, nei0, nei1, neg0, neg1);
        ndu0 = SU[nei0]; ndu1 = SU[nei1]; nsv0 = SV[nei0]; nsv1 = SV[nei1];
#pragma unroll
        for (int i = 0; i < 8; ++i) nh[i] = *(const u32x2*)(p.Hb + (size_t)tn * D + 4 * q + 128 * i);
        float tot[16];
#pragma unroll
        for (int m = 0; m < 8; ++m) {
            const float k0 = hl ? acc[8 + m][0] : acc[m][0], k1 = hl ? acc[8 + m][1] : acc[m][1], s0 = hl ? acc[m][0] : acc[8 + m][0], s1 = hl ? acc[m][1] : acc[8 + m][1];
            tot[2 * m] = k0 + __shfl_xor(s0, 32); tot[2 * m + 1] = k1 + __shfl_xor(s1, 32); }
        float* xr = p.X + (size_t)t * D + eoff; const float* gt = gate + (size_t)tok_cv(t) * 6144 + eoff;
        const float* gvp = (last ? p.final_g : p.norm1_g + D) + eoff; const float* mvp = p.modv + 3 * 6144 + (size_t)tok_cv(t) * 6144 + eoff;
        f32x4 xx[4], gg[4], gn[4], scv[4], shv[4];
#pragma unroll
        for (int v4 = 0; v4 < 4; ++v4) { xx[v4] = *(const f32x4*)(xr + 128 * v4); gg[v4] = *(const f32x4*)(gt + 128 * v4); gn[v4] = *(const f32x4*)(gvp + 128 * v4);
            if (!last) { scv[v4] = *(const f32x4*)(mvp + D + 128 * v4); shv[v4] = *(const f32x4*)(mvp + 128 * v4); } }
        float xn[16]; float ssq = 0.f;
#pragma unroll
        for (int v4 = 0; v4 < 4; ++v4) { f32x4 o;
#pragma unroll
            for (int e = 0; e < 4; ++e) { o[e] = xx[v4][e] + gg[v4][e] * tot[4 * v4 + e]; xn[4 * v4 + e] = o[e]; ssq += o[e] * o[e]; }
            if (!dry) *(f32x4*)(xr + 128 * v4) = o; }
        ssq = wave_sum(ssq);
        if (dry) { if (ssq == 12345.678f) p.NORMSQ[lane] = ssq; continue; }
        const float rstd = rsqrtf(ssq * (1.f / D) + EPSV);
        if (!last) {
#pragma unroll
            for (int v4 = 0; v4 < 4; ++v4) { float y[4];
#pragma unroll
                for (int e = 0; e < 4; ++e) y[e] = xn[4 * v4 + e] * rstd * gn[v4][e] * (1.f + scv[v4][e]) + shv[v4][e];
                u32x2 w; w.x = pk_bf16(y[0], y[1]); w.y = pk_bf16(y[2], y[3]);
                *(u32x2*)(p.Hb + (size_t)t * D + eoff + 128 * v4) = w; }
        } else {
#pragma unroll
            for (int v4 = 0; v4 < 4; ++v4) { f32x4 o;
#pragma unroll
                for (int e = 0; e < 4; ++e) o[e] = xn[4 * v4 + e] * rstd * gn[v4][e];
                *(f32x4*)(p.out + (size_t)t * D + eoff + 128 * v4) = o; }
        }
    }
}

__device__ __forceinline__ void hy_conv_phase(const MKP& p, LAS uchar* lds) {
    int tid = threadIdx.x; asm volatile("" : "+v"(tid));
    LAS bf16_t* tl = (LAS bf16_t*)lds;
    const int tok = tid >> 3, cseg = tid & 7;
    u32x4 zn[3][3];
    auto loadz = [&](int item, u32x4 (&z)[3][3]) {
        const int t = (item >> 4) * 64 + tok, c = (item & 15) * 64 + 8 * cseg;
        const int rowlen = t < CTX_TOK ? 256 : 64; const int pos = (t < CTX_TOK ? t : t - CTX_TOK) % rowlen;
        const bool vm = pos > 0, vp = pos < rowlen - 1;
#pragma unroll
        for (int part = 0; part < 3; ++part) { const int cc = part * 1024 + c;
            z[part][0] = *(const u32x4*)(p.Zb + (size_t)(vm ? t - 1 : t) * 3072 + cc); z[part][1] = *(const u32x4*)(p.Zb + (size_t)t * 3072 + cc); z[part][2] = *(const u32x4*)(p.Zb + (size_t)(vp ? t + 1 : t) * 3072 + cc);
            if (!vm) z[part][0] = (u32x4){0u, 0u, 0u, 0u};
            if (!vp) z[part][2] = (u32x4){0u, 0u, 0u, 0u}; }
    };
    int item = blockIdx.x; int wcg = -1;
    float wb[3][8], w0c[3][8], w1c[3][8], w2c[3][8];
    if (item < 4096) loadz(item, zn);
    for (; item < 4096; item += gridDim.x) {
        const int tt = item >> 4, cgp = item & 15; const int t0 = tt * 64, c0 = cgp * 64;
        const int t = t0 + tok; const int c = c0 + 8 * cseg;
        if (cgp != wcg) {
#pragma unroll
            for (int part = 0; part < 3; ++part)
#pragma unroll
                for (int e = 0; e < 8; ++e) { const int cc = part * 1024 + c + e; wb[part][e] = p.hy_conv_b[cc]; w0c[part][e] = p.hy_conv_w[cc]; w1c[part][e] = p.hy_conv_w[3072 + cc]; w2c[part][e] = p.hy_conv_w[6144 + cc]; }
            wcg = cgp; }
        u32x4 z[3][3];
#pragma unroll
        for (int a = 0; a < 3; ++a)
#pragma unroll
            for (int b = 0; b < 3; ++b) z[a][b] = zn[a][b];
        const int nitem = item + (int)gridDim.x;
        if (nitem < 4096) loadz(nitem, zn);
        float r[3][8];
#pragma unroll
        for (int part = 0; part < 3; ++part) {
            const unsigned zmu[4] = {z[part][0].x, z[part][0].y, z[part][0].z, z[part][0].w}, z0u[4] = {z[part][1].x, z[part][1].y, z[part][1].z, z[part][1].w}, zpu[4] = {z[part][2].x, z[part][2].y, z[part][2].z, z[part][2].w};
#pragma unroll
            for (int e = 0; e < 8; ++e) { const float a = (e & 1) ? bfhi(zmu[e >> 1]) : bflo(zmu[e >> 1]), b = (e & 1) ? bfhi(z0u[e >> 1]) : bflo(z0u[e >> 1]), cpl = (e & 1) ? bfhi(zpu[e >> 1]) : bflo(zpu[e >> 1]);
                r[part][e] = wb[part][e] + w0c[part][e] * a + w1c[part][e] * b + w2c[part][e] * cpl; } }
        float vg[8];
#pragma unroll
        for (int e = 0; e < 8; ++e) vg[e] = r[2][e] * r[1][e];
        u32x4 w0, w1;
        w0.x = pk_bf16(r[0][0], r[0][1]); w0.y = pk_bf16(r[0][2], r[0][3]); w0.z = pk_bf16(r[0][4], r[0][5]); w0.w = pk_bf16(r[0][6], r[0][7]);
        w1.x = pk_bf16(vg[0], vg[1]); w1.y = pk_bf16(vg[2], vg[3]); w1.z = pk_bf16(vg[4], vg[5]); w1.w = pk_bf16(vg[6], vg[7]);
        *(u32x4*)(p.X0C + (size_t)t * D + c) = w0;
        *(u32x4*)(p.VG + (size_t)t * D + c) = w1;
        __syncthreads();
#pragma unroll
        for (int e = 0; e < 8; ++e) tl[(8 * cseg + e) * 72 + tok] = f2bf(vg[e]);
        __syncthreads();
        { const int cc = tid >> 3, ts = tid & 7; const u32x4 w = *(const LAS u32x4*)(tl + cc * 72 + 8 * ts);
          *(u32x4*)(p.VT + (size_t)(c0 + cc) * NTOK + t0 + 8 * ts) = w; }
    }
}

#define HL_C1 16448
#define HL_V 32896
#define HL_ACC 51456
#define HL_VS 144
__device__ __forceinline__ void hy_long_phase(const MKP& p, LAS uchar* lds, int variant = 0) {
    int tid = threadIdx.x; asm volatile("" : "+v"(tid));
    const int wid = tid >> 6, lane = tid & 63, r = lane & 31, hh = lane >> 5;
    for (int item = blockIdx.x; item < 1024; item += gridDim.x) {
        const int pass = 1; const int c = item & 1023;
        const int L = pass ? 4096 : 256, NA = pass ? 64 : 4, RL = 2 * L;
        const bf16_t* R = p.Rf + (pass ? (size_t)1024 * 512 : 0) + (size_t)c * RL;
        const bf16_t* Vc = p.VT + (size_t)c * NTOK + (pass ? CTX_TOK : 0);
        __syncthreads();
        for (int ch = tid; ch < RL / 16; ch += NTHR) {
            const unsigned* src = (const unsigned*)(R + ch * 16);
            unsigned w[9];
#pragma unroll
            for (int i = 0; i < 8; ++i) w[i] = src[i];
            w[8] = (ch * 16 + 16 < RL) ? src[8] : 0u;
            LAS unsigned* d0 = (LAS unsigned*)(lds + ch * 32); LAS unsigned* d1 = (LAS unsigned*)(lds + HL_C1 + ch * 32);
#pragma unroll
            for (int i = 0; i < 8; ++i) { d0[i] = w[i]; d1[i] = (w[i] >> 16) | (w[i + 1] << 16); }
        }
        for (int ch = tid; ch < 1024; ch += NTHR) *(LAS u32x4*)(lds + HL_V + (ch >> 3) * HL_VS + (ch & 7) * 16) = *(const u32x4*)(Vc + ch * 8);
        __syncthreads();
        f32x16 acc[2][4];
#pragma unroll
        for (int mt = 0; mt < 2; ++mt)
#pragma unroll
            for (int nt = 0; nt < 4; ++nt)
#pragma unroll
                for (int e = 0; e < 16; ++e) acc[mt][nt][e] = 0.f;
        const int dlo = -(NA - 1), dhi = NA - 1;
        const int cpo = (r & 1) ? 0 : HL_C1;
        auto dbody = [&](auto maskc, int dl) {
            constexpr int MASK = decltype(maskc)::value;
            int voff[4]; bool vok[4];
#pragma unroll
            for (int nt = 0; nt < 4; ++nt) { const int col = 32 * nt + r; const int a = col % NA; vok[nt] = (a - dl >= 0) && (a - dl < NA); voff[nt] = HL_V + (vok[nt] ? col - dl : 0) * HL_VS + 16 * hh; }
            const int xbase = (L - 1) - 64 * dl - r + 8 * hh;
#pragma unroll
            for (int ks = 0; ks < 4; ++ks) {
                bf16x8 af[2], bfv[4];
#pragma unroll
                for (int mt = 0; mt < 2; ++mt) { const int x = xbase - 32 * mt + 16 * ks; const int xe = x & ~1;
                    const LAS unsigned* src = (const LAS unsigned*)(lds + cpo + xe * 2);
                    u32x4 w; w.x = src[0]; w.y = src[1]; w.z = src[2]; w.w = src[3]; af[mt] = __builtin_bit_cast(bf16x8, w); }
#pragma unroll
                for (int nt = 0; nt < 4; ++nt) if (MASK & (1 << nt)) { u32x4 w = *(const LAS u32x4*)(lds + voff[nt] + 32 * ks);
                    if (!vok[nt]) w = (u32x4){0u, 0u, 0u, 0u}; bfv[nt] = __builtin_bit_cast(bf16x8, w); }
#pragma unroll
                for (int nt = 0; nt < 4; ++nt) if (MASK & (1 << nt)) {
#pragma unroll
                    for (int mt = 0; mt < 2; ++mt) acc[mt][nt] = __builtin_amdgcn_mfma_f32_32x32x16_bf16(af[mt], bfv[nt], acc[mt][nt], 0, 0, 0); }
            }
        };
        if (variant & 2) {}
        else if (pass) {
            for (int dl = -63 + wid; dl <= -32; dl += 8) dbody(std::integral_constant<int, 5>{}, dl);
            for (int dl = -31 + wid; dl <= 31; dl += 8) dbody(std::integral_constant<int, 15>{}, dl);
            for (int dl = 32 + wid; dl <= 63; dl += 8) dbody(std::integral_constant<int, 10>{}, dl);
        } else {
            for (int dl = dlo + wid; dl <= dhi; dl += 8) dbody(std::integral_constant<int, 15>{}, dl);
        }
#pragma unroll
        for (int w = 0; w < 8; ++w) {
            if (wid == w && !(variant & 1)) {
#pragma unroll
                for (int mt = 0; mt < 2; ++mt)
#pragma unroll
                    for (int nt = 0; nt < 4; ++nt)
#pragma unroll
                        for (int q = 0; q < 4; ++q) { LAS f32x4* ap = (LAS f32x4*)(lds + HL_ACC + ((32 * nt + r) * 68 + 32 * mt + 8 * q + 4 * hh) * 4);
                            f32x4 v = {acc[mt][nt][4 * q], acc[mt][nt][4 * q + 1], acc[mt][nt][4 * q + 2], acc[mt][nt][4 * q + 3]};
                            if (w > 0) v += *ap;
                            *ap = v; }
            }
            __syncthreads();
        }
        { float sq = 0.f;
#pragma unroll
          for (int i = 0; i < 4; ++i) { const float* pq = p.PSQ + (size_t)(16 + 4 * lane + i) * 2048 + c; sq += pq[0] + pq[1024]; }
          const float nrm = rsqrtf(wave_sum(sq) + EPSV);
          const int col = tid >> 2, i0 = 16 * (tid & 3); const LAS float* a = (const LAS float*)(lds + HL_ACC) + col * 68 + i0;
          u32x4 w0, w1;
          w0.x = pk_bf16(a[0] * nrm, a[1] * nrm); w0.y = pk_bf16(a[2] * nrm, a[3] * nrm); w0.z = pk_bf16(a[4] * nrm, a[5] * nrm); w0.w = pk_bf16(a[6] * nrm, a[7] * nrm);
          w1.x = pk_bf16(a[8] * nrm, a[9] * nrm); w1.y = pk_bf16(a[10] * nrm, a[11] * nrm); w1.z = pk_bf16(a[12] * nrm, a[13] * nrm); w1.w = pk_bf16(a[14] * nrm, a[15] * nrm);
          bf16_t* dst = p.YT + (size_t)c * NTOK + (pass ? CTX_TOK : 0) + col * 64 + i0;
          if (variant == 0) { *(u32x4*)dst = w0; *(u32x4*)(dst + 8) = w1; } else if (nrm == 123.456f) { *(u32x4*)dst = w0; } }
    }
    {
        constexpr int L = 256, NA = 4, RL = 512;
        LAS uchar* wl = lds + wid * 18688; constexpr int W_C1 = 1088, W_V = 2176;
        const int cpo = (r & 1) ? 0 : W_C1;
        __syncthreads();
        for (int item = blockIdx.x; item < 128; item += gridDim.x) {
            const int c = item * 8 + wid;
            const bf16_t* R = p.Rf + (size_t)c * RL; const bf16_t* Vc = p.VT + (size_t)c * NTOK;
            if (lane < 32) { const unsigned* src = (const unsigned*)(R + lane * 16); unsigned w[9];
#pragma unroll
                for (int i = 0; i < 8; ++i) w[i] = src[i];
                w[8] = src[lane < 31 ? 8 : 7]; if (lane == 31) w[8] = 0u;
                LAS unsigned* d0 = (LAS unsigned*)(wl + lane * 32); LAS unsigned* d1 = (LAS unsigned*)(wl + W_C1 + lane * 32);
#pragma unroll
                for (int i = 0; i < 8; ++i) { d0[i] = w[i]; d1[i] = (w[i] >> 16) | (w[i + 1] << 16); } }
            { u32x4 vv[16];
#pragma unroll
              for (int i = 0; i < 16; ++i) vv[i] = *(const u32x4*)(Vc + (lane + 64 * i) * 8);
#pragma unroll
              for (int i = 0; i < 16; ++i) *(LAS u32x4*)(wl + W_V + (lane + 64 * i) * 16) = vv[i]; }
            f32x16 acc[2][4];
#pragma unroll
            for (int mt = 0; mt < 2; ++mt)
#pragma unroll
                for (int nt = 0; nt < 4; ++nt)
#pragma unroll
                    for (int e = 0; e < 16; ++e) acc[mt][nt][e] = 0.f;
            if (!(variant & 2))
            for (int dl = -3; dl <= 3; ++dl) {
                int voff[4]; bool vok[4];
#pragma unroll
                for (int nt = 0; nt < 4; ++nt) { const int col = 32 * nt + r; const int a = col & 3; vok[nt] = (a - dl >= 0) && (a - dl < NA); voff[nt] = W_V + (vok[nt] ? col - dl : 0) * 128 + 16 * hh; }
                const int xbase = (L - 1) - 64 * dl - r + 8 * hh;
#pragma unroll
                for (int ks = 0; ks < 4; ++ks) {
                    bf16x8 af[2], bfv[4];
#pragma unroll
                    for (int mt = 0; mt < 2; ++mt) { const int x = xbase - 32 * mt + 16 * ks; const int xe = x & ~1;
                        const LAS unsigned* src = (const LAS unsigned*)(wl + cpo + xe * 2);
                        u32x4 w; w.x = src[0]; w.y = src[1]; w.z = src[2]; w.w = src[3]; af[mt] = __builtin_bit_cast(bf16x8, w); }
#pragma unroll
                    for (int nt = 0; nt < 4; ++nt) { u32x4 w = *(const LAS u32x4*)(wl + voff[nt] + 32 * ks);
                        if (!vok[nt]) w = (u32x4){0u, 0u, 0u, 0u}; bfv[nt] = __builtin_bit_cast(bf16x8, w); }
#pragma unroll
                    for (int nt = 0; nt < 4; ++nt)
#pragma unroll
                        for (int mt = 0; mt < 2; ++mt) acc[mt][nt] = __builtin_amdgcn_mfma_f32_32x32x16_bf16(af[mt], bfv[nt], acc[mt][nt], 0, 0, 0);
                }
            }
            float sq = 0.f;
            if (lane < 16) { const float* pq = p.PSQ + (size_t)lane * 2048 + c; const float* pq2 = p.PSQ + (size_t)(272 + lane) * 2048 + c; sq = (pq[0] + pq[1024]) + (pq2[0] + pq2[1024]); }
            const float nrm = rsqrtf(wave_sum(sq) + EPSV);
            bf16_t* dstc = p.YT + (size_t)c * NTOK;
#pragma unroll
            for (int mt = 0; mt < 2; ++mt)
#pragma unroll
                for (int nt = 0; nt < 4; ++nt)
#pragma unroll
                    for (int q = 0; q < 4; ++q) { u32x2 w; w.x = pk_bf16(acc[mt][nt][4 * q] * nrm, acc[mt][nt][4 * q + 1] * nrm); w.y = pk_bf16(acc[mt][nt][4 * q + 2] * nrm, acc[mt][nt][4 * q + 3] * nrm);
                        if (variant == 0) *(u32x2*)(dstc + (32 * nt + r) * 64 + 32 * mt + 8 * q + 4 * hh) = w; }
        }
    }
}

__device__ __forceinline__ void hy_gate_phase(const MKP& p, LAS uchar* lds) {
    int tid = threadIdx.x; asm volatile("" : "+v"(tid));
    LAS bf16_t* tl = (LAS bf16_t*)lds;
    const int tok = tid >> 3, cseg = tid & 7, cc = tid >> 3, ts = tid & 7;
    int item = blockIdx.x;
    u32x4 ytn = {0u, 0u, 0u, 0u}, x0n = ytn, vgn = ytn;
    auto loadg = [&](int it) { const int t0 = (it >> 4) * 64, c0 = (it & 15) * 64;
        ytn = *(const u32x4*)(p.YT + (size_t)(c0 + cc) * NTOK + t0 + 8 * ts);
        x0n = *(const u32x4*)(p.X0C + (size_t)(t0 + tok) * D + c0 + 8 * cseg); vgn = *(const u32x4*)(p.VG + (size_t)(t0 + tok) * D + c0 + 8 * cseg); };
    if (item < 4096) loadg(item);
    for (; item < 4096; item += gridDim.x) {
        const int tt = item >> 4, cgp = item & 15; const int t0 = tt * 64, c0 = cgp * 64;
        const u32x4 yt = ytn, x0 = x0n, vgp = vgn;
        float hb[8];
#pragma unroll
        for (int e = 0; e < 8; ++e) hb[e] = p.hy_bias[c0 + 8 * cseg + e];
        if (item + (int)gridDim.x < 4096) loadg(item + (int)gridDim.x);
        __syncthreads();
        *(LAS u32x4*)(tl + cc * 72 + 8 * ts) = yt;
        __syncthreads();
        const int t = t0 + tok, c = c0 + 8 * cseg;
        const unsigned x0u[4] = {x0.x, x0.y, x0.z, x0.w}, vgu[4] = {vgp.x, vgp.y, vgp.z, vgp.w};
        float y[8];
#pragma unroll
        for (int e = 0; e < 8; ++e) { const float cv = bf2f(tl[(8 * cseg + e) * 72 + tok]); const float vv = (e & 1) ? bfhi(vgu[e >> 1]) : bflo(vgu[e >> 1]), xx = (e & 1) ? bfhi(x0u[e >> 1]) : bflo(x0u[e >> 1]);
            y[e] = (cv + hb[e] * vv) * xx; }
        u32x4 w; w.x = pk_bf16(y[0], y[1]); w.y = pk_bf16(y[2], y[3]); w.z = pk_bf16(y[4], y[5]); w.w = pk_bf16(y[6], y[7]);
        *(u32x4*)(p.CAT + (size_t)t * D + c) = w;
    }
}

extern __shared__ __attribute__((aligned(16))) unsigned char smem_raw[];
#define MK_LDS_BYTES 163840

#define XB_TMO      128
#define XB_XCNT(j)  (256  + 64 * (j))
#define XB_XSUB(j)  (1280 + 64 * (j))
#define XB_XGEN(j)  (2304 + 64 * (j))
#define XB_TOP      3328
#define XB_TOPGEN   3392
#define XCD_BAR_WORDS 3456
#define XB_SPIN_CAP (1u << 20)
__device__ __forceinline__ unsigned xb_ld(unsigned* q) { return __hip_atomic_load(q, __ATOMIC_RELAXED, __HIP_MEMORY_SCOPE_AGENT); }
__device__ __forceinline__ unsigned xb_add(unsigned* q, unsigned v) { return __hip_atomic_fetch_add(q, v, __ATOMIC_RELAXED, __HIP_MEMORY_SCOPE_AGENT); }
__device__ __forceinline__ unsigned xb_xcc_id() { return (unsigned)__builtin_amdgcn_s_getreg((3 << 11) | 20) & 0xFu; }
#define XB_SPIN(cond, bar) do { unsigned _sp = 0; while (cond) { __builtin_amdgcn_s_sleep(1); \
    if ((++_sp & 255u) == 0u) { if (xb_ld(&(bar)[XB_TMO])) break; if (_sp > XB_SPIN_CAP) { atomicAdd(&(bar)[XB_TMO], 1u); break; } } } } while (0)
struct XcdBarrier { unsigned* bar; unsigned x; volatile LAS unsigned* st; };
__device__ __forceinline__ XcdBarrier xcd_barrier_post(unsigned* bar, volatile LAS unsigned* st) {
    XcdBarrier b; b.bar = bar; b.x = xb_xcc_id(); b.st = st;
    if (threadIdx.x == 0) (void)xb_add(&bar[XB_XCNT(b.x)], 1u);
    return b;
}
__device__ __forceinline__ void xcd_barrier_complete(unsigned* bar, unsigned x, unsigned& nloc, unsigned& nx) {
    const unsigned G = gridDim.x * gridDim.y * gridDim.z;
    unsigned sum, cnt, mine, sp = 0u;
    for (;;) {
        sum = 0u; cnt = 0u; mine = 0u;
#pragma unroll
        for (unsigned j = 0; j < 16; ++j) { const unsigned c = xb_ld(&bar[XB_XCNT(j)]); sum += c; cnt += (c > 0u) ? 1u : 0u; mine = (j == x) ? c : mine; }
        if (sum == G) break;
        __builtin_amdgcn_s_sleep(1);
        if ((++sp & 255u) == 0u) { if (xb_ld(&bar[XB_TMO])) break; if (sp > XB_SPIN_CAP) { atomicAdd(&bar[XB_TMO], 1u); break; } }
    }
    nloc = mine > 0u ? mine : 1u; nx = cnt > 0u ? cnt : 1u;
}
__device__ __forceinline__ void xcd_barrier(const XcdBarrier& b) {
    asm volatile("s_waitcnt vmcnt(0)" ::: "memory");
    __syncthreads();
    if (threadIdx.x == 0) {
        unsigned* bar = b.bar;
        __builtin_amdgcn_s_waitcnt(0);
        unsigned nloc = b.st[0], nx = b.st[1];
        if (nloc == 0u) { xcd_barrier_complete(bar, b.x, nloc, nx); b.st[0] = nloc; b.st[1] = nx; }
        const unsigned old = xb_add(&bar[XB_XSUB(b.x)], 1u);
        const unsigned gen = old / nloc;
        if (old + 1u == (gen + 1u) * nloc) {
            __builtin_amdgcn_fence(__ATOMIC_RELEASE, "agent");
            asm volatile("s_waitcnt vmcnt(0)" ::: "memory");
            const unsigned og = xb_add(&bar[XB_TOP], 1u);
            const unsigned tg = og / nx;
            if (og + 1u == (tg + 1u) * nx) xb_add(&bar[XB_TOPGEN], 1u);
            else XB_SPIN(xb_ld(&bar[XB_TOPGEN]) == tg, bar);
            __builtin_amdgcn_fence(__ATOMIC_ACQUIRE, "agent");
            xb_add(&bar[XB_XGEN(b.x)], 1u);
            asm volatile("s_waitcnt vmcnt(0)" ::: "memory");
        } else {
            XB_SPIN(xb_ld(&bar[XB_XGEN(b.x)]) == gen, bar);
            __builtin_amdgcn_fence(__ATOMIC_ACQUIRE, "agent");
            asm volatile("s_waitcnt vmcnt(0)" ::: "memory");
        }
    }
    __syncthreads();
}
#define MK_BAR_LDS_OFF (MK_LDS_BYTES - 16)

#define GSYNC_CG() do { asm volatile("s_waitcnt vmcnt(0)" ::: "memory"); grid.sync(); \
    if (threadIdx.x == 0) { __builtin_amdgcn_fence(__ATOMIC_ACQUIRE, "agent"); asm volatile("s_waitcnt vmcnt(0)" ::: "memory"); } __syncthreads(); } while (0)
#define GSYNC() xcd_barrier(xb)

struct Pg8Store {
    static constexpr bool PERM = false, AFTER_DRAIN = false;
    bf16_t* O; int ldc; const float* bias;
    __device__ __forceinline__ void operator()(const f32x4 (&acc)[2][2][4][2], const pg8::Unit& u, int wr, int wc, int fr, int fq) const {
        f32x4 bv[2][2];
#pragma unroll
        for (int bj = 0; bj < 2; ++bj)
#pragma unroll
            for (int n = 0; n < 2; ++n) bv[bj][n] = bias ? *(const f32x4*)(bias + u.pn * 256 + bj * 128 + wc * 32 + n * 16 + 4 * fq) : (f32x4){0.f, 0.f, 0.f, 0.f};
#pragma unroll
        for (int ai = 0; ai < 2; ++ai)
#pragma unroll
            for (int m = 0; m < 4; ++m)
#pragma unroll
                for (int bj = 0; bj < 2; ++bj)
#pragma unroll
                    for (int n = 0; n < 2; ++n) { const f32x4 v = acc[ai][bj][m][n] + bv[bj][n]; u32x2 w; w.x = pk_bf16(v[0], v[1]); w.y = pk_bf16(v[2], v[3]);
                        *(u32x2*)(O + (size_t)(u.pm * 256 + ai * 128 + wr * 64 + m * 16 + fr) * ldc + u.pn * 256 + bj * 128 + wc * 32 + n * 16 + 4 * fq) = w; }
    }
};
struct Pg8Resid {
    static constexpr bool PERM = false, AFTER_DRAIN = false;
    const MKP* p; bool from_input; const float* gate; const float* bias;
    __device__ __forceinline__ void operator()(const f32x4 (&acc)[2][2][4][2], const pg8::Unit& u, int wr, int wc, int fr, int fq) const {
        const float* gt = gate + (size_t)tok_cv(u.pm * 256) * 6144;
        f32x4 gv[2][2], bv[2][2];
#pragma unroll
        for (int bj = 0; bj < 2; ++bj)
#pragma unroll
            for (int n = 0; n < 2; ++n) { const int col = u.pn * 256 + bj * 128 + wc * 32 + n * 16 + 4 * fq; gv[bj][n] = *(const f32x4*)(gt + col); bv[bj][n] = bias ? *(const f32x4*)(bias + col) : (f32x4){0.f, 0.f, 0.f, 0.f}; }
#pragma unroll
        for (int ai = 0; ai < 2; ++ai)
#pragma unroll
            for (int mh = 0; mh < 2; ++mh) {
                f32x4 xv[2][2][2];
#pragma unroll
                for (int mm = 0; mm < 2; ++mm) { const int row = u.pm * 256 + ai * 128 + wr * 64 + (2 * mh + mm) * 16 + fr; const float* xr = from_input ? xin_row(*p, row) : p->X + (size_t)row * D;
#pragma unroll
                    for (int bj = 0; bj < 2; ++bj)
#pragma unroll
                        for (int n = 0; n < 2; ++n) xv[mm][bj][n] = *(const f32x4*)(xr + u.pn * 256 + bj * 128 + wc * 32 + n * 16 + 4 * fq); }
#pragma unroll
                for (int mm = 0; mm < 2; ++mm) { const int row = u.pm * 256 + ai * 128 + wr * 64 + (2 * mh + mm) * 16 + fr;
#pragma unroll
                    for (int bj = 0; bj < 2; ++bj)
#pragma unroll
                        for (int n = 0; n < 2; ++n) { const f32x4 o = xv[mm][bj][n] + gv[bj][n] * (acc[ai][bj][2 * mh + mm][n] + bv[bj][n]);
                            *(f32x4*)(p->X + (size_t)row * D + u.pn * 256 + bj * 128 + wc * 32 + n * 16 + 4 * fq) = o; } }
            }
    }
};
template <class E> __device__ __forceinline__ void gemm8(const bf16_t* A, const bf16_t* Bt, int M, int N, int K, LAS uchar* lds, const E& e) {
    pg8::StaticOrder S; S.init(M, N, (int)gridDim.x, (int)blockIdx.x);
    pg8::gemm_phase<E, pg8::StaticOrder, false>(lds, pg8::Gemm{A, Bt, M, N, K}, S, e, nullptr);
    __syncthreads();
}

#ifndef MK_PROBE
#define MK_PROBE 0
#endif
#define REP(bit) for (int _r = 0; _r < (((MK_PROBE) >> (bit)) & 1) + 1; ++_r)
__global__ void __launch_bounds__(NTHR) mega_fwd(MKP p) {
    cg::grid_group grid = cg::this_grid();
    LAS uchar* lds = (LAS uchar*)smem_raw;
    volatile LAS unsigned* xst = (volatile LAS unsigned*)(lds + MK_BAR_LDS_OFF);
    if (threadIdx.x == 0) { xst[0] = 0u; xst[1] = 0u; }
    __syncthreads();
    const XcdBarrier xb = xcd_barrier_post(p.bar, xst);
    REP(0) { phase0(p, lds); GSYNC_CG(); }
#pragma nounroll
    for (int layer = 0; layer < 2; ++layer) {
        const float* mv = p.modv + layer * 3 * 6144;
        if (layer == 0) {
            REP(1) { norm_phase(p, true, p.norm1_g, mv, 0, 1, p.Hb); GSYNC(); }
            REP(13) { if (_r == 1) { hyfilt_phase<16>(p, lds, 16, 256, 0); GSYNC(); } }
            REP(2) {
                      { Pg8Store e{p.Zb, 1536, nullptr}; gemm8(p.Hb, p.WinT, NTOK, 1024, D, lds, e); }
                      { EpiStoreT e{p.Zb, 1536, 1024}; gemm_phase<128>(p.Hb, D, p.WinT + (size_t)1024 * 1024, D, D, NTOK, 512, lds, e); }
                      GSYNC(); }
            REP(3) {
#pragma nounroll
                for (int pass = 0; pass < 2; ++pass) {
                    if (_r == 1 && (((MK_PROBE) >> 17) & 3) && !((((MK_PROBE) >> 17) & 3) & (1 << pass))) continue;
                    scan_phase(p, pass, lds, _r == 0 ? 3 : (((MK_PROBE) >> 9) & 3) ? (((MK_PROBE) >> 9) & 3) : 3); GSYNC(); } }
            REP(2) { EpiGlu e{p.ZS, p.CAT, p.s5_b_glu}; gemm_phase<128>(p.ZS, 512, p.WgluT, 512, 512, NTOK, 512, lds, e); GSYNC(); }
        } else {
            REP(2) { Pg8Store e{p.Zb, 3072, p.b_in_c}; gemm8(p.Hb, p.WincT, NTOK, 3072, D, lds, e); GSYNC(); }
            REP(4) { hy_conv_phase(p, lds); GSYNC(); }
            REP(5) { hy_long_phase(p, lds, _r == 0 ? 0 : (((MK_PROBE) >> 11) & 3)); GSYNC(); }
            REP(4) { hy_gate_phase(p, lds); GSYNC(); }
        }
        { Pg8Resid e{&p, layer == 0, mv + 2 * D, layer ? p.b_out_c : nullptr}; gemm8(p.CAT, layer ? p.WoutcT : p.WoutT, NTOK, D, D, lds, e); }
        GSYNC();
        REP(14) { if (_r == 1 && layer == 0) { Pg8Resid e{&p, true, mv + 2 * D, nullptr}; gemm8(p.CAT, p.WoutT, NTOK, D, D, lds, e); GSYNC(); } }
        REP(1) { norm_phase(p, false, p.norm2_g + layer * D, mv, 3, 4, p.Hb); GSYNC(); }
        REP(6) { peer_route2_phase(p, layer, lds, p.Hb); GSYNC(); }
#if (MK_PROBE >> 7) & 1
        peer_eval_phase(p, layer, mv + 5 * D, layer == 1, true); GSYNC();
#endif
        peer_eval_phase(p, layer, mv + 5 * D, layer == 1, false);
        if (layer == 0) GSYNC();
#if (MK_PROBE >> 8) & 1
        for (int _r = 0; _r < 10; ++_r) GSYNC();
#endif
    }
}

static void mk_fill_params(MKP& p, void* const* d_in, void* d_out, void* d_ws) {
    const float** f = (const float**)&p;
    for (int i = 0; i < 50; ++i) f[i] = (const float*)d_in[i];
    p.out = (float*)d_out;
    unsigned char* ws = (unsigned char*)d_ws; size_t off = 0;
    auto take = [&](size_t bytes) { unsigned char* q = ws + off; off += (bytes + 255) & ~(size_t)255; return q; };
    p.X = (float*)take((size_t)NTOK * D * 4);
    p.Hb = (bf16_t*)take((size_t)NTOK * D * 2);
    p.Zb = (bf16_t*)take((size_t)NTOK * 3072 * 2);
    p.CAT = (bf16_t*)take((size_t)NTOK * D * 2);
    unsigned char* regA = take((size_t)96 << 20);
    p.ZS = (bf16_t*)regA; p.HS = (float*)(regA + ((size_t)16 << 20)); p.Qs = (bf16_t*)(regA + ((size_t)48 << 20));
    p.EI = (int*)(regA + ((size_t)80 << 20)); p.EG = (float*)(regA + ((size_t)88 << 20));
    p.X0C = (bf16_t*)regA; p.VG = (bf16_t*)(regA + ((size_t)32 << 20)); p.VT = (bf16_t*)(regA + ((size_t)64 << 20));
    p.YT = p.Zb;
    p.Ub = (uchar*)take((size_t)2 * 16384 * 768); p.Vb = (uchar*)take((size_t)2 * 16384 * 512);
    p.SU = (float*)take(2 * 16384 * 4); p.SV = (float*)take(2 * 16384 * 4); p.bar = (unsigned*)take(16384);
    p.WinT = (bf16_t*)take((size_t)1536 * 1024 * 2); p.WgluT = (bf16_t*)take((size_t)512 * 512 * 2); p.WoutT = (bf16_t*)take((size_t)1024 * 1024 * 2);
    p.WincT = (bf16_t*)take((size_t)3072 * 1024 * 2); p.WoutcT = (bf16_t*)take((size_t)1024 * 1024 * 2); p.WqT = (bf16_t*)take((size_t)2 * 2048 * 1024 * 2);
    p.Keysb = (bf16_t*)take((size_t)2 * 16 * 128 * 128 * 2); p.WaT = (bf16_t*)take((size_t)16 * 4096 * 2); p.WxT = (bf16_t*)take((size_t)16 * 4096 * 2);
    p.Bmat = (bf16_t*)take((size_t)64 * 128 * 16 * 2); p.CmT = (bf16_t*)take((size_t)64 * 16 * 128 * 2);
    p.abar = (float*)take(4096 * 2 * 4); p.aL = (float*)take(4096 * 2 * 4);
    p.S5car = (float*)take((size_t)2 * 2 * 32 * 16 * 128 * 4); p.LRUcar = (float*)take((size_t)256 * 2 * 1024 * 4);
    p.modv = (float*)take(2 * 3 * 6144 * 4); p.Z2 = (float*)take((size_t)4352 * 64 * 4); p.NORMSQ = (float*)take(2048 * 4); p.PSQ = (float*)take((size_t)288 * 2048 * 4);
    p.Rf = (bf16_t*)take(((size_t)1024 * 512 + (size_t)1024 * 8192) * 2);
    p.stop_after = 0; p.pad0 = 0;
}

#include <string.h>
#ifndef MK_STOP_AFTER
#define MK_STOP_AFTER 0
#endif
extern "C" void kernel_launch(void* const* d_in, const int* in_sizes, int n_in, void* d_out, int out_size, void* d_ws, size_t ws_size, hipStream_t stream) {
    static int grid_blocks = 0;
    if (!grid_blocks) {
        int dev = 0, cus = 0, per_cu = 0;
        (void)hipGetDevice(&dev);
        (void)hipDeviceGetAttribute(&cus, hipDeviceAttributeMultiprocessorCount, dev);
        (void)hipFuncSetAttribute((const void*)mega_fwd, hipFuncAttributeMaxDynamicSharedMemorySize, MK_LDS_BYTES);
        (void)hipOccupancyMaxActiveBlocksPerMultiprocessor(&per_cu, (const void*)mega_fwd, NTHR, MK_LDS_BYTES);
        if (per_cu > 1) per_cu = 1;
        grid_blocks = cus * per_cu; if (grid_blocks > 256) grid_blocks = 256;
        grid_blocks &= ~7;
        if (grid_blocks < 1) { fprintf(stderr, "mega_fwd: occupancy query returned 0 blocks per CU\n"); grid_blocks = 0; return; }
    }
    MKP p; memset(&p, 0, sizeof(p));
    mk_fill_params(p, d_in, d_out, d_ws);
    p.stop_after = MK_STOP_AFTER;
    (void)hipMemsetAsync(p.bar, 0, XCD_BAR_WORDS * 4, stream);
    void* args[] = {&p};
    hipError_t e = hipLaunchCooperativeKernel((const void*)mega_fwd, dim3(grid_blocks), dim3(NTHR), args, MK_LDS_BYTES, stream);
    if (e != hipSuccess) fprintf(stderr, "cooperative launch failed: %s (grid %d)\n", hipGetErrorString(e), grid_blocks);
#if MK_STOP_AFTER != 0
    nv::naive_tail(MK_STOP_AFTER, d_in, d_out, d_ws, stream);
#endif
}
```
